# Optimizing an MI355X kernel written in HIP

```python
import math
import jax, jax.numpy as jnp
from jax import lax
import numpy as np

D_MODEL = 1024
BATCH = 1
SEQ = 16384
DEPTH = 4

HEAD_DIM = 64
A_HEADS = 4
A_CONFIGS = ((128, 1), (512, 4), (2048, 16))
B_HEADS = 4
B_KV_HEADS = 2
B_WINDOW = 128
ROPE_THETA = 150000.0
C_HEADS = 8
C_KV_HEADS = 2
CMP_BLOCK = 32
CMP_STRIDE = 16
CMP_HIDDEN = 256
SEL_BLOCK = 64
SEL_TOPK = 16
C_WINDOW = 512
BLOCK = 128
REL_BUCKETS = 32
REL_MAX_DIST = 2048
D_FF = 4 * D_MODEL
MIX_WIDTH = (A_HEADS + B_HEADS + C_HEADS) * HEAD_DIM
DN_ALPHA = (2 * DEPTH) ** 0.25
DN_BETA = (8 * DEPTH) ** -0.25
LN_EPS = 1e-5
NEG = -1e30
FORCE = 1e4

IN_WIDTHS = (
    A_HEADS * HEAD_DIM, A_HEADS * HEAD_DIM, A_HEADS * HEAD_DIM,
    B_HEADS * HEAD_DIM, B_KV_HEADS * HEAD_DIM, B_KV_HEADS * HEAD_DIM,
    C_HEADS * HEAD_DIM,
    C_KV_HEADS * HEAD_DIM, C_KV_HEADS * HEAD_DIM,
    C_KV_HEADS * HEAD_DIM, C_KV_HEADS * HEAD_DIM,
    C_KV_HEADS * HEAD_DIM, C_KV_HEADS * HEAD_DIM,
    C_HEADS * 3,
)
N_IN = sum(IN_WIDTHS)
SPLIT_POINTS = tuple(int(v) for v in np.cumsum(IN_WIDTHS)[:-1])

kernel_name = "hybrid_dilated_swa_nsa_deepnorm_adaln"


def layer_norm(x, g, b):
    xf = x.astype(jnp.float32)
    mu = jnp.mean(xf, axis=-1, keepdims=True)
    var = jnp.mean(jnp.square(xf - mu), axis=-1, keepdims=True)
    return ((xf - mu) * lax.rsqrt(var + LN_EPS) * g + b).astype(x.dtype)


def t5_bucket(dist):
    exact = REL_BUCKETS // 2
    d = jnp.maximum(dist, 0)
    df = jnp.maximum(d, 1).astype(jnp.float32)
    large = exact + (jnp.log(df / exact) / math.log(REL_MAX_DIST / exact)
                     * (REL_BUCKETS - exact)).astype(jnp.int32)
    large = jnp.minimum(large, REL_BUCKETS - 1)
    return jnp.where(d < exact, d, large)


def rope(t, positions):
    half = t.shape[-1] // 2
    freq = ROPE_THETA ** (-jnp.arange(half, dtype=jnp.float32) / half)
    ang = positions[..., None].astype(jnp.float32) * freq
    cos, sin = jnp.cos(ang)[:, :, None, :], jnp.sin(ang)[:, :, None, :]
    t1, t2 = t[..., :half].astype(jnp.float32), t[..., half:].astype(jnp.float32)
    return jnp.concatenate([t1 * cos - t2 * sin, t2 * cos + t1 * sin], -1).astype(t.dtype)


def banded_attention(q, k, v, max_dist, rel_bias=None, dist_scale=1, sinks=None):
    bsz, L, H, hd = q.shape
    hkv = k.shape[2]
    g = H // hkv
    nblk = L // BLOCK
    nprev = -(-max_dist // BLOCK)
    kctx = (nprev + 1) * BLOCK
    qb = q.reshape(bsz, nblk, BLOCK, hkv, g, hd)

    def context(t):
        tp = jnp.pad(t, ((0, 0), (nprev * BLOCK, 0), (0, 0), (0, 0)))
        tb = tp.reshape(bsz, nblk + nprev, BLOCK, hkv, hd)
        return jnp.concatenate([tb[:, i:i + nblk] for i in range(nprev + 1)], axis=2)

    kc, vc = context(k), context(v)
    s = jnp.einsum('bnqhgd,bnkhd->bnhgqk', qb, kc).astype(jnp.float32) * (hd ** -0.5)
    rel = jnp.arange(kctx) - nprev * BLOCK
    dist = jnp.arange(BLOCK)[:, None] - rel[None, :]
    kpos = jnp.arange(nblk)[:, None, None] * BLOCK + rel[None, None, :]
    valid = (dist >= 0) & (dist <= max_dist) & (kpos >= 0)
    if rel_bias is not None:
        bias = rel_bias[t5_bucket(dist * dist_scale)]
        s = s + jnp.transpose(bias, (2, 0, 1)).reshape(hkv, g, BLOCK, kctx).astype(jnp.float32)
    s = jnp.where(valid[None, :, None, None], s, NEG)
    m = jnp.max(s, axis=-1, keepdims=True)
    if sinks is not None:
        sk = sinks.astype(jnp.float32).reshape(hkv, g)[None, None, :, :, None, None]
        m = jnp.maximum(m, sk)
    e = jnp.exp(s - m)
    den = jnp.sum(e, axis=-1, keepdims=True)
    if sinks is not None:
        den = den + jnp.exp(sk - m)
    p = (e / den).astype(v.dtype)
    out = jnp.einsum('bnhgqk,bnkhd->bnqhgd', p, vc).reshape(bsz, L, H, hd)
    lse = (m + jnp.log(den))[..., 0]
    return out, lse.transpose(0, 1, 4, 2, 3).reshape(bsz, L, H)


def dilated_attention(q, k, v, rel_bias):
    bsz, S, H, hd = q.shape
    outs, lses = [], []
    for window, dil in A_CONFIGS:
        span = dil * BLOCK
        L = -(-S // span) * span

        def to_sub(t):
            tp = jnp.pad(t, ((0, 0), (0, L - S), (0, 0), (0, 0)))
            return tp.reshape(bsz, L // dil, dil, H, hd).transpose(0, 2, 1, 3, 4).reshape(bsz * dil, L // dil, H, hd)

        o, lse = banded_attention(to_sub(q), to_sub(k), to_sub(v), window // dil,
                                  rel_bias=rel_bias, dist_scale=dil)
        outs.append(o.reshape(bsz, dil, L // dil, H, hd).transpose(0, 2, 1, 3, 4).reshape(bsz, L, H, hd)[:, :S])
        lses.append(lse.reshape(bsz, dil, L // dil, H).transpose(0, 2, 1, 3).reshape(bsz, L, H)[:, :S])
    w = jax.nn.softmax(jnp.stack(lses, axis=-1), axis=-1)
    return jnp.einsum('bshdc,bshc->bshd', jnp.stack(outs, axis=-1), w.astype(q.dtype))


def nsa_attention(q, k_cmp_tok, v_cmp_tok, k_slc, v_slc, k_win, v_win, gates,
                  cmp_pos, cmp_w1, cmp_w2, rel_bias):
    bsz, S, H, hd = q.shape
    hkv = k_slc.shape[2]
    g = H // hkv
    scale = hd ** -0.5
    r = CMP_BLOCK // CMP_STRIDE
    n_cmp = S // CMP_STRIDE - r + 1

    def compress(t, pos, w1, w2):
        tb = t.reshape(bsz, S // CMP_STRIDE, CMP_STRIDE, hkv, hd)
        blocks = jnp.concatenate([tb[:, i:i + n_cmp] for i in range(r)], axis=2)
        blocks = blocks + pos[None, None, :, None, :]
        flat = blocks.transpose(0, 1, 3, 2, 4).reshape(bsz, n_cmp, hkv, CMP_BLOCK * hd)
        return jax.nn.gelu(flat @ w1) @ w2

    kc = compress(k_cmp_tok, cmp_pos[0], cmp_w1[0], cmp_w2[0])
    vc = compress(v_cmp_tok, cmp_pos[1], cmp_w1[1], cmp_w2[1])

    n_sel = S // SEL_BLOCK
    topk = min(SEL_TOPK, n_sel)
    ks = k_slc.reshape(bsz, n_sel, SEL_BLOCK, hkv, hd).transpose(0, 3, 1, 2, 4)
    vs = v_slc.reshape(bsz, n_sel, SEL_BLOCK, hkv, hd).transpose(0, 3, 1, 2, 4)

    ratio = SEL_BLOCK // CMP_STRIDE
    front = r - 1
    offs = np.arange(-front, ratio)
    ov_w = jnp.asarray(np.array([max(0, min(SEL_BLOCK, o * CMP_STRIDE + CMP_BLOCK) - max(0, o * CMP_STRIDE))
                                 / CMP_BLOCK for o in offs], dtype=np.float32))
    map_idx = np.arange(n_sel)[:, None] * ratio + offs[None, :] + front
    pad_end = max(0, int(map_idx.max()) + 1 - (n_cmp + front))

    bias_c = rel_bias.reshape(REL_BUCKETS, hkv, g)
    cmp_end = jnp.arange(n_cmp) * CMP_STRIDE + CMP_BLOCK - 1
    sel_start = jnp.arange(n_sel) * SEL_BLOCK
    jj = jnp.arange(n_sel)
    bi = jnp.arange(bsz)[:, None, None, None]
    hi = jnp.arange(hkv)[None, :, None, None]
    hi5 = jnp.arange(hkv)[None, :, None, None, None]
    nblk = S // BLOCK
    qb = q.reshape(bsz, nblk, BLOCK, hkv, g, hd).transpose(1, 0, 2, 3, 4, 5)

    def block_fn(args):
        qn, n = args
        qpos = n * BLOCK + jnp.arange(BLOCK)
        s = jnp.einsum('bqhgd,bchd->bhgqc', qn, kc).astype(jnp.float32) * scale
        valid = cmp_end[None, :] <= qpos[:, None]
        s = jnp.where(valid, s, NEG)
        m = jnp.max(s, axis=-1, keepdims=True)
        e = jnp.where(valid, jnp.exp(s - m), 0.0)
        p = e / jnp.maximum(jnp.sum(e, axis=-1, keepdims=True), 1e-30)
        o_cmp = jnp.einsum('bhgqc,bchd->bqhgd', p.astype(vc.dtype), vc)
        imp = jnp.pad(jnp.sum(p, axis=2), ((0, 0), (0, 0), (0, 0), (front, pad_end)))
        imp_sel = jnp.einsum('bhqjr,r->bhqj', imp[..., map_idx], ov_w)
        cur = qpos // SEL_BLOCK
        sel_valid = sel_start[None, :] <= qpos[:, None]
        forced = (jj[None, :] == 0) | (jj[None, :] == cur[:, None]) | (jj[None, :] == cur[:, None] - 1)
        score = jnp.where(forced, FORCE, jnp.where(sel_valid, imp_sel, NEG))
        _, idx = lax.top_k(score, topk)
        kg = ks[bi, hi, idx]
        vg = vs[bi, hi, idx]
        s2 = jnp.einsum('bqhgd,bhqktd->bhgqkt', qn, kg).astype(jnp.float32) * scale
        kpos = idx[..., None] * SEL_BLOCK + jnp.arange(SEL_BLOCK)
        dist = qpos[None, None, :, None, None] - kpos
        bias = jnp.moveaxis(bias_c[t5_bucket(dist), hi5], -1, 2).astype(jnp.float32)
        s2 = jnp.where((dist >= 0)[:, :, None], s2 + bias, NEG)
        p2 = jax.nn.softmax(s2.reshape(s2.shape[:4] + (topk * SEL_BLOCK,)), axis=-1).reshape(s2.shape)
        o_slc = jnp.einsum('bhgqkt,bhqktd->bqhgd', p2.astype(vg.dtype), vg)
        return o_cmp, o_slc

    o_cmp, o_slc = lax.map(block_fn, (qb, jnp.arange(nblk)))
    o_cmp = o_cmp.transpose(1, 0, 2, 3, 4, 5).reshape(bsz, S, H, hd)
    o_slc = o_slc.transpose(1, 0, 2, 3, 4, 5).reshape(bsz, S, H, hd)
    o_win, _ = banded_attention(q, k_win, v_win, C_WINDOW - 1, rel_bias=rel_bias)
    gt = jax.nn.sigmoid(gates.astype(jnp.float32)).astype(q.dtype)
    return gt[..., 0:1] * o_cmp + gt[..., 1:2] * o_slc + gt[..., 2:3] * o_win


def setup_inputs(seed: int = 0) -> dict:
    key = jax.random.key(seed)
    ks = jax.random.split(key, 16)
    f32 = jnp.float32
    nrm = lambda k, shape, s: jax.random.normal(k, shape, f32) * s
    return {
        "x": nrm(ks[0], (BATCH, SEQ, D_MODEL), 1.0),
        "c": nrm(ks[1], (BATCH, D_MODEL), 1.0),
        "positions": jnp.broadcast_to(jnp.arange(SEQ, dtype=jnp.int32), (BATCH, SEQ)),
        "w_in": nrm(ks[2], (DEPTH, D_MODEL, N_IN), D_MODEL ** -0.5),
        "w_out": nrm(ks[3], (DEPTH, MIX_WIDTH, D_MODEL), DN_BETA * MIX_WIDTH ** -0.5),
        "rel_bias": nrm(ks[4], (REL_BUCKETS, A_HEADS + C_HEADS), 0.2),
        "sinks": nrm(ks[5], (DEPTH, B_HEADS), 1.0),
        "cmp_pos": nrm(ks[6], (DEPTH, 2, CMP_BLOCK, HEAD_DIM), 0.1),
        "cmp_w1": nrm(ks[7], (DEPTH, 2, CMP_BLOCK * HEAD_DIM, CMP_HIDDEN), (CMP_BLOCK * HEAD_DIM) ** -0.5),
        "cmp_w2": nrm(ks[8], (DEPTH, 2, CMP_HIDDEN, HEAD_DIM), CMP_HIDDEN ** -0.5),
        "mlp_w1": nrm(ks[9], (DEPTH, D_MODEL, D_FF), D_MODEL ** -0.5),
        "mlp_w2": nrm(ks[10], (DEPTH, D_FF, D_MODEL), DN_BETA * D_FF ** -0.5),
        "ada_w": nrm(ks[11], (DEPTH, D_MODEL, 6 * D_MODEL), 0.1 * D_MODEL ** -0.5),
        "ada_b": nrm(ks[12], (DEPTH, 6 * D_MODEL), 0.01),
        "ln_g": 1.0 + nrm(ks[13], (DEPTH, 2, D_MODEL), 0.02),
        "ln_b": nrm(ks[14], (DEPTH, 2, D_MODEL), 0.02),
    }


def reference(x, c, positions, w_in, w_out, rel_bias, sinks, cmp_pos, cmp_w1, cmp_w2,
              mlp_w1, mlp_w2, ada_w, ada_b, ln_g, ln_b):
    bsz, seq = x.shape[0], x.shape[1]
    heads = lambda t: t.reshape(bsz, seq, -1, HEAD_DIM)
    bias_a = rel_bias[:, :A_HEADS]
    bias_c = rel_bias[:, A_HEADS:]
    for l in range(DEPTH):
        mod = jax.nn.silu(c) @ ada_w[l] + ada_b[l]
        sh_a, sc_a, g_a, sh_m, sc_m, g_m = [m_[:, None, :] for m_ in jnp.split(mod, 6, axis=-1)]
        h = x * (1 + sc_a) + sh_a
        parts = jnp.split(h @ w_in[l], SPLIT_POINTS, axis=-1)
        aq, ak, av, bq, bk, bv, cq, ckc, cvc, cks, cvs, ckw, cvw = [heads(p) for p in parts[:-1]]
        cg = parts[-1].reshape(bsz, seq, C_HEADS, 3)
        oa = dilated_attention(aq, ak, av, bias_a)
        ob, _ = banded_attention(rope(bq, positions), rope(bk, positions), bv, B_WINDOW - 1, sinks=sinks[l])
        oc = nsa_attention(cq, ckc, cvc, cks, cvs, ckw, cvw, cg, cmp_pos[l], cmp_w1[l], cmp_w2[l], bias_c)
        mixed = jnp.concatenate([oa.reshape(bsz, seq, -1), ob.reshape(bsz, seq, -1),
                                 oc.reshape(bsz, seq, -1)], axis=-1)
        x = layer_norm(DN_ALPHA * x + (1 + g_a) * (mixed @ w_out[l]), ln_g[l, 0], ln_b[l, 0])
        h = x * (1 + sc_m) + sh_m
        f = jnp.square(jax.nn.relu(h @ mlp_w1[l])) @ mlp_w2[l]
        x = layer_norm(DN_ALPHA * x + (1 + g_m) * f, ln_g[l, 1], ln_b[l, 1])
    return x
```

```cpp
#include <hip/hip_runtime.h>
#include <cstdio>
#include <cstdint>
#include <cmath>
namespace pg8 {
#define PG8_LAS __attribute__((address_space(3)))
typedef unsigned short bf16_t;
typedef short bf16x8 __attribute__((ext_vector_type(8)));
typedef float f32x4 __attribute__((ext_vector_type(4)));
typedef unsigned u32x4 __attribute__((ext_vector_type(4)));
constexpr int BM = 256, BK = 64, HALF = 128, HTB = HALF * BK * 2  , STAGE_BYTES = 8 * HTB, NXCD = 8, WGM = 8;

__host__ __device__ __forceinline__ int lds_byte(int r, int c) { const int st = (r >> 4) * 2 + (c >> 5), rr = r & 15, cc = c & 31, ob = rr * 64 + cc * 2; return st * 1024 + (ob ^ (((ob >> 9) & 1) << 5)); }
__host__ __device__ __forceinline__ void stage_rc(int b, int& R, int& C) { const int st = b / 1024, sb = b % 1024, swz = sb ^ (((sb >> 9) & 1) << 5); R = (st >> 1) * 16 + swz / 64; C = (st & 1) * 32 + (swz % 64) / 2; }
__host__ __device__ __forceinline__ int perm32(int rho) { const int n = rho >> 4, i = rho & 15; return 8 * (i >> 2) + 4 * n + (i & 3); }

struct Unit { int pm, pn; };
struct Gemm { const bf16_t* A; const bf16_t* Bt; int M, N, K; };

struct StaticOrder {
    int nM, nN, nwg, G, c;
    __host__ __device__ void init(int M, int N, int G_, int c_) { nM = M / BM; nN = N / BM; nwg = nM * nN; G = G_; c = c_; }
    __host__ __device__ bool next(int i, Unit& u) const {
        const long L = (long)i * G + c; if (L >= nwg) return false;
        int wgid = (int)L; { const int q = nwg / NXCD, r = nwg % NXCD, xcd = wgid % NXCD, off = wgid / NXCD; wgid = (xcd < r ? xcd * (q + 1) : r * (q + 1) + (xcd - r) * q) + off; }
        const int nig = WGM * nN, gid = wgid / nig, fm = gid * WGM, gsz = (nM - fm) < WGM ? (nM - fm) : WGM;
        u.pm = fm + ((wgid % nig) % gsz); u.pn = (wgid % nig) / gsz; return true;
    }
    __device__ __forceinline__ void a_ready(const Unit&) const {}
    __device__ __forceinline__ void done(const Unit&) const {}
};


__device__ __forceinline__ unsigned cvt_pk_bf16(float lo, float hi) { unsigned r; asm volatile("v_cvt_pk_bf16_f32 %0, %1, %2" : "=v"(r) : "v"(lo), "v"(hi)); return r; }
typedef float f32x2 __attribute__((ext_vector_type(2)));

struct EpiInProj {
    static constexpr bool PERM = true, AFTER_DRAIN = false;
    bf16_t* O; int ldc; const float* rope; float qscale;
    __device__ __forceinline__ void operator()(const f32x4 (&acc)[2][2][4][2], const Unit& u, int wr, int wc, int fr, int fq) const {
        const int row0 = u.pm * BM + wr * 64 + fr; const int col0 = u.pn * BM + wc * 32 + 8 * fq;
        const int i0 = 16 * (wc & 1) + 4 * fq;
#pragma unroll
        for (int bj = 0; bj < 2; ++bj) {
            const int pn = u.pn;
            const bool do_rope = (pn == 3) || (pn == 4 && bj == 0);
            const bool do_sig = (pn == 10);
            const float sc = (pn == 0 || pn == 3 || pn == 5 || pn == 6) ? qscale : 1.0f;
#pragma unroll
            for (int ai = 0; ai < 2; ++ai)
#pragma unroll
                for (int m = 0; m < 4; ++m) {
                    const int row = row0 + ai * HALF + m * 16;
                    f32x4 v0 = acc[ai][bj][m][0], v1 = acc[ai][bj][m][1];
                    if (do_rope) {
                        const f32x4* rp = (const f32x4*)(rope + ((size_t)row * 32 + i0) * 2);
                        const f32x4 c01 = rp[0], c23 = rp[1];
                        f32x4 w0, w1;
                        w0[0] = v0[0] * c01[0] - v0[1] * c01[1]; w0[1] = v0[1] * c01[0] + v0[0] * c01[1];
                        w0[2] = v0[2] * c01[2] - v0[3] * c01[3]; w0[3] = v0[3] * c01[2] + v0[2] * c01[3];
                        w1[0] = v1[0] * c23[0] - v1[1] * c23[1]; w1[1] = v1[1] * c23[0] + v1[0] * c23[1];
                        w1[2] = v1[2] * c23[2] - v1[3] * c23[3]; w1[3] = v1[3] * c23[2] + v1[2] * c23[3];
                        v0 = w0; v1 = w1;
                    }
                    if (do_sig) {
#pragma unroll
                        for (int e = 0; e < 4; ++e) { v0[e] = 1.0f / (1.0f + __expf(-v0[e])); v1[e] = 1.0f / (1.0f + __expf(-v1[e])); }
                    }
                    v0 = v0 * sc; v1 = v1 * sc;
                    u32x4 w; w.x = cvt_pk_bf16(v0[0], v0[1]); w.y = cvt_pk_bf16(v0[2], v0[3]); w.z = cvt_pk_bf16(v1[0], v1[1]); w.w = cvt_pk_bf16(v1[2], v1[3]);
                    *(u32x4*)(O + (size_t)row * ldc + col0 + bj * HALF) = w;
                }
        }
    }
};
struct EpiRelu2 {
    static constexpr bool PERM = true, AFTER_DRAIN = false;
    bf16_t* O; int ldc;
    __device__ __forceinline__ void operator()(const f32x4 (&acc)[2][2][4][2], const Unit& u, int wr, int wc, int fr, int fq) const {
        const int row0 = u.pm * BM + wr * 64 + fr; const int col0 = u.pn * BM + wc * 32 + 8 * fq;
#pragma unroll
        for (int ai = 0; ai < 2; ++ai)
#pragma unroll
            for (int m = 0; m < 4; ++m) { bf16_t* rowp = O + (size_t)(row0 + ai * HALF + m * 16) * ldc + col0;
#pragma unroll
                for (int bj = 0; bj < 2; ++bj) { f32x4 v0 = acc[ai][bj][m][0], v1 = acc[ai][bj][m][1];
#pragma unroll
                    for (int e = 0; e < 4; ++e) { const float a = fmaxf(v0[e], 0.f), b = fmaxf(v1[e], 0.f); v0[e] = a * a; v1[e] = b * b; }
                    u32x4 w; w.x = cvt_pk_bf16(v0[0], v0[1]); w.y = cvt_pk_bf16(v0[2], v0[3]); w.z = cvt_pk_bf16(v1[0], v1[1]); w.w = cvt_pk_bf16(v1[2], v1[3]);
                    *(u32x4*)(rowp + bj * HALF) = w; } }
    }
};
struct EpiResid {
    static constexpr bool PERM = false, AFTER_DRAIN = false;
    const float* base; float* out; int ldc; const float* gate; float alpha;
    __device__ __forceinline__ void operator()(const f32x4 (&acc)[2][2][4][2], const Unit& u, int wr, int wc, int fr, int fq) const {
        const int col0 = u.pn * BM + wc * 32 + 4 * fq;
#pragma unroll
        for (int bj = 0; bj < 2; ++bj)
#pragma unroll
            for (int n = 0; n < 2; ++n) { const f32x4 gv = *(const f32x4*)(gate + col0 + bj * HALF + n * 16) + 1.0f;
#pragma unroll
                for (int ai = 0; ai < 2; ++ai)
#pragma unroll
                    for (int m = 0; m < 4; ++m) { const size_t off = (size_t)(u.pm * BM + ai * HALF + wr * 64 + m * 16 + fr) * ldc + col0 + bj * HALF + n * 16;
                        const f32x4 bs = *(const f32x4*)(base + off); *(f32x4*)(out + off) = bs * alpha + gv * acc[ai][bj][m][n]; } }
    }
};
template <class Epi, class Sched, bool ALIGN_EPI = false, bool SP2 = false>
__device__ __forceinline__ void gemm_phase(PG8_LAS unsigned char* lds, const Gemm g, const Sched& S, const Epi& E, const int wid  ) {
    int lane_ = __builtin_amdgcn_mbcnt_hi(~0u, __builtin_amdgcn_mbcnt_lo(~0u, 0u)); asm volatile("" : "+v"(lane_));
    const int lane = lane_, tid = wid * 64 + lane, wr = wid >> 2, wc = wid & 3, fr = lane & 15, fq = lane >> 4;
    const int K = g.K, nt = K / BK;
    unsigned voffA[2], voffB[2];
#pragma unroll
    for (int i = 0; i < 2; ++i) { int R, C; stage_rc(tid * 16 + i * 8192, R, C); const int Rb = Epi::PERM ? ((R & ~31) + perm32(R & 31)) : R;
        voffA[i] = (unsigned)(R * K + C) * 2u; voffB[i] = (unsigned)(Rb * K + C) * 2u; }
    const size_t kstep = (size_t)(BK * 2);
    const size_t hstep = (size_t)HALF * K * 2;
    const size_t tstep = 2 * hstep;
    const unsigned ldsw = (unsigned)wid * 1024u;
    const int aoff = lds_byte(wr * 64 + fr, fq * 8), boff = lds_byte(wc * 32 + fr, fq * 8);
#define PG8_SA(b, h) (((b) * 2 + (h)) * HTB)
#define PG8_SB(b, h) ((4 + (b) * 2 + (h)) * HTB)
#define PG8_STAGE(bufoff, gbase, voff) do { _Pragma("unroll") for (int _i = 0; _i < 2; ++_i) \
        __builtin_amdgcn_global_load_lds((const unsigned*)((const char*)(gbase) + (voff)[_i]), (PG8_LAS unsigned*)(lds + (bufoff) + ldsw + _i * 8192), 16, 0, 0); } while (0)
#define PG8_LDA(dst, b, h) do { _Pragma("unroll") for (int m = 0; m < 4; ++m) _Pragma("unroll") for (int k = 0; k < 2; ++k) dst[m][k] = *(const PG8_LAS bf16x8*)(lds + PG8_SA(b, h) + aoff + m * 2048 + k * 1024); } while (0)
#define PG8_LDB(dst, b, h) do { _Pragma("unroll") for (int n = 0; n < 2; ++n) _Pragma("unroll") for (int k = 0; k < 2; ++k) dst[n][k] = *(const PG8_LAS bf16x8*)(lds + PG8_SB(b, h) + boff + n * 2048 + k * 1024); } while (0)
#define PG8_MMA(ai, bj, At, Bt) do { __builtin_amdgcn_s_setprio(1); _Pragma("unroll") for (int m = 0; m < 4; ++m) _Pragma("unroll") for (int n = 0; n < 2; ++n) _Pragma("unroll") for (int k = 0; k < 2; ++k) \
        acc[ai][bj][m][n] = __builtin_amdgcn_mfma_f32_16x16x32_bf16(Bt[n][k], At[m][k], acc[ai][bj][m][n], 0, 0, 0); __builtin_amdgcn_s_setprio(0); } while (0)
#define PG8_WAIT_V(n) asm volatile("s_waitcnt vmcnt(" #n ")" ::: "memory")
#define PG8_WAIT_L(n) asm volatile("s_waitcnt lgkmcnt(" #n ")" ::: "memory")
#define PG8_BAR __builtin_amdgcn_s_barrier()
#define PG8_SCHED __builtin_amdgcn_sched_barrier(0)
    Unit cur, nxt; int ui = 0;
    if (!S.next(0, cur)) return;
    f32x4 acc[2][2][4][2];
#pragma unroll
    for (int a = 0; a < 2; ++a)
#pragma unroll
        for (int b = 0; b < 2; ++b)
#pragma unroll
            for (int m = 0; m < 4; ++m)
#pragma unroll
                for (int n = 0; n < 2; ++n) acc[a][b][m][n] = (f32x4){0.f, 0.f, 0.f, 0.f};
    bf16x8 At[4][2], B0[2][2], B1[2][2];
    const char* cA = (const char*)g.A + (size_t)cur.pm * tstep; const char* cB = (const char*)g.Bt + (size_t)cur.pn * tstep;
    S.a_ready(cur);
    if constexpr (SP2) {
        PG8_STAGE(PG8_SB(0, 0), cB, voffB); PG8_STAGE(PG8_SB(0, 1), cB + hstep, voffB); PG8_STAGE(PG8_SA(0, 0), cA, voffA); PG8_STAGE(PG8_SA(0, 1), cA + hstep, voffA);
        if (wr == 1) PG8_BAR;
        PG8_WAIT_V(2); PG8_BAR;
        PG8_STAGE(PG8_SB(1, 0), cB + kstep, voffB); PG8_STAGE(PG8_SA(1, 0), cA + kstep, voffA); PG8_STAGE(PG8_SB(1, 1), cB + hstep + kstep, voffB);
        PG8_WAIT_V(6); PG8_BAR;
    } else {
        PG8_STAGE(PG8_SB(0, 0), cB, voffB); PG8_STAGE(PG8_SA(0, 0), cA, voffA); PG8_STAGE(PG8_SB(0, 1), cB + hstep, voffB); PG8_STAGE(PG8_SA(0, 1), cA + hstep, voffA);
        if (wr == 1) PG8_BAR;
        PG8_WAIT_V(4); PG8_BAR;
        PG8_STAGE(PG8_SB(1, 0), cB + kstep, voffB); PG8_STAGE(PG8_SA(1, 0), cA + kstep, voffA); PG8_STAGE(PG8_SB(1, 1), cB + hstep + kstep, voffB);
        PG8_WAIT_V(6); PG8_BAR;
    }
    for (;;) {
        const bool has_next = S.next(ui + 1, nxt);
        const char* nA = has_next ? (const char*)g.A + (size_t)nxt.pm * tstep : cA; const char* nB = has_next ? (const char*)g.Bt + (size_t)nxt.pn * tstep : cB;
        for (int t = 0; t < nt; t += 2) {
            const bool last = (t == nt - 2);
            const char* a1 = cA + (size_t)(t + 1) * kstep;
            const char* a2 = last ? nA : cA + (size_t)(t + 2) * kstep; const char* b2 = last ? nB : cB + (size_t)(t + 2) * kstep;
            const char* a3 = a2 + kstep; const char* b3 = b2 + kstep;
            if (last && has_next) S.a_ready(nxt);
            if constexpr (SP2) {
            PG8_LDB(B0, 0, 0); PG8_LDB(B1, 0, 1); PG8_SCHED; PG8_LDA(At, 0, 0); PG8_STAGE(PG8_SA(1, 1), a1 + hstep, voffA);
            PG8_WAIT_V(8); PG8_WAIT_L(0); PG8_BAR; PG8_MMA(0, 0, At, B0); PG8_MMA(0, 1, At, B1); PG8_BAR; PG8_SCHED;
            PG8_LDA(At, 0, 1); PG8_STAGE(PG8_SB(0, 0), b2, voffB); PG8_STAGE(PG8_SB(0, 1), b2 + hstep, voffB); PG8_STAGE(PG8_SA(0, 0), a2, voffA);
            PG8_WAIT_V(8); PG8_WAIT_L(0); PG8_BAR; PG8_MMA(1, 0, At, B0); PG8_MMA(1, 1, At, B1); PG8_BAR; PG8_SCHED;
            PG8_LDB(B0, 1, 0); PG8_LDB(B1, 1, 1); PG8_SCHED; PG8_LDA(At, 1, 0); PG8_STAGE(PG8_SA(0, 1), a2 + hstep, voffA);
            PG8_WAIT_V(8); PG8_WAIT_L(0); PG8_BAR; PG8_MMA(0, 0, At, B0); PG8_MMA(0, 1, At, B1); PG8_BAR; PG8_SCHED;
            PG8_LDA(At, 1, 1); PG8_STAGE(PG8_SB(1, 0), b3, voffB); PG8_STAGE(PG8_SB(1, 1), b3 + hstep, voffB); PG8_STAGE(PG8_SA(1, 0), a3, voffA);
            PG8_WAIT_V(8); PG8_WAIT_L(0); PG8_BAR; PG8_MMA(1, 0, At, B0); PG8_MMA(1, 1, At, B1); PG8_BAR; PG8_SCHED;
            } else {
            PG8_LDB(B0, 0, 0); PG8_SCHED; PG8_LDA(At, 0, 0); PG8_STAGE(PG8_SA(1, 1), a1 + hstep, voffA);
            PG8_WAIT_L(8); PG8_BAR; PG8_WAIT_L(0); PG8_MMA(0, 0, At, B0); PG8_BAR; PG8_SCHED;
            PG8_LDB(B1, 0, 1); PG8_STAGE(PG8_SB(0, 0), b2, voffB);
            PG8_BAR; PG8_WAIT_L(0); PG8_MMA(0, 1, At, B1); PG8_BAR;
            PG8_LDA(At, 0, 1); PG8_STAGE(PG8_SA(0, 0), a2, voffA);
            PG8_BAR; PG8_WAIT_L(0); PG8_MMA(1, 0, At, B0); PG8_BAR; PG8_SCHED;
            PG8_STAGE(PG8_SB(0, 1), b2 + hstep, voffB);
            PG8_WAIT_V(6); PG8_BAR; PG8_MMA(1, 1, At, B1); PG8_BAR;
            PG8_LDB(B0, 1, 0); PG8_SCHED; PG8_LDA(At, 1, 0); PG8_STAGE(PG8_SA(0, 1), a2 + hstep, voffA);
            PG8_WAIT_L(8); PG8_BAR; PG8_WAIT_L(0); PG8_MMA(0, 0, At, B0); PG8_BAR; PG8_SCHED;
            PG8_LDB(B1, 1, 1); PG8_STAGE(PG8_SB(1, 0), b3, voffB);
            PG8_BAR; PG8_WAIT_L(0); PG8_MMA(0, 1, At, B1); PG8_BAR;
            PG8_LDA(At, 1, 1); PG8_STAGE(PG8_SA(1, 0), a3, voffA);
            PG8_BAR; PG8_WAIT_L(0); PG8_MMA(1, 0, At, B0); PG8_BAR; PG8_SCHED;
            PG8_STAGE(PG8_SB(1, 1), b3 + hstep, voffB);
            PG8_WAIT_V(6); PG8_BAR; PG8_MMA(1, 1, At, B1); PG8_BAR;
            }
        }
        if constexpr (ALIGN_EPI) { if (wr == 0) PG8_BAR; }
        if constexpr (!Epi::AFTER_DRAIN) { E(acc, cur, wr, wc, fr, fq); S.done(cur); }
        if (!has_next) break;
#pragma unroll
        for (int a = 0; a < 2; ++a)
#pragma unroll
            for (int b = 0; b < 2; ++b)
#pragma unroll
                for (int m = 0; m < 4; ++m)
#pragma unroll
                    for (int n = 0; n < 2; ++n) acc[a][b][m][n] = (f32x4){0.f, 0.f, 0.f, 0.f};
        cur = nxt; cA = nA; cB = nB; ++ui;
        if constexpr (ALIGN_EPI) { if (wr == 1) PG8_BAR; }
    }
    PG8_WAIT_V(0);
    if constexpr (!ALIGN_EPI) { if (wr == 0) PG8_BAR; }
    PG8_BAR;
    if constexpr (Epi::AFTER_DRAIN) { E.fused(acc, cur, wr, wc, fr, fq, lds, wid, lane); S.done(cur); }
#undef PG8_SA
#undef PG8_SB
#undef PG8_STAGE
#undef PG8_LDA
#undef PG8_LDB
#undef PG8_MMA
#undef PG8_WAIT_V
#undef PG8_WAIT_L
#undef PG8_BAR
#undef PG8_SCHED
}
}

#ifndef PG8_SP2
#define PG8_SP2 true
#endif
#ifndef PG8_ALIGN
#define PG8_ALIGN true
#endif

constexpr int S = 16384, DM = 1024, NIN = 2584, NINP = 2816, DFF = 4096, DEPTH = 4;
constexpr int NWAVES = 8, NTHREADS = 512;
constexpr float LN_EPS = 1e-5f;
constexpr float LOG2E = 1.4426950408889634f;
constexpr float QSCALE = 0.125f * LOG2E;
constexpr float DN_ALPHA = 1.681792830507429f;
constexpr int C_AQ = 0, C_AK = 256, C_AV = 512, C_BQ = 768, C_BK = 1024, C_BV = 1152, C_CQ = 1280, C_CKC = 1792, C_CVC = 1920,
              C_CKS = 2048, C_CVS = 2176, C_CKW = 2304, C_CVW = 2432, C_CG = 2560;
constexpr int NCMP = 1023, NSEL = 256;
constexpr int BIASLEN = 2048;

constexpr size_t MiB = 1u << 20;
constexpr size_t WS_CTL = 0, CTL_ZERO_BYTES = 1 * MiB;
constexpr size_t WS_MOD = 1 * MiB;
constexpr size_t WS_BIAS = 1 * MiB + 128 * 1024;
constexpr size_t WS_ROPE = 2 * MiB;
constexpr size_t WS_KC = 6 * MiB, WS_VC = 6 * MiB + 512 * 1024;
constexpr size_t WS_WIN = 8 * MiB;
constexpr size_t WS_WOUT = 30 * MiB;
constexpr size_t WS_W1 = 38 * MiB;
constexpr size_t WS_W2 = 70 * MiB;
constexpr size_t WS_CW1 = 102 * MiB;
constexpr size_t WS_RA = 110 * MiB, WS_RB = 142 * MiB;
constexpr size_t WS_BIG = 174 * MiB;
constexpr size_t WS_OWIN = 302 * MiB;
constexpr size_t WS_END = 318 * MiB;

#define GAS __attribute__((address_space(1)))
#define LAS __attribute__((address_space(3)))
typedef unsigned short bf16;
typedef unsigned v4u __attribute__((ext_vector_type(4)));
typedef unsigned v2u __attribute__((ext_vector_type(2)));
typedef float f32x4 __attribute__((ext_vector_type(4)));
typedef float f32x2 __attribute__((ext_vector_type(2)));
#define LDS_WAIT() asm volatile("s_waitcnt lgkmcnt(0)" ::: "memory")
#define VM_WAIT() asm volatile("s_waitcnt vmcnt(0)" ::: "memory")
__device__ __forceinline__ unsigned f2bf(float f) { unsigned u = __builtin_bit_cast(unsigned, f); return (u + 0x7fffu + ((u >> 16) & 1u)) >> 16; }
__device__ __forceinline__ unsigned pk2(float lo, float hi) { return f2bf(lo) | (f2bf(hi) << 16); }
__device__ __forceinline__ float bf2f(unsigned short b) { return __uint_as_float((unsigned)b << 16); }
__device__ __forceinline__ float bflo(unsigned w) { return __uint_as_float(w << 16); }
__device__ __forceinline__ float bfhi(unsigned w) { return __uint_as_float(w & 0xffff0000u); }
__device__ __forceinline__ float wave_sum(float v) {
#pragma unroll
    for (int o = 1; o < 64; o <<= 1) v += __shfl_xor(v, o);
    return v;
}
__device__ __forceinline__ float wave_max(float v) {
#pragma unroll
    for (int o = 1; o < 64; o <<= 1) v = fmaxf(v, __shfl_xor(v, o));
    return v;
}

constexpr int RING_BYTES = 131072;
constexpr int LDSCTL_OFF = RING_BYTES, MISC_OFF = LDSCTL_OFF + 320;
constexpr int LDS_BYTES = 147456;

struct Args { const float* in[16]; float* out; unsigned char* ws; int ph_lo, ph_hi; };

struct Frame {
    LAS unsigned char* lds;
    int tid, lane, wave, G, vcu;
    unsigned char* ws;
    const float* in[16];
    float* out;
};
enum { I_X = 0, I_C, I_POS, I_WIN, I_WOUT, I_RELB, I_SINK, I_CPOS, I_CW1, I_CW2, I_MW1, I_MW2, I_ADAW, I_ADAB, I_LNG, I_LNB };

__device__ __forceinline__ int t5_bucket(int d) {
    if (d < 16) return d;
    int b = 16;
    b += d >= 22; b += d >= 30; b += d >= 40; b += d >= 54; b += d >= 73; b += d >= 99; b += d >= 134; b += d >= 182;
    b += d >= 246; b += d >= 332; b += d >= 450; b += d >= 609; b += d >= 825; b += d >= 1117; b += d >= 1513;
    return b;
}
__device__ const float ROPE_FREQ[32] = {1.000000000e+00f, 6.890442967e-01f, 4.747820497e-01f, 3.271458745e-01f, 2.254180014e-01f, 1.553229839e-01f, 1.070244238e-01f, 7.374456525e-02f,
    5.081327632e-02f, 3.501259908e-02f, 2.412523143e-02f, 1.662335359e-02f, 1.145422645e-02f, 7.892469876e-03f, 5.438261200e-03f, 3.747202922e-03f,
    2.581988927e-03f, 1.779104699e-03f, 1.225881977e-03f, 8.446869906e-04f, 5.820267834e-04f, 4.010422272e-04f, 2.763358643e-04f, 1.904076635e-04f,
    1.311993110e-04f, 9.040213627e-05f, 6.229108112e-05f, 4.292131416e-05f, 2.957468678e-05f, 2.037826926e-05f, 1.404153045e-05f, 9.675236470e-06f};
__device__ __forceinline__ void sincos_f(float a, float& c, float& s) {
    const float n = rintf(a * 0.636619772367581343f);
    float r = fmaf(-n, 1.5703125f, a); r = fmaf(-n, 0.0004838267923332751f, r); r = fmaf(-n, 2.5632829192545614e-12f, r);
    const float r2 = r * r;
    const float sp = fmaf(r * r2, fmaf(r2, fmaf(r2, fmaf(r2, 2.755731922e-6f, -1.984126984e-4f), 8.333333333e-3f), -1.666666667e-1f), r);
    const float cp = fmaf(r2, fmaf(r2, fmaf(r2, fmaf(r2, fmaf(r2, -2.755731922e-7f, 2.480158730e-5f), -1.388888889e-3f), 4.166666667e-2f), -0.5f), 1.0f);
    const int q = ((int)n) & 3;
    c = (q == 0) ? cp : (q == 1) ? -sp : (q == 2) ? -cp : sp;
    s = (q == 0) ? sp : (q == 1) ? cp : (q == 2) ? -sp : -cp;
}

template <int MODE>
__device__ __forceinline__ int colmap(int n) {
    if (MODE == 0) return n;
    if (n >= NIN) return -1;
    if (n >= C_BQ && n < C_BV) { const int hb = n & ~63, j = n & 63; return hb + (j >> 1) + 32 * (j & 1); }
    return n;
}
template <int MODE>
__device__ __forceinline__ void transpose_item(const float* W, int K, int N, int NP, bf16* WT, LAS float* scr, int item, int lane) {
    const int nblk = NP / 32, kb = item / nblk, nb = item % nblk, k0 = 64 * kb, n0 = 32 * nb;
    const int src = colmap<MODE>(n0 + (lane & 31));
#pragma unroll 8
    for (int i = 0; i < 32; ++i) { const int kk = 2 * i + (lane >> 5); scr[kk * 33 + (lane & 31)] = src >= 0 ? W[(size_t)(k0 + kk) * N + src] : 0.f; }
    LDS_WAIT(); asm volatile("" ::: "memory");
    const int c = lane & 7;
#pragma unroll
    for (int j = 0; j < 4; ++j) { const int n = (lane >> 3) + 8 * j; const LAS float* s = scr + (8 * c) * 33 + n;
        v4u o; o.x = pk2(s[0 * 33], s[1 * 33]); o.y = pk2(s[2 * 33], s[3 * 33]); o.z = pk2(s[4 * 33], s[5 * 33]); o.w = pk2(s[6 * 33], s[7 * 33]);
        *(v4u*)(WT + (size_t)(n0 + n) * K + k0 + 8 * c) = o; }
    LDS_WAIT(); asm volatile("" ::: "memory");
}

__device__ __forceinline__ void p0_prologue(Frame& F) {
    LAS float* scr = (LAS float*)(F.lds + F.wave * 16384);
    const int gw = F.vcu * NWAVES + F.wave, NGW = F.G * NWAVES;
    constexpr int I_IN = (DM / 64) * (NINP / 32), I_OUT = (DM / 64) * (DM / 32), I_1 = (DM / 64) * (DFF / 32), I_2 = (DFF / 64) * (DM / 32);
    constexpr int PER_LAYER = I_IN + I_OUT + I_1 + I_2;
    for (int it = gw; it < DEPTH * PER_LAYER; it += NGW) {
        const int l = it / PER_LAYER; int r = it % PER_LAYER;
        if (r < I_IN) { transpose_item<1>(F.in[I_WIN] + (size_t)l * DM * NIN, DM, NIN, NINP, (bf16*)(F.ws + WS_WIN) + (size_t)l * NINP * DM, scr, r, F.lane); continue; } r -= I_IN;
        if (r < I_OUT) { transpose_item<0>(F.in[I_WOUT] + (size_t)l * DM * DM, DM, DM, DM, (bf16*)(F.ws + WS_WOUT) + (size_t)l * DM * DM, scr, r, F.lane); continue; } r -= I_OUT;
        if (r < I_1) { transpose_item<0>(F.in[I_MW1] + (size_t)l * DM * DFF, DM, DFF, DFF, (bf16*)(F.ws + WS_W1) + (size_t)l * DFF * DM, scr, r, F.lane); continue; } r -= I_1;
        transpose_item<0>(F.in[I_MW2] + (size_t)l * DFF * DM, DFF, DM, DM, (bf16*)(F.ws + WS_W2) + (size_t)l * DM * DFF, scr, r, F.lane);
    }
    {
        __syncthreads();
        LAS float* red = (LAS float*)F.lds;
        const int nl = F.tid & 63, kp = F.tid >> 6;
        for (int it = F.vcu; it < DEPTH * 96; it += F.G) {
            const int l = it / 96, n = (it % 96) * 64 + nl;
            const float* w = F.in[I_ADAW] + (size_t)l * DM * 6144 + n;
            const float* c = F.in[I_C];
            float a = 0.f;
#pragma unroll 8
            for (int k = kp * 128; k < kp * 128 + 128; ++k) { const float cv = c[k]; a += (cv / (1.0f + __expf(-cv))) * w[(size_t)k * 6144]; }
            red[kp * 64 + nl] = a;
            __syncthreads();
            if (kp == 0) { float s = F.in[I_ADAB][l * 6144 + n];
#pragma unroll
                for (int j = 0; j < 8; ++j) s += red[j * 64 + nl];
                ((float*)(F.ws + WS_MOD))[l * 6144 + n] = s; }
            __syncthreads();
        }
    }
    {
        const int gt = F.vcu * NTHREADS + F.tid, NGT = F.G * NTHREADS;
        const int* pos = (const int*)F.in[I_POS];
        f32x2* rt = (f32x2*)(F.ws + WS_ROPE);
        for (int e = gt; e < S * 32; e += NGT) {
            const int r = e >> 5, i = e & 31;
            const float ang = (float)pos[r] * ROPE_FREQ[i];
            float cs, sn; sincos_f(ang, cs, sn);
            rt[e] = (f32x2){cs, sn};
        }
        float* bt = (float*)(F.ws + WS_BIAS);
        for (int e = gt; e < 12 * BIASLEN; e += NGT) {
            const int h = e / BIASLEN, d = e % BIASLEN;
            bt[e] = F.in[I_RELB][t5_bucket(d) * 12 + h] * LOG2E;
        }
    }
}

template <int MODE>
__device__ __forceinline__ void row_pass(Frame& F, const float* xin, float* xout, bf16* H, const float* lng, const float* lnb, const float* sc, const float* sh) {
    const int gw = F.vcu * NWAVES + F.wave, NGW = F.G * NWAVES;
    for (int m = gw; m < S; m += NGW) {
        const f32x4* xr = (const f32x4*)(xin + (size_t)m * DM) + F.lane;
        f32x4 v[4];
#pragma unroll
        for (int j = 0; j < 4; ++j) v[j] = xr[64 * j];
        if (MODE != 0) {
            float s = 0.f;
#pragma unroll
            for (int j = 0; j < 4; ++j) s += (v[j].x + v[j].y) + (v[j].z + v[j].w);
            const float mean = wave_sum(s) * (1.f / DM); float s2 = 0.f;
#pragma unroll
            for (int j = 0; j < 4; ++j) { v[j] = v[j] - mean; s2 += (v[j].x * v[j].x + v[j].y * v[j].y) + (v[j].z * v[j].z + v[j].w * v[j].w); }
            const float rstd = 1.f / sqrtf(wave_sum(s2) * (1.f / DM) + LN_EPS);
            f32x4* xo = (f32x4*)(xout + (size_t)m * DM) + F.lane;
#pragma unroll
            for (int j = 0; j < 4; ++j) { const f32x4 g = ((const f32x4*)lng)[F.lane + 64 * j], b = ((const f32x4*)lnb)[F.lane + 64 * j]; v[j] = v[j] * rstd * g + b; xo[64 * j] = v[j]; }
        }
        if (MODE != 2) {
            v2u* o8 = (v2u*)(H + (size_t)m * DM) + F.lane;
#pragma unroll
            for (int j = 0; j < 4; ++j) { const f32x4 a = ((const f32x4*)sc)[F.lane + 64 * j] + 1.0f, b = ((const f32x4*)sh)[F.lane + 64 * j]; const f32x4 h = v[j] * a + b;
                o8[64 * j] = (v2u){pk2(h.x, h.y), pk2(h.z, h.w)}; }
        }
    }
}

typedef GAS unsigned gu32;
typedef GAS unsigned long long gu64;
#define RLX_AGENT __ATOMIC_RELAXED, __HIP_MEMORY_SCOPE_AGENT
__device__ __forceinline__ unsigned long long rt() { return __builtin_amdgcn_s_memrealtime(); }

#define XB_TMO      128
#define XB_XCNT(j)  (256  + 64 * (j))
#define XB_XSUB(j)  (1280 + 64 * (j))
#define XB_XGEN(j)  (2304 + 64 * (j))
#define XB_TOP      3328
#define XB_TOPGEN   3392
#define XCD_BAR_WORDS 3456
#define XB_SPIN_CAP (1u << 18)

__device__ __forceinline__ unsigned xb_ld(unsigned* p)              { return __hip_atomic_load(p, __ATOMIC_RELAXED, __HIP_MEMORY_SCOPE_AGENT); }
__device__ __forceinline__ unsigned xb_add(unsigned* p, unsigned v) { return __hip_atomic_fetch_add(p, v, __ATOMIC_RELAXED, __HIP_MEMORY_SCOPE_AGENT); }
__device__ __forceinline__ unsigned xb_xcc_id() { return (unsigned)__builtin_amdgcn_s_getreg((3 << 11) | 20) & 0xFu; }
#define XB_SPIN(cond, bar) do { unsigned _sp = 0; while (cond) { __builtin_amdgcn_s_sleep(1); \
    if ((++_sp & 255u) == 0u) { if (xb_ld(&(bar)[XB_TMO])) break; if (_sp > XB_SPIN_CAP) { atomicAdd(&(bar)[XB_TMO], 1u); break; } } } } while (0)

struct XcdBarrier {
    unsigned* bar; unsigned x;
    volatile LAS unsigned* st;
};

__device__ __forceinline__ XcdBarrier xcd_barrier_post(unsigned* bar, volatile LAS unsigned* st) {
    XcdBarrier b; b.bar = bar; b.x = xb_xcc_id(); b.st = st;
    if (threadIdx.x == 0) (void)xb_add(&bar[XB_XCNT(b.x)], 1u);
    return b;
}
__device__ __forceinline__ void xcd_barrier_complete(unsigned* bar, unsigned x, unsigned& nloc, unsigned& nx) {
    const unsigned G = gridDim.x * gridDim.y * gridDim.z;
    unsigned sum, cnt, mine, sp = 0u;
    for (;;) {
        sum = 0u; cnt = 0u; mine = 0u;
#pragma unroll
        for (unsigned j = 0; j < 16; ++j) { const unsigned c = xb_ld(&bar[XB_XCNT(j)]); sum += c; cnt += (c > 0u) ? 1u : 0u; mine = (j == x) ? c : mine; }
        if (sum == G) break;
        __builtin_amdgcn_s_sleep(1);
        if ((++sp & 255u) == 0u) { if (xb_ld(&bar[XB_TMO])) break; if (sp > XB_SPIN_CAP) { atomicAdd(&bar[XB_TMO], 1u); break; } }
    }
    nloc = mine > 0u ? mine : 1u; nx = cnt > 0u ? cnt : 1u;
}

__device__ __forceinline__ void xcd_barrier(const XcdBarrier& b) {
    asm volatile("s_waitcnt vmcnt(0)" ::: "memory");
    __syncthreads();
    if (threadIdx.x == 0) {
        unsigned* bar = b.bar;
        __builtin_amdgcn_s_waitcnt(0);
        unsigned nloc = b.st[0], nx = b.st[1];
        if (nloc == 0u) { xcd_barrier_complete(bar, b.x, nloc, nx); b.st[0] = nloc; b.st[1] = nx; }
        const unsigned old = xb_add(&bar[XB_XSUB(b.x)], 1u);
        const unsigned gen = old / nloc;
        if (old + 1u == (gen + 1u) * nloc) {
            __builtin_amdgcn_fence(__ATOMIC_RELEASE, "agent");
            asm volatile("s_waitcnt vmcnt(0)" ::: "memory");
            const unsigned og = xb_add(&bar[XB_TOP], 1u);
            const unsigned tg = og / nx;
            if (og + 1u == (tg + 1u) * nx) xb_add(&bar[XB_TOPGEN], 1u);
            else XB_SPIN(xb_ld(&bar[XB_TOPGEN]) == tg, bar);
            __builtin_amdgcn_fence(__ATOMIC_ACQUIRE, "agent");
            xb_add(&bar[XB_XGEN(b.x)], 1u);
            asm volatile("s_waitcnt vmcnt(0)" ::: "memory");
        } else {
            XB_SPIN(xb_ld(&bar[XB_XGEN(b.x)]) == gen, bar);
            __builtin_amdgcn_fence(__ATOMIC_ACQUIRE, "agent");
            asm volatile("s_waitcnt vmcnt(0)" ::: "memory");
        }
    }
    __syncthreads();
}


__device__ __forceinline__ float ld_elem(const bf16* p) { return bf2f(*p); }
__device__ __forceinline__ float ld_elem(const float* p) { return *p; }
template <int G>
__device__ __forceinline__ void dot64(const bf16* k, const LAS float* qs, float (&s)[G]) {
    const v4u* kp = (const v4u*)k;
#pragma unroll 2
    for (int c = 0; c < 8; ++c) { const v4u w = kp[c];
        float kv[8] = {bflo(w.x), bfhi(w.x), bflo(w.y), bfhi(w.y), bflo(w.z), bfhi(w.z), bflo(w.w), bfhi(w.w)};
#pragma unroll
        for (int g = 0; g < G; ++g) { const LAS f32x4* q4 = (const LAS f32x4*)(qs + g * 64 + c * 8); const f32x4 a = q4[0], b = q4[1];
            s[g] += kv[0] * a.x + kv[1] * a.y + kv[2] * a.z + kv[3] * a.w + kv[4] * b.x + kv[5] * b.y + kv[6] * b.z + kv[7] * b.w; } }
}
template <int G>
__device__ __forceinline__ void dot64(const float* k, const LAS float* qs, float (&s)[G]) {
    const f32x4* kp = (const f32x4*)k;
#pragma unroll 2
    for (int c = 0; c < 16; ++c) { const f32x4 w = kp[c];
#pragma unroll
        for (int g = 0; g < G; ++g) { const f32x4 a = *(const LAS f32x4*)(qs + g * 64 + c * 4); s[g] += w.x * a.x + w.y * a.y + w.z * a.z + w.w * a.w; } }
}
template <int G, class KT, class KeyFn>
__device__ __forceinline__ void wave_attend(const KT* K, const KT* V, const LAS float* qs, int nk, const KeyFn& kf, float (&m)[G], float (&l)[G], float (&o)[G], int lane) {
    for (int base = 0; base < nk; base += 64) {
        const int i = base + lane;
        long off = 0; float s[G], p[G];
#pragma unroll
        for (int g = 0; g < G; ++g) s[g] = 0.f;
        bool valid = false;
        if (i < nk) valid = kf(i, off, s);
        const LAS float* qo = qs; asm volatile("" : "+v"(qo));
        if (valid) dot64<G>(K + off, qo, s);
        const unsigned long long mask = __ballot(valid);
        if (mask == 0ull) continue;
#pragma unroll
        for (int g = 0; g < G; ++g) {
            const float sv = valid ? s[g] : -1e30f;
            const float mn = fmaxf(m[g], wave_max(sv));
            const float scl = exp2f(m[g] - mn);
            p[g] = valid ? exp2f(sv - mn) : 0.f;
            l[g] = l[g] * scl + wave_sum(p[g]); o[g] *= scl; m[g] = mn;
        }
#pragma unroll 2
        for (int j = 0; j < 64; ++j) {
            if (!((mask >> j) & 1ull)) continue;
            const unsigned olo = __builtin_amdgcn_readlane((unsigned)(unsigned long long)off, j), ohi = __builtin_amdgcn_readlane((unsigned)((unsigned long long)off >> 32), j);
            const long oj = (long)(((unsigned long long)ohi << 32) | olo);
            const float v = ld_elem(V + oj + lane);
#pragma unroll
            for (int g = 0; g < G; ++g) o[g] += __uint_as_float(__builtin_amdgcn_readlane(__float_as_uint(p[g]), j)) * v;
        }
    }
}

struct KeyA { int p, r; const float* bias; __device__ __forceinline__ bool operator()(int i, long& off, float (&b)[1]) const {
    const int row = p - r * i; if (row < 0) return false; off = (long)row * NINP; const int d = r * i; b[0] = bias[d < BIASLEN ? d : BIASLEN - 1]; return true; } };
struct KeyB { int p; __device__ __forceinline__ bool operator()(int i, long& off, float (&b)[2]) const {
    const int row = p - i; if (row < 0) return false; off = (long)row * NINP; return true; } };
struct KeyW { int p; const float* bias; __device__ __forceinline__ bool operator()(int i, long& off, float (&b)[4]) const {
    const int row = p - i; if (row < 0) return false; off = (long)row * NINP;
#pragma unroll
    for (int g = 0; g < 4; ++g) b[g] = bias[g * BIASLEN + i]; return true; } };

__device__ __forceinline__ void load_q(const bf16* q, LAS float* qs, int lane) { qs[lane] = bf2f(q[lane]); }

__device__ __forceinline__ void p2_token_attention(Frame& F, int layer, const bf16* PROJ, bf16* MIXED, bf16* OWIN) {
    LAS float* qs = (LAS float*)(F.lds + F.wave * 2048);
    const int gw = F.vcu * NWAVES + F.wave, NGW = F.G * NWAVES, lane = F.lane;
    const float* bias2 = (const float*)(F.ws + WS_BIAS);
    for (int it = gw; it < S * 4; it += NGW) {
        const int p = it >> 2, h = it & 3;
        load_q(PROJ + (size_t)p * NINP + C_AQ + h * 64, qs, lane); LDS_WAIT(); asm volatile("" ::: "memory");
        float m[1] = {-1e30f}, l[1] = {0.f}, o[1] = {0.f};
        const bf16* K = PROJ + C_AK + h * 64; const bf16* V = PROJ + C_AV + h * 64;
#pragma unroll 1
        for (int c = 0; c < 3; ++c) { const int r = c == 0 ? 1 : (c == 1 ? 4 : 16); KeyA kf{p, r, bias2 + h * BIASLEN}; wave_attend<1>(K, V, qs, 129, kf, m, l, o, lane); }
        MIXED[(size_t)p * DM + h * 64 + lane] = (bf16)f2bf(o[0] / l[0]);
        LDS_WAIT(); asm volatile("" ::: "memory");
    }
    for (int it = gw; it < S * 2; it += NGW) {
        const int p = it >> 1, kvh = it & 1;
        load_q(PROJ + (size_t)p * NINP + C_BQ + (2 * kvh) * 64, qs, lane); load_q(PROJ + (size_t)p * NINP + C_BQ + (2 * kvh + 1) * 64, qs + 64, lane); LDS_WAIT(); asm volatile("" ::: "memory");
        float m[2] = {-1e30f, -1e30f}, l[2] = {0.f, 0.f}, o[2] = {0.f, 0.f};
        KeyB kf{p}; wave_attend<2>(PROJ + C_BK + kvh * 64, PROJ + C_BV + kvh * 64, qs, 128, kf, m, l, o, lane);
#pragma unroll
        for (int g = 0; g < 2; ++g) { const float sk = F.in[I_SINK][layer * 4 + 2 * kvh + g] * LOG2E; const float mn = fmaxf(m[g], sk); const float scl = exp2f(m[g] - mn);
            const float den = l[g] * scl + exp2f(sk - mn); MIXED[(size_t)p * DM + 256 + (2 * kvh + g) * 64 + lane] = (bf16)f2bf(o[g] * scl / den); }
        LDS_WAIT(); asm volatile("" ::: "memory");
    }
    for (int it = gw; it < S * 2; it += NGW) {
        const int p = it >> 1, kvh = it & 1;
#pragma unroll
        for (int g = 0; g < 4; ++g) load_q(PROJ + (size_t)p * NINP + C_CQ + (4 * kvh + g) * 64, qs + g * 64, lane);
        LDS_WAIT(); asm volatile("" ::: "memory");
        float m[4] = {-1e30f, -1e30f, -1e30f, -1e30f}, l[4] = {0.f, 0.f, 0.f, 0.f}, o[4] = {0.f, 0.f, 0.f, 0.f};
        KeyW kf{p, bias2 + (4 + 4 * kvh) * BIASLEN}; wave_attend<4>(PROJ + C_CKW + kvh * 64, PROJ + C_CVW + kvh * 64, qs, 512, kf, m, l, o, lane);
#pragma unroll
        for (int g = 0; g < 4; ++g) OWIN[(size_t)p * 512 + (4 * kvh + g) * 64 + lane] = (bf16)f2bf(o[g] / l[g]);
        LDS_WAIT(); asm volatile("" ::: "memory");
    }
}

__device__ __forceinline__ float gelu_tanh(float x) { const float u = 0.7978845608028654f * (x + 0.044715f * x * x * x); return 0.5f * x * (1.0f + tanhf(u)); }
__device__ __forceinline__ void p2_compress(Frame& F, int layer, const bf16* PROJ) {
    LAS float* flat = (LAS float*)F.lds;
    LAS float* hid = flat + 8 * 2048;
    const int tid = F.tid;
    for (int it = F.vcu; it < 2 * 256; it += F.G) {
        const int kv = it >> 8, rg = it & 255;
        const float* pos = F.in[I_CPOS] + ((size_t)layer * 2 + kv) * 2048;
        const float* w1 = F.in[I_CW1] + ((size_t)layer * 2 + kv) * 2048 * 256;
        const float* w2 = F.in[I_CW2] + ((size_t)layer * 2 + kv) * 256 * 64;
        float* outp = (float*)(F.ws + (kv ? WS_VC : WS_KC));
        __syncthreads();
        for (int e = tid; e < 8 * 2048; e += NTHREADS) {
            const int r = e >> 11, f = e & 2047, R = rg * 8 + r, i = R >> 1, hk = R & 1, t = f >> 6, d = f & 63;
            float v = 0.f;
            if (i < NCMP) v = bf2f(PROJ[(size_t)(16 * i + t) * NINP + (kv ? C_CVC : C_CKC) + hk * 64 + d]) + pos[f];
            flat[e] = v;
        }
        __syncthreads();
        { const int j = tid & 255, half = tid >> 8; float a[4] = {0.f, 0.f, 0.f, 0.f}; const LAS float* fl = flat + half * 4 * 2048;
#pragma unroll 4
            for (int f = 0; f < 2048; ++f) { const float w = w1[(size_t)f * 256 + j];
#pragma unroll
                for (int r = 0; r < 4; ++r) a[r] += fl[r * 2048 + f] * w; }
#pragma unroll
            for (int r = 0; r < 4; ++r) hid[(half * 4 + r) * 256 + j] = gelu_tanh(a[r]); }
        __syncthreads();
        { const int r = tid >> 6, e = tid & 63, R = rg * 8 + r; float a = 0.f;
#pragma unroll 8
            for (int j = 0; j < 256; ++j) a += hid[r * 256 + j] * w2[j * 64 + e];
            if ((R >> 1) < NCMP) outp[(size_t)R * 64 + e] = a; }
    }
    __syncthreads();
}

struct KeyCmp { int g; __device__ __forceinline__ bool operator()(int i, long& off, float (&b)[4]) const { off = ((long)i * 2 + g) * 64; return true; } };
struct KeySel { int p, blk; const float* bias; __device__ __forceinline__ bool operator()(int i, long& off, float (&b)[4]) const {
    const int kpos = blk * 64 + i; if (kpos > p) return false; off = (long)kpos * NINP; const int d = p - kpos;
#pragma unroll
    for (int g = 0; g < 4; ++g) b[g] = bias[g * BIASLEN + (d < BIASLEN ? d : BIASLEN - 1)]; return true; } };

__device__ __forceinline__ void p3_nsa(Frame& F, int layer, const bf16* PROJ, const bf16* OWIN, bf16* MIXED) {
    LAS float* qs = (LAS float*)(F.lds + F.wave * 8192);
    LAS float* imp = qs + 256;
    const int gw = F.vcu * NWAVES + F.wave, NGW = F.G * NWAVES, lane = F.lane;
    const float* bias2 = (const float*)(F.ws + WS_BIAS);
    const float* KC = (const float*)(F.ws + WS_KC); const float* VC = (const float*)(F.ws + WS_VC);
    for (int it = gw; it < S * 2; it += NGW) {
        const int p = it >> 1, kvh = it & 1;
#pragma unroll
        for (int g = 0; g < 4; ++g) load_q(PROJ + (size_t)p * NINP + C_CQ + (4 * kvh + g) * 64, qs + g * 64, lane);
        for (int e = lane; e < 1040; e += 64) imp[e] = 0.f;
        LDS_WAIT(); asm volatile("" ::: "memory");
        int nv = p >= 31 ? ((p - 31) >> 4) + 1 : 0; if (nv > NCMP) nv = NCMP;
        float m1[4] = {-1e30f, -1e30f, -1e30f, -1e30f}, l1[4] = {0.f, 0.f, 0.f, 0.f}, o1[4] = {0.f, 0.f, 0.f, 0.f};
        { KeyCmp kf{kvh}; wave_attend<4>(KC, VC, qs, nv, kf, m1, l1, o1, lane); }
        for (int base = 0; base < nv; base += 64) { const int i = base + lane;
            const LAS float* qo = qs; asm volatile("" : "+v"(qo));
            if (i < nv) { float s[4] = {0.f, 0.f, 0.f, 0.f}; dot64<4>(KC + ((size_t)i * 2 + kvh) * 64, qo, s); float a = 0.f;
#pragma unroll
                for (int g = 0; g < 4; ++g) a += exp2f(s[g] - m1[g]) / fmaxf(l1[g], 1e-30f);
                imp[1 + i] = a; } }
        LDS_WAIT(); asm volatile("" ::: "memory");
        const int cur = p >> 6;
        float sc[4];
#pragma unroll
        for (int c = 0; c < 4; ++c) { const int j = lane + 64 * c; const LAS float* q = imp + 4 * j;
            const float is = 0.5f * q[0] + q[1] + q[2] + q[3] + 0.5f * q[4];
            const bool forced = (j == 0) || (j == cur) || (j == cur - 1);
            sc[c] = forced ? 1e4f : ((j * 64 <= p) ? is : -1e30f); }
        float m2[4] = {-1e30f, -1e30f, -1e30f, -1e30f}, l2[4] = {0.f, 0.f, 0.f, 0.f}, o2[4] = {0.f, 0.f, 0.f, 0.f};
#pragma unroll 1
        for (int k = 0; k < 16; ++k) {
            float bv = sc[0]; int bi = lane;
#pragma unroll
            for (int c = 1; c < 4; ++c) if (sc[c] > bv) { bv = sc[c]; bi = lane + 64 * c; }
#pragma unroll
            for (int off = 1; off < 64; off <<= 1) { const float ov = __shfl_xor(bv, off); const int oi = __shfl_xor(bi, off); if (ov > bv || (ov == bv && oi < bi)) { bv = ov; bi = oi; } }
#pragma unroll
            for (int c = 0; c < 4; ++c) if (bi == lane + 64 * c) sc[c] = -3e38f;
            if (bi * 64 <= p) { KeySel kf{p, bi, bias2 + (4 + 4 * kvh) * BIASLEN}; wave_attend<4>(PROJ + C_CKS + kvh * 64, PROJ + C_CVS + kvh * 64, qs, 64, kf, m2, l2, o2, lane); }
        }
#pragma unroll
        for (int g = 0; g < 4; ++g) { const int H = 4 * kvh + g;
            const float g0 = bf2f(PROJ[(size_t)p * NINP + C_CG + H * 3 + 0]), g1 = bf2f(PROJ[(size_t)p * NINP + C_CG + H * 3 + 1]), g2 = bf2f(PROJ[(size_t)p * NINP + C_CG + H * 3 + 2]);
            const float ocmp = o1[g] / fmaxf(l1[g], 1e-30f), oslc = o2[g] / l2[g], owin = bf2f(OWIN[(size_t)p * 512 + H * 64 + lane]);
            MIXED[(size_t)p * DM + 512 + H * 64 + lane] = (bf16)f2bf(g0 * ocmp + g1 * oslc + g2 * owin); }
        LDS_WAIT(); asm volatile("" ::: "memory");
    }
}

constexpr int N_PHASES = 2 + 8 * DEPTH;
__device__ __forceinline__ void run_phase(Frame& F, int ph) {
    unsigned char* ws = F.ws;
    const float* mod = (const float*)(ws + WS_MOD);
    if (ph == 0) { p0_prologue(F); return; }
    if (ph == 1) { row_pass<0>(F, F.in[I_X], nullptr, (bf16*)(ws + WS_RA), nullptr, nullptr, mod + 1024, mod + 0); return; }
    const int l = (ph - 2) >> 3, sub = (ph - 2) & 7;
    const float* modl = mod + l * 6144;
    bf16* bufX = (bf16*)(ws + ((l & 1) ? WS_RB : WS_RA));
    bf16* bufY = (bf16*)(ws + ((l & 1) ? WS_RA : WS_RB));
    bf16* PROJ = (bf16*)(ws + WS_BIG); bf16* HID = (bf16*)(ws + WS_BIG); bf16* OWIN = (bf16*)(ws + WS_OWIN);
    const float* xres = (l == 0) ? F.in[I_X] : F.out;
    switch (sub) {
    case 0: {
        pg8::Gemm g{bufX, (const bf16*)(ws + WS_WIN) + (size_t)l * NINP * DM, S, NINP, DM}; pg8::StaticOrder So; So.init(S, NINP, F.G, (int)blockIdx.x);
        pg8::EpiInProj E{PROJ, NINP, (const float*)(ws + WS_ROPE), QSCALE};
        pg8::gemm_phase<pg8::EpiInProj, pg8::StaticOrder, PG8_ALIGN, PG8_SP2>(F.lds, g, So, E, F.wave);
    } break;
    case 1: p2_compress(F, l, PROJ); p2_token_attention(F, l, PROJ, bufY, OWIN); break;
    case 2: p3_nsa(F, l, PROJ, OWIN, bufY); break;
    case 3: {
        pg8::Gemm g{bufY, (const bf16*)(ws + WS_WOUT) + (size_t)l * DM * DM, S, DM, DM}; pg8::StaticOrder So; So.init(S, DM, F.G, (int)blockIdx.x);
        pg8::EpiResid E{xres, F.out, DM, modl + 2048, DN_ALPHA};
        pg8::gemm_phase<pg8::EpiResid, pg8::StaticOrder, PG8_ALIGN, PG8_SP2>(F.lds, g, So, E, F.wave);
    } break;
    case 4: row_pass<1>(F, F.out, F.out, bufX, F.in[I_LNG] + (l * 2 + 0) * DM, F.in[I_LNB] + (l * 2 + 0) * DM, modl + 4096, modl + 3072); break;
    case 5: {
        pg8::Gemm g{bufX, (const bf16*)(ws + WS_W1) + (size_t)l * DFF * DM, S, DFF, DM}; pg8::StaticOrder So; So.init(S, DFF, F.G, (int)blockIdx.x);
        pg8::EpiRelu2 E{HID, DFF};
        pg8::gemm_phase<pg8::EpiRelu2, pg8::StaticOrder, PG8_ALIGN, PG8_SP2>(F.lds, g, So, E, F.wave);
    } break;
    case 6: {
        pg8::Gemm g{HID, (const bf16*)(ws + WS_W2) + (size_t)l * DM * DFF, S, DM, DFF}; pg8::StaticOrder So; So.init(S, DM, F.G, (int)blockIdx.x);
        pg8::EpiResid E{F.out, F.out, DM, modl + 5120, DN_ALPHA};
        pg8::gemm_phase<pg8::EpiResid, pg8::StaticOrder, PG8_ALIGN, PG8_SP2>(F.lds, g, So, E, F.wave);
    } break;
    default: {
        if (l + 1 < DEPTH) row_pass<1>(F, F.out, F.out, bufY, F.in[I_LNG] + (l * 2 + 1) * DM, F.in[I_LNB] + (l * 2 + 1) * DM, modl + 6144 + 1024, modl + 6144 + 0);
        else row_pass<2>(F, F.out, F.out, nullptr, F.in[I_LNG] + (l * 2 + 1) * DM, F.in[I_LNB] + (l * 2 + 1) * DM, nullptr, nullptr);
    } break;
    }
}

__global__ void __launch_bounds__(NTHREADS, 2) fwd_kernel(Args args) {
    extern __shared__ __attribute__((aligned(16))) unsigned char lds[];
    Frame F;
    F.lds = (LAS unsigned char*)lds;
    F.tid = threadIdx.x; F.lane = F.tid & 63; F.wave = __builtin_amdgcn_readfirstlane(F.tid >> 6);
    F.G = gridDim.x; { const int bx = blockIdx.x; F.vcu = (F.G % 8 == 0) ? (bx % 8) * (F.G / 8) + bx / 8 : bx; }
    F.ws = args.ws; F.out = args.out;
#pragma unroll
    for (int i = 0; i < 16; ++i) F.in[i] = args.in[i];
    for (int u = F.tid; u < (LDS_BYTES - LDSCTL_OFF) / 4; u += NTHREADS) ((LAS unsigned*)(F.lds + LDSCTL_OFF))[u] = 0u;
    __syncthreads();
    const int wave0 = __builtin_amdgcn_readfirstlane(threadIdx.x >> 6);
    const bool multi = (args.ph_hi - args.ph_lo) > 1;
    XcdBarrier bar; bar.bar = (unsigned*)(F.ws + WS_CTL) + 4096; bar.x = 0; bar.st = nullptr;
    if (multi) bar = xcd_barrier_post((unsigned*)(F.ws + WS_CTL) + 4096, (volatile LAS unsigned*)(F.lds + MISC_OFF) + 8);
    for (int ph = args.ph_lo; ph < args.ph_hi; ++ph) {
        { int ln = __builtin_amdgcn_mbcnt_hi(~0u, __builtin_amdgcn_mbcnt_lo(~0u, 0u)); asm volatile("" : "+v"(ln)); F.lane = ln; F.wave = wave0; F.tid = wave0 * 64 + ln; }
        run_phase(F, ph);
        if (ph + 1 < args.ph_hi) xcd_barrier(bar);
    }
}

#ifndef N_LAUNCH_MODE
#define N_LAUNCH_MODE 0
#endif
extern "C" void kernel_launch(void* const* d_in, const int* in_sizes, int n_in, void* d_out, int out_size, void* d_ws, size_t ws_size, hipStream_t stream) {
    static int grid = 0;
    if (grid == 0) {
        if (n_in != 16 || out_size != S * DM || ws_size < WS_END) { fprintf(stderr, "kernel_launch: unexpected shapes (n_in %d out %d ws %zu)\n", n_in, out_size, ws_size); grid = -1; return; }
        int dev = 0, cus = 0;
        if (hipGetDevice(&dev) != hipSuccess || hipDeviceGetAttribute(&cus, hipDeviceAttributeMultiprocessorCount, dev) != hipSuccess) { grid = -1; return; }
        if (hipFuncSetAttribute((const void*)fwd_kernel, hipFuncAttributeMaxDynamicSharedMemorySize, LDS_BYTES) != hipSuccess) { fprintf(stderr, "kernel_launch: hipFuncSetAttribute failed\n"); grid = -1; return; }
        int per_cu = 0;
        if (hipOccupancyMaxActiveBlocksPerMultiprocessor(&per_cu, (const void*)fwd_kernel, NTHREADS, LDS_BYTES) != hipSuccess || per_cu < 1) fprintf(stderr, "kernel_launch: occupancy query says %d\n", per_cu);
        (void)hipGetLastError();
        grid = cus;
    }
    if (grid < 0) return;
    (void)hipMemsetAsync((char*)d_ws + WS_CTL, 0, CTL_ZERO_BYTES, stream);
    Args a{};
    for (int i = 0; i < 16; ++i) a.in[i] = (const float*)d_in[i];
    a.out = (float*)d_out; a.ws = (unsigned char*)d_ws;
#if N_LAUNCH_MODE == 1
    a.ph_lo = 0; a.ph_hi = N_PHASES;
    hipLaunchKernelGGL(fwd_kernel, dim3(grid), dim3(NTHREADS), LDS_BYTES, stream, a);
#else
    for (int ph = 0; ph < N_PHASES; ++ph) { a.ph_lo = ph; a.ph_hi = ph + 1; hipLaunchKernelGGL(fwd_kernel, dim3(grid), dim3(NTHREADS), LDS_BYTES, stream, a); }
#endif
}
```

```cpp
#include <hip/hip_runtime.h>
#include <cstdio>
#include <cstdint>
#include <cmath>
namespace pg8 {
#define PG8_LAS __attribute__((address_space(3)))
typedef unsigned short bf16_t;
typedef short bf16x8 __attribute__((ext_vector_type(8)));
typedef float f32x4 __attribute__((ext_vector_type(4)));
typedef unsigned u32x4 __attribute__((ext_vector_type(4)));
constexpr int BM = 256, BK = 64, HALF = 128, HTB = HALF * BK * 2  , STAGE_BYTES = 8 * HTB, NXCD = 8, WGM = 8;

__host__ __device__ __forceinline__ int lds_byte(int r, int c) { const int st = (r >> 4) * 2 + (c >> 5), rr = r & 15, cc = c & 31, ob = rr * 64 + cc * 2; return st * 1024 + (ob ^ (((ob >> 9) & 1) << 5)); }
__host__ __device__ __forceinline__ void stage_rc(int b, int& R, int& C) { const int st = b / 1024, sb = b % 1024, swz = sb ^ (((sb >> 9) & 1) << 5); R = (st >> 1) * 16 + swz / 64; C = (st & 1) * 32 + (swz % 64) / 2; }
__host__ __device__ __forceinline__ int perm32(int rho) { const int n = rho >> 4, i = rho & 15; return 8 * (i >> 2) + 4 * n + (i & 3); }

struct Unit { int pm, pn; };
struct Gemm { const bf16_t* A; const bf16_t* Bt; int M, N, K; };

struct StaticOrder {
    int nM, nN, nwg, G, c;
    __host__ __device__ void init(int M, int N, int G_, int c_) { nM = M / BM; nN = N / BM; nwg = nM * nN; G = G_; c = c_; }
    __host__ __device__ bool next(int i, Unit& u) const {
        const long L = (long)i * G + c; if (L >= nwg) return false;
        int wgid = (int)L; { const int q = nwg / NXCD, r = nwg % NXCD, xcd = wgid % NXCD, off = wgid / NXCD; wgid = (xcd < r ? xcd * (q + 1) : r * (q + 1) + (xcd - r) * q) + off; }
        const int nig = WGM * nN, gid = wgid / nig, fm = gid * WGM, gsz = (nM - fm) < WGM ? (nM - fm) : WGM;
        u.pm = fm + ((wgid % nig) % gsz); u.pn = (wgid % nig) / gsz; return true;
    }
    __device__ __forceinline__ void a_ready(const Unit&) const {}
    __device__ __forceinline__ void done(const Unit&) const {}
};


__device__ __forceinline__ unsigned cvt_pk_bf16(float lo, float hi) { unsigned r; asm volatile("v_cvt_pk_bf16_f32 %0, %1, %2" : "=v"(r) : "v"(lo), "v"(hi)); return r; }
typedef float f32x2 __attribute__((ext_vector_type(2)));

struct EpiInProj {
    static constexpr bool PERM = true, AFTER_DRAIN = false;
    bf16_t* O; int ldc; const float* rope; float qscale;
    __device__ __forceinline__ void operator()(const f32x4 (&acc)[2][2][4][2], const Unit& u, int wr, int wc, int fr, int fq) const {
        const int row0 = u.pm * BM + wr * 64 + fr; const int col0 = u.pn * BM + wc * 32 + 8 * fq;
        const int i0 = 16 * (wc & 1) + 4 * fq;
#pragma unroll
        for (int bj = 0; bj < 2; ++bj) {
            const int pn = u.pn;
            const bool do_rope = (pn == 3) || (pn == 4 && bj == 0);
            const bool do_sig = (pn == 10);
            const float sc = (pn == 0 || pn == 3 || pn == 5 || pn == 6) ? qscale : 1.0f;
#pragma unroll
            for (int ai = 0; ai < 2; ++ai)
#pragma unroll
                for (int m = 0; m < 4; ++m) {
                    const int row = row0 + ai * HALF + m * 16;
                    f32x4 v0 = acc[ai][bj][m][0], v1 = acc[ai][bj][m][1];
                    if (do_rope) {
                        const f32x4* rp = (const f32x4*)(rope + ((size_t)row * 32 + i0) * 2);
                        const f32x4 c01 = rp[0], c23 = rp[1];
                        f32x4 w0, w1;
                        w0[0] = v0[0] * c01[0] - v0[1] * c01[1]; w0[1] = v0[1] * c01[0] + v0[0] * c01[1];
                        w0[2] = v0[2] * c01[2] - v0[3] * c01[3]; w0[3] = v0[3] * c01[2] + v0[2] * c01[3];
                        w1[0] = v1[0] * c23[0] - v1[1] * c23[1]; w1[1] = v1[1] * c23[0] + v1[0] * c23[1];
                        w1[2] = v1[2] * c23[2] - v1[3] * c23[3]; w1[3] = v1[3] * c23[2] + v1[2] * c23[3];
                        v0 = w0; v1 = w1;
                    }
                    if (do_sig) {
#pragma unroll
                        for (int e = 0; e < 4; ++e) { v0[e] = 1.0f / (1.0f + __expf(-v0[e])); v1[e] = 1.0f / (1.0f + __expf(-v1[e])); }
                    }
                    v0 = v0 * sc; v1 = v1 * sc;
                    u32x4 w; w.x = cvt_pk_bf16(v0[0], v0[1]); w.y = cvt_pk_bf16(v0[2], v0[3]); w.z = cvt_pk_bf16(v1[0], v1[1]); w.w = cvt_pk_bf16(v1[2], v1[3]);
                    *(u32x4*)(O + (size_t)row * ldc + col0 + bj * HALF) = w;
                }
        }
    }
};
struct EpiRelu2 {
    static constexpr bool PERM = true, AFTER_DRAIN = false;
    bf16_t* O; int ldc;
    __device__ __forceinline__ void operator()(const f32x4 (&acc)[2][2][4][2], const Unit& u, int wr, int wc, int fr, int fq) const {
        const int row0 = u.pm * BM + wr * 64 + fr; const int col0 = u.pn * BM + wc * 32 + 8 * fq;
#pragma unroll
        for (int ai = 0; ai < 2; ++ai)
#pragma unroll
            for (int m = 0; m < 4; ++m) { bf16_t* rowp = O + (size_t)(row0 + ai * HALF + m * 16) * ldc + col0;
#pragma unroll
                for (int bj = 0; bj < 2; ++bj) { f32x4 v0 = acc[ai][bj][m][0], v1 = acc[ai][bj][m][1];
#pragma unroll
                    for (int e = 0; e < 4; ++e) { const float a = fmaxf(v0[e], 0.f), b = fmaxf(v1[e], 0.f); v0[e] = a * a; v1[e] = b * b; }
                    u32x4 w; w.x = cvt_pk_bf16(v0[0], v0[1]); w.y = cvt_pk_bf16(v0[2], v0[3]); w.z = cvt_pk_bf16(v1[0], v1[1]); w.w = cvt_pk_bf16(v1[2], v1[3]);
                    *(u32x4*)(rowp + bj * HALF) = w; } }
    }
};
struct EpiResid {
    static constexpr bool PERM = false, AFTER_DRAIN = false;
    const float* base; float* out; int ldc; const float* gate; float alpha;
    __device__ __forceinline__ void operator()(const f32x4 (&acc)[2][2][4][2], const Unit& u, int wr, int wc, int fr, int fq) const {
        const int col0 = u.pn * BM + wc * 32 + 4 * fq;
#pragma unroll
        for (int bj = 0; bj < 2; ++bj)
#pragma unroll
            for (int n = 0; n < 2; ++n) { const f32x4 gv = *(const f32x4*)(gate + col0 + bj * HALF + n * 16) + 1.0f;
#pragma unroll
                for (int ai = 0; ai < 2; ++ai)
#pragma unroll
                    for (int m = 0; m < 4; ++m) { const size_t off = (size_t)(u.pm * BM + ai * HALF + wr * 64 + m * 16 + fr) * ldc + col0 + bj * HALF + n * 16;
                        const f32x4 bs = *(const f32x4*)(base + off); *(f32x4*)(out + off) = bs * alpha + gv * acc[ai][bj][m][n]; } }
    }
};
template <class Epi, class Sched, bool ALIGN_EPI = false, bool SP2 = false>
__device__ __forceinline__ void gemm_phase(PG8_LAS unsigned char* lds, const Gemm g, const Sched& S, const Epi& E, const int wid  ) {
    int lane_ = __builtin_amdgcn_mbcnt_hi(~0u, __builtin_amdgcn_mbcnt_lo(~0u, 0u)); asm volatile("" : "+v"(lane_));
    const int lane = lane_, tid = wid * 64 + lane, wr = wid >> 2, wc = wid & 3, fr = lane & 15, fq = lane >> 4;
    const int K = g.K, nt = K / BK;
    unsigned voffA[2], voffB[2];
#pragma unroll
    for (int i = 0; i < 2; ++i) { int R, C; stage_rc(tid * 16 + i * 8192, R, C); const int Rb = Epi::PERM ? ((R & ~31) + perm32(R & 31)) : R;
        voffA[i] = (unsigned)(R * K + C) * 2u; voffB[i] = (unsigned)(Rb * K + C) * 2u; }
    const size_t kstep = (size_t)(BK * 2);
    const size_t hstep = (size_t)HALF * K * 2;
    const size_t tstep = 2 * hstep;
    const unsigned ldsw = (unsigned)wid * 1024u;
    const int aoff = lds_byte(wr * 64 + fr, fq * 8), boff = lds_byte(wc * 32 + fr, fq * 8);
#define PG8_SA(b, h) (((b) * 2 + (h)) * HTB)
#define PG8_SB(b, h) ((4 + (b) * 2 + (h)) * HTB)
#define PG8_STAGE(bufoff, gbase, voff) do { _Pragma("unroll") for (int _i = 0; _i < 2; ++_i) \
        __builtin_amdgcn_global_load_lds((const unsigned*)((const char*)(gbase) + (voff)[_i]), (PG8_LAS unsigned*)(lds + (bufoff) + ldsw + _i * 8192), 16, 0, 0); } while (0)
#define PG8_LDA(dst, b, h) do { _Pragma("unroll") for (int m = 0; m < 4; ++m) _Pragma("unroll") for (int k = 0; k < 2; ++k) dst[m][k] = *(const PG8_LAS bf16x8*)(lds + PG8_SA(b, h) + aoff + m * 2048 + k * 1024); } while (0)
#define PG8_LDB(dst, b, h) do { _Pragma("unroll") for (int n = 0; n < 2; ++n) _Pragma("unroll") for (int k = 0; k < 2; ++k) dst[n][k] = *(const PG8_LAS bf16x8*)(lds + PG8_SB(b, h) + boff + n * 2048 + k * 1024); } while (0)
#define PG8_MMA(ai, bj, At, Bt) do { __builtin_amdgcn_s_setprio(1); _Pragma("unroll") for (int m = 0; m < 4; ++m) _Pragma("unroll") for (int n = 0; n < 2; ++n) _Pragma("unroll") for (int k = 0; k < 2; ++k) \
        acc[ai][bj][m][n] = __builtin_amdgcn_mfma_f32_16x16x32_bf16(Bt[n][k], At[m][k], acc[ai][bj][m][n], 0, 0, 0); __builtin_amdgcn_s_setprio(0); } while (0)
#define PG8_WAIT_V(n) asm volatile("s_waitcnt vmcnt(" #n ")" ::: "memory")
#define PG8_WAIT_L(n) asm volatile("s_waitcnt lgkmcnt(" #n ")" ::: "memory")
#define PG8_BAR __builtin_amdgcn_s_barrier()
#define PG8_SCHED __builtin_amdgcn_sched_barrier(0)
    Unit cur, nxt; int ui = 0;
    if (!S.next(0, cur)) return;
    f32x4 acc[2][2][4][2];
#pragma unroll
    for (int a = 0; a < 2; ++a)
#pragma unroll
        for (int b = 0; b < 2; ++b)
#pragma unroll
            for (int m = 0; m < 4; ++m)
#pragma unroll
                for (int n = 0; n < 2; ++n) acc[a][b][m][n] = (f32x4){0.f, 0.f, 0.f, 0.f};
    bf16x8 At[4][2], B0[2][2], B1[2][2];
    const char* cA = (const char*)g.A + (size_t)cur.pm * tstep; const char* cB = (const char*)g.Bt + (size_t)cur.pn * tstep;
    S.a_ready(cur);
    if constexpr (SP2) {
        PG8_STAGE(PG8_SB(0, 0), cB, voffB); PG8_STAGE(PG8_SB(0, 1), cB + hstep, voffB); PG8_STAGE(PG8_SA(0, 0), cA, voffA); PG8_STAGE(PG8_SA(0, 1), cA + hstep, voffA);
        if (wr == 1) PG8_BAR;
        PG8_WAIT_V(2); PG8_BAR;
        PG8_STAGE(PG8_SB(1, 0), cB + kstep, voffB); PG8_STAGE(PG8_SA(1, 0), cA + kstep, voffA); PG8_STAGE(PG8_SB(1, 1), cB + hstep + kstep, voffB);
        PG8_WAIT_V(6); PG8_BAR;
    } else {
        PG8_STAGE(PG8_SB(0, 0), cB, voffB); PG8_STAGE(PG8_SA(0, 0), cA, voffA); PG8_STAGE(PG8_SB(0, 1), cB + hstep, voffB); PG8_STAGE(PG8_SA(0, 1), cA + hstep, voffA);
        if (wr == 1) PG8_BAR;
        PG8_WAIT_V(4); PG8_BAR;
        PG8_STAGE(PG8_SB(1, 0), cB + kstep, voffB); PG8_STAGE(PG8_SA(1, 0), cA + kstep, voffA); PG8_STAGE(PG8_SB(1, 1), cB + hstep + kstep, voffB);
        PG8_WAIT_V(6); PG8_BAR;
    }
    for (;;) {
        const bool has_next = S.next(ui + 1, nxt);
        const char* nA = has_next ? (const char*)g.A + (size_t)nxt.pm * tstep : cA; const char* nB = has_next ? (const char*)g.Bt + (size_t)nxt.pn * tstep : cB;
        for (int t = 0; t < nt; t += 2) {
            const bool last = (t == nt - 2);
            const char* a1 = cA + (size_t)(t + 1) * kstep;
            const char* a2 = last ? nA : cA + (size_t)(t + 2) * kstep; const char* b2 = last ? nB : cB + (size_t)(t + 2) * kstep;
            const char* a3 = a2 + kstep; const char* b3 = b2 + kstep;
            if (last && has_next) S.a_ready(nxt);
            if constexpr (SP2) {
            PG8_LDB(B0, 0, 0); PG8_LDB(B1, 0, 1); PG8_SCHED; PG8_LDA(At, 0, 0); PG8_STAGE(PG8_SA(1, 1), a1 + hstep, voffA);
            PG8_WAIT_V(8); PG8_WAIT_L(0); PG8_BAR; PG8_MMA(0, 0, At, B0); PG8_MMA(0, 1, At, B1); PG8_BAR; PG8_SCHED;
            PG8_LDA(At, 0, 1); PG8_STAGE(PG8_SB(0, 0), b2, voffB); PG8_STAGE(PG8_SB(0, 1), b2 + hstep, voffB); PG8_STAGE(PG8_SA(0, 0), a2, voffA);
            PG8_WAIT_V(8); PG8_WAIT_L(0); PG8_BAR; PG8_MMA(1, 0, At, B0); PG8_MMA(1, 1, At, B1); PG8_BAR; PG8_SCHED;
            PG8_LDB(B0, 1, 0); PG8_LDB(B1, 1, 1); PG8_SCHED; PG8_LDA(At, 1, 0); PG8_STAGE(PG8_SA(0, 1), a2 + hstep, voffA);
            PG8_WAIT_V(8); PG8_WAIT_L(0); PG8_BAR; PG8_MMA(0, 0, At, B0); PG8_MMA(0, 1, At, B1); PG8_BAR; PG8_SCHED;
            PG8_LDA(At, 1, 1); PG8_STAGE(PG8_SB(1, 0), b3, voffB); PG8_STAGE(PG8_SB(1, 1), b3 + hstep, voffB); PG8_STAGE(PG8_SA(1, 0), a3, voffA);
            PG8_WAIT_V(8); PG8_WAIT_L(0); PG8_BAR; PG8_MMA(1, 0, At, B0); PG8_MMA(1, 1, At, B1); PG8_BAR; PG8_SCHED;
            } else {
            PG8_LDB(B0, 0, 0); PG8_SCHED; PG8_LDA(At, 0, 0); PG8_STAGE(PG8_SA(1, 1), a1 + hstep, voffA);
            PG8_WAIT_L(8); PG8_BAR; PG8_WAIT_L(0); PG8_MMA(0, 0, At, B0); PG8_BAR; PG8_SCHED;
            PG8_LDB(B1, 0, 1); PG8_STAGE(PG8_SB(0, 0), b2, voffB);
            PG8_BAR; PG8_WAIT_L(0); PG8_MMA(0, 1, At, B1); PG8_BAR;
            PG8_LDA(At, 0, 1); PG8_STAGE(PG8_SA(0, 0), a2, voffA);
            PG8_BAR; PG8_WAIT_L(0); PG8_MMA(1, 0, At, B0); PG8_BAR; PG8_SCHED;
            PG8_STAGE(PG8_SB(0, 1), b2 + hstep, voffB);
            PG8_WAIT_V(6); PG8_BAR; PG8_MMA(1, 1, At, B1); PG8_BAR;
            PG8_LDB(B0, 1, 0); PG8_SCHED; PG8_LDA(At, 1, 0); PG8_STAGE(PG8_SA(0, 1), a2 + hstep, voffA);
            PG8_WAIT_L(8); PG8_BAR; PG8_WAIT_L(0); PG8_MMA(0, 0, At, B0); PG8_BAR; PG8_SCHED;
            PG8_LDB(B1, 1, 1); PG8_STAGE(PG8_SB(1, 0), b3, voffB);
            PG8_BAR; PG8_WAIT_L(0); PG8_MMA(0, 1, At, B1); PG8_BAR;
            PG8_LDA(At, 1, 1); PG8_STAGE(PG8_SA(1, 0), a3, voffA);
            PG8_BAR; PG8_WAIT_L(0); PG8_MMA(1, 0, At, B0); PG8_BAR; PG8_SCHED;
            PG8_STAGE(PG8_SB(1, 1), b3 + hstep, voffB);
            PG8_WAIT_V(6); PG8_BAR; PG8_MMA(1, 1, At, B1); PG8_BAR;
            }
        }
        if constexpr (ALIGN_EPI) { if (wr == 0) PG8_BAR; }
        if constexpr (!Epi::AFTER_DRAIN) { E(acc, cur, wr, wc, fr, fq); S.done(cur); }
        if (!has_next) break;
#pragma unroll
        for (int a = 0; a < 2; ++a)
#pragma unroll
            for (int b = 0; b < 2; ++b)
#pragma unroll
                for (int m = 0; m < 4; ++m)
#pragma unroll
                    for (int n = 0; n < 2; ++n) acc[a][b][m][n] = (f32x4){0.f, 0.f, 0.f, 0.f};
        cur = nxt; cA = nA; cB = nB; ++ui;
        if constexpr (ALIGN_EPI) { if (wr == 1) PG8_BAR; }
    }
    PG8_WAIT_V(0);
    if constexpr (!ALIGN_EPI) { if (wr == 0) PG8_BAR; }
    PG8_BAR;
    if constexpr (Epi::AFTER_DRAIN) { E.fused(acc, cur, wr, wc, fr, fq, lds, wid, lane); S.done(cur); }
#undef PG8_SA
#undef PG8_SB
#undef PG8_STAGE
#undef PG8_LDA
#undef PG8_LDB
#undef PG8_MMA
#undef PG8_WAIT_V
#undef PG8_WAIT_L
#undef PG8_BAR
#undef PG8_SCHED
}
}

#ifndef PG8_SP2
#define PG8_SP2 true
#endif
#ifndef PG8_ALIGN
#define PG8_ALIGN true
#endif

constexpr int S = 16384, DM = 1024, NIN = 2584, NINP = 2816, DFF = 4096, DEPTH = 4;
constexpr int NWAVES = 8, NTHREADS = 512;
constexpr float LN_EPS = 1e-5f;
constexpr float LOG2E = 1.4426950408889634f;
constexpr float QSCALE = 0.125f * LOG2E;
constexpr float DN_ALPHA = 1.681792830507429f;
constexpr int C_AQ = 0, C_AK = 256, C_AV = 512, C_BQ = 768, C_BK = 1024, C_BV = 1152, C_CQ = 1280, C_CKC = 1792, C_CVC = 1920,
              C_CKS = 2048, C_CVS = 2176, C_CKW = 2304, C_CVW = 2432, C_CG = 2560;
constexpr int NCMP = 1023, NSEL = 256;
constexpr int BIASLEN = 2048;

constexpr size_t MiB = 1u << 20;
constexpr size_t WS_CTL = 0, CTL_ZERO_BYTES = 1 * MiB;
constexpr size_t WS_MOD = 1 * MiB;
constexpr size_t WS_BIAS = 1 * MiB + 128 * 1024;
constexpr size_t WS_ROPE = 2 * MiB;
constexpr size_t WS_KC = 6 * MiB, WS_VC = 6 * MiB + 512 * 1024;
constexpr size_t WS_WIN = 8 * MiB;
constexpr size_t WS_WOUT = 30 * MiB;
constexpr size_t WS_W1 = 38 * MiB;
constexpr size_t WS_W2 = 70 * MiB;
constexpr size_t WS_CW1 = 102 * MiB;
constexpr size_t WS_RA = 110 * MiB, WS_RB = 142 * MiB;
constexpr size_t WS_BIG = 174 * MiB;
constexpr size_t WS_OWIN = 302 * MiB;
constexpr size_t WS_END = 318 * MiB;

#define GAS __attribute__((address_space(1)))
#define LAS __attribute__((address_space(3)))
typedef unsigned short bf16;
typedef unsigned v4u __attribute__((ext_vector_type(4)));
typedef unsigned v2u __attribute__((ext_vector_type(2)));
typedef float f32x4 __attribute__((ext_vector_type(4)));
typedef float f32x2 __attribute__((ext_vector_type(2)));
#define LDS_WAIT() asm volatile("s_waitcnt lgkmcnt(0)" ::: "memory")
#define VM_WAIT() asm volatile("s_waitcnt vmcnt(0)" ::: "memory")
__device__ __forceinline__ unsigned f2bf(float f) { unsigned u = __builtin_bit_cast(unsigned, f); return (u + 0x7fffu + ((u >> 16) & 1u)) >> 16; }
__device__ __forceinline__ unsigned pk2(float lo, float hi) { return f2bf(lo) | (f2bf(hi) << 16); }
__device__ __forceinline__ float bf2f(unsigned short b) { return __uint_as_float((unsigned)b << 16); }
__device__ __forceinline__ float bflo(unsigned w) { return __uint_as_float(w << 16); }
__device__ __forceinline__ float bfhi(unsigned w) { return __uint_as_float(w & 0xffff0000u); }
__device__ __forceinline__ float wave_sum(float v) {
#pragma unroll
    for (int o = 1; o < 64; o <<= 1) v += __shfl_xor(v, o);
    return v;
}
__device__ __forceinline__ float wave_max(float v) {
#pragma unroll
    for (int o = 1; o < 64; o <<= 1) v = fmaxf(v, __shfl_xor(v, o));
    return v;
}

constexpr int RING_BYTES = 131072;
constexpr int LDSCTL_OFF = RING_BYTES, MISC_OFF = LDSCTL_OFF + 320;
constexpr int LDS_BYTES = 147456;

struct Args { const float* in[16]; float* out; unsigned char* ws; int ph_lo, ph_hi; };

struct Frame {
    LAS unsigned char* lds;
    int tid, lane, wave, G, vcu;
    unsigned char* ws;
    const float* in[16];
    float* out;
};
enum { I_X = 0, I_C, I_POS, I_WIN, I_WOUT, I_RELB, I_SINK, I_CPOS, I_CW1, I_CW2, I_MW1, I_MW2, I_ADAW, I_ADAB, I_LNG, I_LNB };

__device__ __forceinline__ int t5_bucket(int d) {
    if (d < 16) return d;
    int b = 16;
    b += d >= 22; b += d >= 30; b += d >= 40; b += d >= 54; b += d >= 73; b += d >= 99; b += d >= 134; b += d >= 182;
    b += d >= 246; b += d >= 332; b += d >= 450; b += d >= 609; b += d >= 825; b += d >= 1117; b += d >= 1513;
    return b;
}
__device__ const float ROPE_FREQ[32] = {1.000000000e+00f, 6.890442967e-01f, 4.747820497e-01f, 3.271458745e-01f, 2.254180014e-01f, 1.553229839e-01f, 1.070244238e-01f, 7.374456525e-02f,
    5.081327632e-02f, 3.501259908e-02f, 2.412523143e-02f, 1.662335359e-02f, 1.145422645e-02f, 7.892469876e-03f, 5.438261200e-03f, 3.747202922e-03f,
    2.581988927e-03f, 1.779104699e-03f, 1.225881977e-03f, 8.446869906e-04f, 5.820267834e-04f, 4.010422272e-04f, 2.763358643e-04f, 1.904076635e-04f,
    1.311993110e-04f, 9.040213627e-05f, 6.229108112e-05f, 4.292131416e-05f, 2.957468678e-05f, 2.037826926e-05f, 1.404153045e-05f, 9.675236470e-06f};
__device__ __forceinline__ void sincos_f(float a, float& c, float& s) {
    const float n = rintf(a * 0.636619772367581343f);
    float r = fmaf(-n, 1.5703125f, a); r = fmaf(-n, 0.0004838267923332751f, r); r = fmaf(-n, 2.5632829192545614e-12f, r);
    const float r2 = r * r;
    const float sp = fmaf(r * r2, fmaf(r2, fmaf(r2, fmaf(r2, 2.755731922e-6f, -1.984126984e-4f), 8.333333333e-3f), -1.666666667e-1f), r);
    const float cp = fmaf(r2, fmaf(r2, fmaf(r2, fmaf(r2, fmaf(r2, -2.755731922e-7f, 2.480158730e-5f), -1.388888889e-3f), 4.166666667e-2f), -0.5f), 1.0f);
    const int q = ((int)n) & 3;
    c = (q == 0) ? cp : (q == 1) ? -sp : (q == 2) ? -cp : sp;
    s = (q == 0) ? sp : (q == 1) ? cp : (q == 2) ? -sp : -cp;
}

template <int MODE>
__device__ __forceinline__ int colmap(int n) {
    if (MODE == 0) return n;
    if (n >= NIN) return -1;
    if (n >= C_BQ && n < C_BV) { const int hb = n & ~63, j = n & 63; return hb + (j >> 1) + 32 * (j & 1); }
    return n;
}
template <int MODE>
__device__ __forceinline__ void transpose_item(const float* W, int K, int N, int NP, bf16* WT, LAS float* scr, int item, int lane) {
    const int nblk = NP / 32, kb = item / nblk, nb = item % nblk, k0 = 64 * kb, n0 = 32 * nb;
    const int src = colmap<MODE>(n0 + (lane & 31));
#pragma unroll 8
    for (int i = 0; i < 32; ++i) { const int kk = 2 * i + (lane >> 5); scr[kk * 33 + (lane & 31)] = src >= 0 ? W[(size_t)(k0 + kk) * N + src] : 0.f; }
    LDS_WAIT(); asm volatile("" ::: "memory");
    const int c = lane & 7;
#pragma unroll
    for (int j = 0; j < 4; ++j) { const int n = (lane >> 3) + 8 * j; const LAS float* s = scr + (8 * c) * 33 + n;
        v4u o; o.x = pk2(s[0 * 33], s[1 * 33]); o.y = pk2(s[2 * 33], s[3 * 33]); o.z = pk2(s[4 * 33], s[5 * 33]); o.w = pk2(s[6 * 33], s[7 * 33]);
        *(v4u*)(WT + (size_t)(n0 + n) * K + k0 + 8 * c) = o; }
    LDS_WAIT(); asm volatile("" ::: "memory");
}

__device__ __forceinline__ void p0_prologue(Frame& F) {
    LAS float* scr = (LAS float*)(F.lds + F.wave * 16384);
    const int gw = F.vcu * NWAVES + F.wave, NGW = F.G * NWAVES;
    constexpr int I_IN = (DM / 64) * (NINP / 32), I_OUT = (DM / 64) * (DM / 32), I_1 = (DM / 64) * (DFF / 32), I_2 = (DFF / 64) * (DM / 32);
    constexpr int PER_LAYER = I_IN + I_OUT + I_1 + I_2;
    for (int it = gw; it < DEPTH * PER_LAYER; it += NGW) {
        const int l = it / PER_LAYER; int r = it % PER_LAYER;
        if (r < I_IN) { transpose_item<1>(F.in[I_WIN] + (size_t)l * DM * NIN, DM, NIN, NINP, (bf16*)(F.ws + WS_WIN) + (size_t)l * NINP * DM, scr, r, F.lane); continue; } r -= I_IN;
        if (r < I_OUT) { transpose_item<0>(F.in[I_WOUT] + (size_t)l * DM * DM, DM, DM, DM, (bf16*)(F.ws + WS_WOUT) + (size_t)l * DM * DM, scr, r, F.lane); continue; } r -= I_OUT;
        if (r < I_1) { transpose_item<0>(F.in[I_MW1] + (size_t)l * DM * DFF, DM, DFF, DFF, (bf16*)(F.ws + WS_W1) + (size_t)l * DFF * DM, scr, r, F.lane); continue; } r -= I_1;
        transpose_item<0>(F.in[I_MW2] + (size_t)l * DFF * DM, DFF, DM, DM, (bf16*)(F.ws + WS_W2) + (size_t)l * DM * DFF, scr, r, F.lane);
    }
    {
        __syncthreads();
        LAS float* red = (LAS float*)F.lds;
        const int nl = F.tid & 63, kp = F.tid >> 6;
        for (int it = F.vcu; it < DEPTH * 96; it += F.G) {
            const int l = it / 96, n = (it % 96) * 64 + nl;
            const float* w = F.in[I_ADAW] + (size_t)l * DM * 6144 + n;
            const float* c = F.in[I_C];
            float a = 0.f;
#pragma unroll 8
            for (int k = kp * 128; k < kp * 128 + 128; ++k) { const float cv = c[k]; a += (cv / (1.0f + __expf(-cv))) * w[(size_t)k * 6144]; }
            red[kp * 64 + nl] = a;
            __syncthreads();
            if (kp == 0) { float s = F.in[I_ADAB][l * 6144 + n];
#pragma unroll
                for (int j = 0; j < 8; ++j) s += red[j * 64 + nl];
                ((float*)(F.ws + WS_MOD))[l * 6144 + n] = s; }
            __syncthreads();
        }
    }
    {
        const int gt = F.vcu * NTHREADS + F.tid, NGT = F.G * NTHREADS;
        const int* pos = (const int*)F.in[I_POS];
        f32x2* rt = (f32x2*)(F.ws + WS_ROPE);
        for (int e = gt; e < S * 32; e += NGT) {
            const int r = e >> 5, i = e & 31;
            const float ang = (float)pos[r] * ROPE_FREQ[i];
            float cs, sn; sincos_f(ang, cs, sn);
            rt[e] = (f32x2){cs, sn};
        }
        float* bt = (float*)(F.ws + WS_BIAS);
        for (int e = gt; e < 12 * BIASLEN; e += NGT) {
            const int h = e / BIASLEN, d = e % BIASLEN;
            bt[e] = F.in[I_RELB][t5_bucket(d) * 12 + h] * LOG2E;
        }
    }
}

template <int MODE>
__device__ __forceinline__ void row_pass(Frame& F, const float* xin, float* xout, bf16* H, const float* lng, const float* lnb, const float* sc, const float* sh) {
    const int gw = F.vcu * NWAVES + F.wave, NGW = F.G * NWAVES;
    for (int m = gw; m < S; m += NGW) {
        const f32x4* xr = (const f32x4*)(xin + (size_t)m * DM) + F.lane;
        f32x4 v[4];
#pragma unroll
        for (int j = 0; j < 4; ++j) v[j] = xr[64 * j];
        if (MODE != 0) {
            float s = 0.f;
#pragma unroll
            for (int j = 0; j < 4; ++j) s += (v[j].x + v[j].y) + (v[j].z + v[j].w);
            const float mean = wave_sum(s) * (1.f / DM); float s2 = 0.f;
#pragma unroll
            for (int j = 0; j < 4; ++j) { v[j] = v[j] - mean; s2 += (v[j].x * v[j].x + v[j].y * v[j].y) + (v[j].z * v[j].z + v[j].w * v[j].w); }
            const float rstd = 1.f / sqrtf(wave_sum(s2) * (1.f / DM) + LN_EPS);
            f32x4* xo = (f32x4*)(xout + (size_t)m * DM) + F.lane;
#pragma unroll
            for (int j = 0; j < 4; ++j) { const f32x4 g = ((const f32x4*)lng)[F.lane + 64 * j], b = ((const f32x4*)lnb)[F.lane + 64 * j]; v[j] = v[j] * rstd * g + b; xo[64 * j] = v[j]; }
        }
        if (MODE != 2) {
            v2u* o8 = (v2u*)(H + (size_t)m * DM) + F.lane;
#pragma unroll
            for (int j = 0; j < 4; ++j) { const f32x4 a = ((const f32x4*)sc)[F.lane + 64 * j] + 1.0f, b = ((const f32x4*)sh)[F.lane + 64 * j]; const f32x4 h = v[j] * a + b;
                o8[64 * j] = (v2u){pk2(h.x, h.y), pk2(h.z, h.w)}; }
        }
    }
}

typedef GAS unsigned gu32;
typedef GAS unsigned long long gu64;
#define RLX_AGENT __ATOMIC_RELAXED, __HIP_MEMORY_SCOPE_AGENT
__device__ __forceinline__ unsigned long long rt() { return __builtin_amdgcn_s_memrealtime(); }

#define XB_TMO      128
#define XB_XCNT(j)  (256  + 64 * (j))
#define XB_XSUB(j)  (1280 + 64 * (j))
#define XB_XGEN(j)  (2304 + 64 * (j))
#define XB_TOP      3328
#define XB_TOPGEN   3392
#define XCD_BAR_WORDS 3456
#define XB_SPIN_CAP (1u << 18)

__device__ __forceinline__ unsigned xb_ld(unsigned* p)              { return __hip_atomic_load(p, __ATOMIC_RELAXED, __HIP_MEMORY_SCOPE_AGENT); }
__device__ __forceinline__ unsigned xb_add(unsigned* p, unsigned v) { return __hip_atomic_fetch_add(p, v, __ATOMIC_RELAXED, __HIP_MEMORY_SCOPE_AGENT); }
__device__ __forceinline__ unsigned xb_xcc_id() { return (unsigned)__builtin_amdgcn_s_getreg((3 << 11) | 20) & 0xFu; }
#define XB_SPIN(cond, bar) do { unsigned _sp = 0; while (cond) { __builtin_amdgcn_s_sleep(1); \
    if ((++_sp & 255u) == 0u) { if (xb_ld(&(bar)[XB_TMO])) break; if (_sp > XB_SPIN_CAP) { atomicAdd(&(bar)[XB_TMO], 1u); break; } } } } while (0)

struct XcdBarrier {
    unsigned* bar; unsigned x;
    volatile LAS unsigned* st;
};

__device__ __forceinline__ XcdBarrier xcd_barrier_post(unsigned* bar, volatile LAS unsigned* st) {
    XcdBarrier b; b.bar = bar; b.x = xb_xcc_id(); b.st = st;
    if (threadIdx.x == 0) (void)xb_add(&bar[XB_XCNT(b.x)], 1u);
    return b;
}
__device__ __forceinline__ void xcd_barrier_complete(unsigned* bar, unsigned x, unsigned& nloc, unsigned& nx) {
    const unsigned G = gridDim.x * gridDim.y * gridDim.z;
    unsigned sum, cnt, mine, sp = 0u;
    for (;;) {
        sum = 0u; cnt = 0u; mine = 0u;
#pragma unroll
        for (unsigned j = 0; j < 16; ++j) { const unsigned c = xb_ld(&bar[XB_XCNT(j)]); sum += c; cnt += (c > 0u) ? 1u : 0u; mine = (j == x) ? c : mine; }
        if (sum == G) break;
        __builtin_amdgcn_s_sleep(1);
        if ((++sp & 255u) == 0u) { if (xb_ld(&bar[XB_TMO])) break; if (sp > XB_SPIN_CAP) { atomicAdd(&bar[XB_TMO], 1u); break; } }
    }
    nloc = mine > 0u ? mine : 1u; nx = cnt > 0u ? cnt : 1u;
}

__device__ __forceinline__ void xcd_barrier(const XcdBarrier& b) {
    asm volatile("s_waitcnt vmcnt(0)" ::: "memory");
    __syncthreads();
    if (threadIdx.x == 0) {
        unsigned* bar = b.bar;
        __builtin_amdgcn_s_waitcnt(0);
        unsigned nloc = b.st[0], nx = b.st[1];
        if (nloc == 0u) { xcd_barrier_complete(bar, b.x, nloc, nx); b.st[0] = nloc; b.st[1] = nx; }
        const unsigned old = xb_add(&bar[XB_XSUB(b.x)], 1u);
        const unsigned gen = old / nloc;
        if (old + 1u == (gen + 1u) * nloc) {
            __builtin_amdgcn_fence(__ATOMIC_RELEASE, "agent");
            asm volatile("s_waitcnt vmcnt(0)" ::: "memory");
            const unsigned og = xb_add(&bar[XB_TOP], 1u);
            const unsigned tg = og / nx;
            if (og + 1u == (tg + 1u) * nx) xb_add(&bar[XB_TOPGEN], 1u);
            else XB_SPIN(xb_ld(&bar[XB_TOPGEN]) == tg, bar);
            __builtin_amdgcn_fence(__ATOMIC_ACQUIRE, "agent");
            xb_add(&bar[XB_XGEN(b.x)], 1u);
            asm volatile("s_waitcnt vmcnt(0)" ::: "memory");
        } else {
            XB_SPIN(xb_ld(&bar[XB_XGEN(b.x)]) == gen, bar);
            __builtin_amdgcn_fence(__ATOMIC_ACQUIRE, "agent");
            asm volatile("s_waitcnt vmcnt(0)" ::: "memory");
        }
    }
    __syncthreads();
}


__device__ __forceinline__ float ld_elem(const bf16* p) { return bf2f(*p); }
__device__ __forceinline__ float ld_elem(const float* p) { return *p; }
template <int G>
__device__ __forceinline__ void dot64(const bf16* k, const LAS float* qs, float (&s)[G]) {
    const v4u* kp = (const v4u*)k;
#pragma unroll 2
    for (int c = 0; c < 8; ++c) { const v4u w = kp[c];
        float kv[8] = {bflo(w.x), bfhi(w.x), bflo(w.y), bfhi(w.y), bflo(w.z), bfhi(w.z), bflo(w.w), bfhi(w.w)};
#pragma unroll
        for (int g = 0; g < G; ++g) { const LAS f32x4* q4 = (const LAS f32x4*)(qs + g * 64 + c * 8); const f32x4 a = q4[0], b = q4[1];
            s[g] += kv[0] * a.x + kv[1] * a.y + kv[2] * a.z + kv[3] * a.w + kv[4] * b.x + kv[5] * b.y + kv[6] * b.z + kv[7] * b.w; } }
}
template <int G>
__device__ __forceinline__ void dot64(const float* k, const LAS float* qs, float (&s)[G]) {
    const f32x4* kp = (const f32x4*)k;
#pragma unroll 2
    for (int c = 0; c < 16; ++c) { const f32x4 w = kp[c];
#pragma unroll
        for (int g = 0; g < G; ++g) { const f32x4 a = *(const LAS f32x4*)(qs + g * 64 + c * 4); s[g] += w.x * a.x + w.y * a.y + w.z * a.z + w.w * a.w; } }
}
template <int G, class KT, class KeyFn>
__device__ __forceinline__ void wave_attend(const KT* K, const KT* V, const LAS float* qs, int nk, const KeyFn& kf, float (&m)[G], float (&l)[G], float (&o)[G], int lane) {
    for (int base = 0; base < nk; base += 64) {
        const int i = base + lane;
        long off = 0; float s[G], p[G];
#pragma unroll
        for (int g = 0; g < G; ++g) s[g] = 0.f;
        bool valid = false;
        if (i < nk) valid = kf(i, off, s);
        const LAS float* qo = qs; asm volatile("" : "+v"(qo));
        if (valid) dot64<G>(K + off, qo, s);
        const unsigned long long mask = __ballot(valid);
        if (mask == 0ull) continue;
#pragma unroll
        for (int g = 0; g < G; ++g) {
            const float sv = valid ? s[g] : -1e30f;
            const float mn = fmaxf(m[g], wave_max(sv));
            const float scl = exp2f(m[g] - mn);
            p[g] = valid ? exp2f(sv - mn) : 0.f;
            l[g] = l[g] * scl + wave_sum(p[g]); o[g] *= scl; m[g] = mn;
        }
#pragma unroll 2
        for (int j = 0; j < 64; ++j) {
            if (!((mask >> j) & 1ull)) continue;
            const unsigned olo = __builtin_amdgcn_readlane((unsigned)(unsigned long long)off, j), ohi = __builtin_amdgcn_readlane((unsigned)((unsigned long long)off >> 32), j);
            const long oj = (long)(((unsigned long long)ohi << 32) | olo);
            const float v = ld_elem(V + oj + lane);
#pragma unroll
            for (int g = 0; g < G; ++g) o[g] += __uint_as_float(__builtin_amdgcn_readlane(__float_as_uint(p[g]), j)) * v;
        }
    }
}

struct KeyA { int p, r; const float* bias; __device__ __forceinline__ bool operator()(int i, long& off, float (&b)[1]) const {
    const int row = p - r * i; if (row < 0) return false; off = (long)row * NINP; const int d = r * i; b[0] = bias[d < BIASLEN ? d : BIASLEN - 1]; return true; } };
struct KeyB { int p; __device__ __forceinline__ bool operator()(int i, long& off, float (&b)[2]) const {
    const int row = p - i; if (row < 0) return false; off = (long)row * NINP; return true; } };
struct KeyW { int p; const float* bias; __device__ __forceinline__ bool operator()(int i, long& off, float (&b)[4]) const {
    const int row = p - i; if (row < 0) return false; off = (long)row * NINP;
#pragma unroll
    for (int g = 0; g < 4; ++g) b[g] = bias[g * BIASLEN + i]; return true; } };

__device__ __forceinline__ void load_q(const bf16* q, LAS float* qs, int lane) { qs[lane] = bf2f(q[lane]); }

__device__ __forceinline__ void p2_token_attention(Frame& F, int layer, const bf16* PROJ, bf16* MIXED, bf16* OWIN) {
    LAS float* qs = (LAS float*)(F.lds + F.wave * 2048);
    const int gw = F.vcu * NWAVES + F.wave, NGW = F.G * NWAVES, lane = F.lane;
    const float* bias2 = (const float*)(F.ws + WS_BIAS);
    for (int it = gw; it < S * 4; it += NGW) {
        const int p = it >> 2, h = it & 3;
        load_q(PROJ + (size_t)p * NINP + C_AQ + h * 64, qs, lane); LDS_WAIT(); asm volatile("" ::: "memory");
        float m[1] = {-1e30f}, l[1] = {0.f}, o[1] = {0.f};
        const bf16* K = PROJ + C_AK + h * 64; const bf16* V = PROJ + C_AV + h * 64;
#pragma unroll 1
        for (int c = 0; c < 3; ++c) { const int r = c == 0 ? 1 : (c == 1 ? 4 : 16); KeyA kf{p, r, bias2 + h * BIASLEN}; wave_attend<1>(K, V, qs, 129, kf, m, l, o, lane); }
        MIXED[(size_t)p * DM + h * 64 + lane] = (bf16)f2bf(o[0] / l[0]);
        LDS_WAIT(); asm volatile("" ::: "memory");
    }
    for (int it = gw; it < S * 2; it += NGW) {
        const int p = it >> 1, kvh = it & 1;
        load_q(PROJ + (size_t)p * NINP + C_BQ + (2 * kvh) * 64, qs, lane); load_q(PROJ + (size_t)p * NINP + C_BQ + (2 * kvh + 1) * 64, qs + 64, lane); LDS_WAIT(); asm volatile("" ::: "memory");
        float m[2] = {-1e30f, -1e30f}, l[2] = {0.f, 0.f}, o[2] = {0.f, 0.f};
        KeyB kf{p}; wave_attend<2>(PROJ + C_BK + kvh * 64, PROJ + C_BV + kvh * 64, qs, 128, kf, m, l, o, lane);
#pragma unroll
        for (int g = 0; g < 2; ++g) { const float sk = F.in[I_SINK][layer * 4 + 2 * kvh + g] * LOG2E; const float mn = fmaxf(m[g], sk); const float scl = exp2f(m[g] - mn);
            const float den = l[g] * scl + exp2f(sk - mn); MIXED[(size_t)p * DM + 256 + (2 * kvh + g) * 64 + lane] = (bf16)f2bf(o[g] * scl / den); }
        LDS_WAIT(); asm volatile("" ::: "memory");
    }
    for (int it = gw; it < S * 2; it += NGW) {
        const int p = it >> 1, kvh = it & 1;
#pragma unroll
        for (int g = 0; g < 4; ++g) load_q(PROJ + (size_t)p * NINP + C_CQ + (4 * kvh + g) * 64, qs + g * 64, lane);
        LDS_WAIT(); asm volatile("" ::: "memory");
        float m[4] = {-1e30f, -1e30f, -1e30f, -1e30f}, l[4] = {0.f, 0.f, 0.f, 0.f}, o[4] = {0.f, 0.f, 0.f, 0.f};
        KeyW kf{p, bias2 + (4 + 4 * kvh) * BIASLEN}; wave_attend<4>(PROJ + C_CKW + kvh * 64, PROJ + C_CVW + kvh * 64, qs, 512, kf, m, l, o, lane);
#pragma unroll
        for (int g = 0; g < 4; ++g) OWIN[(size_t)p * 512 + (4 * kvh + g) * 64 + lane] = (bf16)f2bf(o[g] / l[g]);
        LDS_WAIT(); asm volatile("" ::: "memory");
    }
}

__device__ __forceinline__ float gelu_tanh(float x) { const float u = 0.7978845608028654f * (x + 0.044715f * x * x * x); return 0.5f * x * (1.0f + tanhf(u)); }
__device__ __forceinline__ void p2_compress(Frame& F, int layer, const bf16* PROJ) {
    LAS float* flat = (LAS float*)F.lds;
    LAS float* hid = flat + 8 * 2048;
    const int tid = F.tid;
    for (int it = F.vcu; it < 2 * 256; it += F.G) {
        const int kv = it >> 8, rg = it & 255;
        const float* pos = F.in[I_CPOS] + ((size_t)layer * 2 + kv) * 2048;
        const float* w1 = F.in[I_CW1] + ((size_t)layer * 2 + kv) * 2048 * 256;
        const float* w2 = F.in[I_CW2] + ((size_t)layer * 2 + kv) * 256 * 64;
        float* outp = (float*)(F.ws + (kv ? WS_VC : WS_KC));
        __syncthreads();
        for (int e = tid; e < 8 * 2048; e += NTHREADS) {
            const int r = e >> 11, f = e & 2047, R = rg * 8 + r, i = R >> 1, hk = R & 1, t = f >> 6, d = f & 63;
            float v = 0.f;
            if (i < NCMP) v = bf2f(PROJ[(size_t)(16 * i + t) * NINP + (kv ? C_CVC : C_CKC) + hk * 64 + d]) + pos[f];
            flat[e] = v;
        }
        __syncthreads();
        { const int j = tid & 255, half = tid >> 8; float a[4] = {0.f, 0.f, 0.f, 0.f}; const LAS float* fl = flat + half * 4 * 2048;
#pragma unroll 4
            for (int f = 0; f < 2048; ++f) { const float w = w1[(size_t)f * 256 + j];
#pragma unroll
                for (int r = 0; r < 4; ++r) a[r] += fl[r * 2048 + f] * w; }
#pragma unroll
            for (int r = 0; r < 4; ++r) hid[(half * 4 + r) * 256 + j] = gelu_tanh(a[r]); }
        __syncthreads();
        { const int r = tid >> 6, e = tid & 63, R = rg * 8 + r; float a = 0.f;
#pragma unroll 8
            for (int j = 0; j < 256; ++j) a += hid[r * 256 + j] * w2[j * 64 + e];
            if ((R >> 1) < NCMP) outp[(size_t)R * 64 + e] = a; }
    }
    __syncthreads();
}

struct KeyCmp { int g; __device__ __forceinline__ bool operator()(int i, long& off, float (&b)[4]) const { off = ((long)i * 2 + g) * 64; return true; } };
struct KeySel { int p, blk; const float* bias; __device__ __forceinline__ bool operator()(int i, long& off, float (&b)[4]) const {
    const int kpos = blk * 64 + i; if (kpos > p) return false; off = (long)kpos * NINP; const int d = p - kpos;
#pragma unroll
    for (int g = 0; g < 4; ++g) b[g] = bias[g * BIASLEN + (d < BIASLEN ? d : BIASLEN - 1)]; return true; } };

__device__ __forceinline__ void p3_nsa(Frame& F, int layer, const bf16* PROJ, const bf16* OWIN, bf16* MIXED) {
    LAS float* qs = (LAS float*)(F.lds + F.wave * 8192);
    LAS float* imp = qs + 256;
    const int gw = F.vcu * NWAVES + F.wave, NGW = F.G * NWAVES, lane = F.lane;
    const float* bias2 = (const float*)(F.ws + WS_BIAS);
    const float* KC = (const float*)(F.ws + WS_KC); const float* VC = (const float*)(F.ws + WS_VC);
    for (int it = gw; it < S * 2; it += NGW) {
        const int p = it >> 1, kvh = it & 1;
#pragma unroll
        for (int g = 0; g < 4; ++g) load_q(PROJ + (size_t)p * NINP + C_CQ + (4 * kvh + g) * 64, qs + g * 64, lane);
        for (int e = lane; e < 1040; e += 64) imp[e] = 0.f;
        LDS_WAIT(); asm volatile("" ::: "memory");
        int nv = p >= 31 ? ((p - 31) >> 4) + 1 : 0; if (nv > NCMP) nv = NCMP;
        float m1[4] = {-1e30f, -1e30f, -1e30f, -1e30f}, l1[4] = {0.f, 0.f, 0.f, 0.f}, o1[4] = {0.f, 0.f, 0.f, 0.f};
        { KeyCmp kf{kvh}; wave_attend<4>(KC, VC, qs, nv, kf, m1, l1, o1, lane); }
        for (int base = 0; base < nv; base += 64) { const int i = base + lane;
            const LAS float* qo = qs; asm volatile("" : "+v"(qo));
            if (i < nv) { float s[4] = {0.f, 0.f, 0.f, 0.f}; dot64<4>(KC + ((size_t)i * 2 + kvh) * 64, qo, s); float a = 0.f;
#pragma unroll
                for (int g = 0; g < 4; ++g) a += exp2f(s[g] - m1[g]) / fmaxf(l1[g], 1e-30f);
                imp[1 + i] = a; } }
        LDS_WAIT(); asm volatile("" ::: "memory");
        const int cur = p >> 6;
        float sc[4];
#pragma unroll
        for (int c = 0; c < 4; ++c) { const int j = lane + 64 * c; const LAS float* q = imp + 4 * j;
            const float is = 0.5f * q[0] + q[1] + q[2] + q[3] + 0.5f * q[4];
            const bool forced = (j == 0) || (j == cur) || (j == cur - 1);
            sc[c] = forced ? 1e4f : ((j * 64 <= p) ? is : -1e30f); }
        float m2[4] = {-1e30f, -1e30f, -1e30f, -1e30f}, l2[4] = {0.f, 0.f, 0.f, 0.f}, o2[4] = {0.f, 0.f, 0.f, 0.f};
#pragma unroll 1
        for (int k = 0; k < 16; ++k) {
            float bv = sc[0]; int bi = lane;
#pragma unroll
            for (int c = 1; c < 4; ++c) if (sc[c] > bv) { bv = sc[c]; bi = lane + 64 * c; }
#pragma unroll
            for (int off = 1; off < 64; off <<= 1) { const float ov = __shfl_xor(bv, off); const int oi = __shfl_xor(bi, off); if (ov > bv || (ov == bv && oi < bi)) { bv = ov; bi = oi; } }
#pragma unroll
            for (int c = 0; c < 4; ++c) if (bi == lane + 64 * c) sc[c] = -3e38f;
            if (bi * 64 <= p) { KeySel kf{p, bi, bias2 + (4 + 4 * kvh) * BIASLEN}; wave_attend<4>(PROJ + C_CKS + kvh * 64, PROJ + C_CVS + kvh * 64, qs, 64, kf, m2, l2, o2, lane); }
        }
#pragma unroll
        for (int g = 0; g < 4; ++g) { const int H = 4 * kvh + g;
            const float g0 = bf2f(PROJ[(size_t)p * NINP + C_CG + H * 3 + 0]), g1 = bf2f(PROJ[(size_t)p * NINP + C_CG + H * 3 + 1]), g2 = bf2f(PROJ[(size_t)p * NINP + C_CG + H * 3 + 2]);
            const float ocmp = o1[g] / fmaxf(l1[g], 1e-30f), oslc = o2[g] / l2[g], owin = bf2f(OWIN[(size_t)p * 512 + H * 64 + lane]);
            MIXED[(size_t)p * DM + 512 + H * 64 + lane] = (bf16)f2bf(g0 * ocmp + g1 * oslc + g2 * owin); }
        LDS_WAIT(); asm volatile("" ::: "memory");
    }
}

constexpr int N_PHASES = 2 + 8 * DEPTH;
__device__ __forceinline__ void run_phase(Frame& F, int ph) {
    unsigned char* ws = F.ws;
    const float* mod = (const float*)(ws + WS_MOD);
    if (ph == 0) { p0_prologue(F); return; }
    if (ph == 1) { row_pass<0>(F, F.in[I_X], nullptr, (bf16*)(ws + WS_RA), nullptr, nullptr, mod + 1024, mod + 0); return; }
    const int l = (ph - 2) >> 3, sub = (ph - 2) & 7;
    const float* modl = mod + l * 6144;
    bf16* bufX = (bf16*)(ws + ((l & 1) ? WS_RB : WS_RA));
    bf16* bufY = (bf16*)(ws + ((l & 1) ? WS_RA : WS_RB));
    bf16* PROJ = (bf16*)(ws + WS_BIG); bf16* HID = (bf16*)(ws + WS_BIG); bf16* OWIN = (bf16*)(ws + WS_OWIN);
    const float* xres = (l == 0) ? F.in[I_X] : F.out;
    switch (sub) {
    case 0: {
        pg8::Gemm g{bufX, (const bf16*)(ws + WS_WIN) + (size_t)l * NINP * DM, S, NINP, DM}; pg8::StaticOrder So; So.init(S, NINP, F.G, (int)blockIdx.x);
        pg8::EpiInProj E{PROJ, NINP, (const float*)(ws + WS_ROPE), QSCALE};
        pg8::gemm_phase<pg8::EpiInProj, pg8::StaticOrder, PG8_ALIGN, PG8_SP2>(F.lds, g, So, E, F.wave);
    } break;
    case 1: p2_compress(F, l, PROJ); p2_token_attention(F, l, PROJ, bufY, OWIN); break;
    case 2: p3_nsa(F, l, PROJ, OWIN, bufY); break;
    case 3: {
        pg8::Gemm g{bufY, (const bf16*)(ws + WS_WOUT) + (size_t)l * DM * DM, S, DM, DM}; pg8::StaticOrder So; So.init(S, DM, F.G, (int)blockIdx.x);
        pg8::EpiResid E{xres, F.out, DM, modl + 2048, DN_ALPHA};
        pg8::gemm_phase<pg8::EpiResid, pg8::StaticOrder, PG8_ALIGN, PG8_SP2>(F.lds, g, So, E, F.wave);
    } break;
    case 4: row_pass<1>(F, F.out, F.out, bufX, F.in[I_LNG] + (l * 2 + 0) * DM, F.in[I_LNB] + (l * 2 + 0) * DM, modl + 4096, modl + 3072); break;
    case 5: {
        pg8::Gemm g{bufX, (const bf16*)(ws + WS_W1) + (size_t)l * DFF * DM, S, DFF, DM}; pg8::StaticOrder So; So.init(S, DFF, F.G, (int)blockIdx.x);
        pg8::EpiRelu2 E{HID, DFF};
        pg8::gemm_phase<pg8::EpiRelu2, pg8::StaticOrder, PG8_ALIGN, PG8_SP2>(F.lds, g, So, E, F.wave);
    } break;
    case 6: {
        pg8::Gemm g{HID, (const bf16*)(ws + WS_W2) + (size_t)l * DM * DFF, S, DM, DFF}; pg8::StaticOrder So; So.init(S, DM, F.G, (int)blockIdx.x);
        pg8::EpiResid E{F.out, F.out, DM, modl + 5120, DN_ALPHA};
        pg8::gemm_phase<pg8::EpiResid, pg8::StaticOrder, PG8_ALIGN, PG8_SP2>(F.lds, g, So, E, F.wave);
    } break;
    default: {
        if (l + 1 < DEPTH) row_pass<1>(F, F.out, F.out, bufY, F.in[I_LNG] + (l * 2 + 1) * DM, F.in[I_LNB] + (l * 2 + 1) * DM, modl + 6144 + 1024, modl + 6144 + 0);
        else row_pass<2>(F, F.out, F.out, nullptr, F.in[I_LNG] + (l * 2 + 1) * DM, F.in[I_LNB] + (l * 2 + 1) * DM, nullptr, nullptr);
    } break;
    }
}

__global__ void __launch_bounds__(NTHREADS, 2) fwd_kernel(Args args) {
    extern __shared__ __attribute__((aligned(16))) unsigned char lds[];
    Frame F;
    F.lds = (LAS unsigned char*)lds;
    F.tid = threadIdx.x; F.lane = F.tid & 63; F.wave = __builtin_amdgcn_readfirstlane(F.tid >> 6);
    F.G = gridDim.x; { const int bx = blockIdx.x; F.vcu = (F.G % 8 == 0) ? (bx % 8) * (F.G / 8) + bx / 8 : bx; }
    F.ws = args.ws; F.out = args.out;
#pragma unroll
    for (int i = 0; i < 16; ++i) F.in[i] = args.in[i];
    for (int u = F.tid; u < (LDS_BYTES - LDSCTL_OFF) / 4; u += NTHREADS) ((LAS unsigned*)(F.lds + LDSCTL_OFF))[u] = 0u;
    __syncthreads();
    const int wave0 = __builtin_amdgcn_readfirstlane(threadIdx.x >> 6);
    const bool multi = (args.ph_hi - args.ph_lo) > 1;
    XcdBarrier bar; bar.bar = (unsigned*)(F.ws + WS_CTL) + 4096; bar.x = 0; bar.st = nullptr;
    if (multi) bar = xcd_barrier_post((unsigned*)(F.ws + WS_CTL) + 4096, (volatile LAS unsigned*)(F.lds + MISC_OFF) + 8);
    for (int ph = args.ph_lo; ph < args.ph_hi; ++ph) {
        { int ln = __builtin_amdgcn_mbcnt_hi(~0u, __builtin_amdgcn_mbcnt_lo(~0u, 0u)); asm volatile("" : "+v"(ln)); F.lane = ln; F.wave = wave0; F.tid = wave0 * 64 + ln; }
        run_phase(F, ph);
        if (ph + 1 < args.ph_hi) xcd_barrier(bar);
    }
}

#ifndef N_LAUNCH_MODE
#define N_LAUNCH_MODE 1
#endif
extern "C" void kernel_launch(void* const* d_in, const int* in_sizes, int n_in, void* d_out, int out_size, void* d_ws, size_t ws_size, hipStream_t stream) {
    static int grid = 0;
    if (grid == 0) {
        if (n_in != 16 || out_size != S * DM || ws_size < WS_END) { fprintf(stderr, "kernel_launch: unexpected shapes (n_in %d out %d ws %zu)\n", n_in, out_size, ws_size); grid = -1; return; }
        int dev = 0, cus = 0;
        if (hipGetDevice(&dev) != hipSuccess || hipDeviceGetAttribute(&cus, hipDeviceAttributeMultiprocessorCount, dev) != hipSuccess) { grid = -1; return; }
        if (hipFuncSetAttribute((const void*)fwd_kernel, hipFuncAttributeMaxDynamicSharedMemorySize, LDS_BYTES) != hipSuccess) { fprintf(stderr, "kernel_launch: hipFuncSetAttribute failed\n"); grid = -1; return; }
        int per_cu = 0;
        if (hipOccupancyMaxActiveBlocksPerMultiprocessor(&per_cu, (const void*)fwd_kernel, NTHREADS, LDS_BYTES) != hipSuccess || per_cu < 1) fprintf(stderr, "kernel_launch: occupancy query says %d\n", per_cu);
        (void)hipGetLastError();
        grid = cus;
    }
    if (grid < 0) return;
    (void)hipMemsetAsync((char*)d_ws + WS_CTL, 0, CTL_ZERO_BYTES, stream);
    Args a{};
    for (int i = 0; i < 16; ++i) a.in[i] = (const float*)d_in[i];
    a.out = (float*)d_out; a.ws = (unsigned char*)d_ws;
#if N_LAUNCH_MODE == 1
    a.ph_lo = 0; a.ph_hi = N_PHASES;
    hipLaunchKernelGGL(fwd_kernel, dim3(grid), dim3(NTHREADS), LDS_BYTES, stream, a);
#else
    for (int ph = 0; ph < N_PHASES; ++ph) { a.ph_lo = ph; a.ph_hi = ph + 1; hipLaunchKernelGGL(fwd_kernel, dim3(grid), dim3(NTHREADS), LDS_BYTES, stream, a); }
#endif
}
```

```cpp
#include <hip/hip_runtime.h>
#include <cstdio>
#include <cstdint>
#include <cmath>
namespace pg8 {
#define PG8_LAS __attribute__((address_space(3)))
typedef unsigned short bf16_t;
typedef short bf16x8 __attribute__((ext_vector_type(8)));
typedef float f32x4 __attribute__((ext_vector_type(4)));
typedef unsigned u32x4 __attribute__((ext_vector_type(4)));
constexpr int BM = 256, BK = 64, HALF = 128, HTB = HALF * BK * 2  , STAGE_BYTES = 8 * HTB, NXCD = 8, WGM = 8;

__host__ __device__ __forceinline__ int lds_byte(int r, int c) { const int st = (r >> 4) * 2 + (c >> 5), rr = r & 15, cc = c & 31, ob = rr * 64 + cc * 2; return st * 1024 + (ob ^ (((ob >> 9) & 1) << 5)); }
__host__ __device__ __forceinline__ void stage_rc(int b, int& R, int& C) { const int st = b / 1024, sb = b % 1024, swz = sb ^ (((sb >> 9) & 1) << 5); R = (st >> 1) * 16 + swz / 64; C = (st & 1) * 32 + (swz % 64) / 2; }
__host__ __device__ __forceinline__ int perm32(int rho) { const int n = rho >> 4, i = rho & 15; return 8 * (i >> 2) + 4 * n + (i & 3); }

struct Unit { int pm, pn; };
struct Gemm { const bf16_t* A; const bf16_t* Bt; int M, N, K; };

struct StaticOrder {
    int nM, nN, nwg, G, c;
    __host__ __device__ void init(int M, int N, int G_, int c_) { nM = M / BM; nN = N / BM; nwg = nM * nN; G = G_; c = c_; }
    __host__ __device__ bool next(int i, Unit& u) const {
        const long L = (long)i * G + c; if (L >= nwg) return false;
        int wgid = (int)L; { const int q = nwg / NXCD, r = nwg % NXCD, xcd = wgid % NXCD, off = wgid / NXCD; wgid = (xcd < r ? xcd * (q + 1) : r * (q + 1) + (xcd - r) * q) + off; }
        const int nig = WGM * nN, gid = wgid / nig, fm = gid * WGM, gsz = (nM - fm) < WGM ? (nM - fm) : WGM;
        u.pm = fm + ((wgid % nig) % gsz); u.pn = (wgid % nig) / gsz; return true;
    }
    __device__ __forceinline__ void a_ready(const Unit&) const {}
    __device__ __forceinline__ void done(const Unit&) const {}
};


__device__ __forceinline__ unsigned cvt_pk_bf16(float lo, float hi) { unsigned r; asm volatile("v_cvt_pk_bf16_f32 %0, %1, %2" : "=v"(r) : "v"(lo), "v"(hi)); return r; }
typedef float f32x2 __attribute__((ext_vector_type(2)));

struct EpiInProj {
    static constexpr bool PERM = true, AFTER_DRAIN = false;
    bf16_t* O; int ldc; const float* rope; float qscale;
    __device__ __forceinline__ void operator()(const f32x4 (&acc)[2][2][4][2], const Unit& u, int wr, int wc, int fr, int fq) const {
        const int row0 = u.pm * BM + wr * 64 + fr; const int col0 = u.pn * BM + wc * 32 + 8 * fq;
        const int i0 = 16 * (wc & 1) + 4 * fq;
#pragma unroll
        for (int bj = 0; bj < 2; ++bj) {
            const int pn = u.pn;
            const bool do_rope = (pn == 3) || (pn == 4 && bj == 0);
            const bool do_sig = (pn == 10);
            const float sc = (pn == 0 || pn == 3 || pn == 5 || pn == 6) ? qscale : 1.0f;
#pragma unroll
            for (int ai = 0; ai < 2; ++ai)
#pragma unroll
                for (int m = 0; m < 4; ++m) {
                    const int row = row0 + ai * HALF + m * 16;
                    f32x4 v0 = acc[ai][bj][m][0], v1 = acc[ai][bj][m][1];
                    if (do_rope) {
                        const f32x4* rp = (const f32x4*)(rope + ((size_t)row * 32 + i0) * 2);
                        const f32x4 c01 = rp[0], c23 = rp[1];
                        f32x4 w0, w1;
                        w0[0] = v0[0] * c01[0] - v0[1] * c01[1]; w0[1] = v0[1] * c01[0] + v0[0] * c01[1];
                        w0[2] = v0[2] * c01[2] - v0[3] * c01[3]; w0[3] = v0[3] * c01[2] + v0[2] * c01[3];
                        w1[0] = v1[0] * c23[0] - v1[1] * c23[1]; w1[1] = v1[1] * c23[0] + v1[0] * c23[1];
                        w1[2] = v1[2] * c23[2] - v1[3] * c23[3]; w1[3] = v1[3] * c23[2] + v1[2] * c23[3];
                        v0 = w0; v1 = w1;
                    }
                    if (do_sig) {
#pragma unroll
                        for (int e = 0; e < 4; ++e) { v0[e] = 1.0f / (1.0f + __expf(-v0[e])); v1[e] = 1.0f / (1.0f + __expf(-v1[e])); }
                    }
                    v0 = v0 * sc; v1 = v1 * sc;
                    u32x4 w; w.x = cvt_pk_bf16(v0[0], v0[1]); w.y = cvt_pk_bf16(v0[2], v0[3]); w.z = cvt_pk_bf16(v1[0], v1[1]); w.w = cvt_pk_bf16(v1[2], v1[3]);
                    *(u32x4*)(O + (size_t)row * ldc + col0 + bj * HALF) = w;
                }
        }
    }
};
struct EpiRelu2 {
    static constexpr bool PERM = true, AFTER_DRAIN = false;
    bf16_t* O; int ldc;
    __device__ __forceinline__ void operator()(const f32x4 (&acc)[2][2][4][2], const Unit& u, int wr, int wc, int fr, int fq) const {
        const int row0 = u.pm * BM + wr * 64 + fr; const int col0 = u.pn * BM + wc * 32 + 8 * fq;
#pragma unroll
        for (int ai = 0; ai < 2; ++ai)
#pragma unroll
            for (int m = 0; m < 4; ++m) { bf16_t* rowp = O + (size_t)(row0 + ai * HALF + m * 16) * ldc + col0;
#pragma unroll
                for (int bj = 0; bj < 2; ++bj) { f32x4 v0 = acc[ai][bj][m][0], v1 = acc[ai][bj][m][1];
#pragma unroll
                    for (int e = 0; e < 4; ++e) { const float a = fmaxf(v0[e], 0.f), b = fmaxf(v1[e], 0.f); v0[e] = a * a; v1[e] = b * b; }
                    u32x4 w; w.x = cvt_pk_bf16(v0[0], v0[1]); w.y = cvt_pk_bf16(v0[2], v0[3]); w.z = cvt_pk_bf16(v1[0], v1[1]); w.w = cvt_pk_bf16(v1[2], v1[3]);
                    *(u32x4*)(rowp + bj * HALF) = w; } }
    }
};
struct EpiResid {
    static constexpr bool PERM = false, AFTER_DRAIN = false;
    const float* base; float* out; int ldc; const float* gate; float alpha;
    __device__ __forceinline__ void operator()(const f32x4 (&acc)[2][2][4][2], const Unit& u, int wr, int wc, int fr, int fq) const {
        const int col0 = u.pn * BM + wc * 32 + 4 * fq;
#pragma unroll
        for (int bj = 0; bj < 2; ++bj)
#pragma unroll
            for (int n = 0; n < 2; ++n) { const f32x4 gv = *(const f32x4*)(gate + col0 + bj * HALF + n * 16) + 1.0f;
#pragma unroll
                for (int ai = 0; ai < 2; ++ai)
#pragma unroll
                    for (int m = 0; m < 4; ++m) { const size_t off = (size_t)(u.pm * BM + ai * HALF + wr * 64 + m * 16 + fr) * ldc + col0 + bj * HALF + n * 16;
                        const f32x4 bs = *(const f32x4*)(base + off); *(f32x4*)(out + off) = bs * alpha + gv * acc[ai][bj][m][n]; } }
    }
};
template <class Epi, class Sched, bool ALIGN_EPI = false, bool SP2 = false>
__device__ __forceinline__ void gemm_phase(PG8_LAS unsigned char* lds, const Gemm g, const Sched& S, const Epi& E, const int wid  ) {
    int lane_ = __builtin_amdgcn_mbcnt_hi(~0u, __builtin_amdgcn_mbcnt_lo(~0u, 0u)); asm volatile("" : "+v"(lane_));
    const int lane = lane_, tid = wid * 64 + lane, wr = wid >> 2, wc = wid & 3, fr = lane & 15, fq = lane >> 4;
    const int K = g.K, nt = K / BK;
    unsigned voffA[2], voffB[2];
#pragma unroll
    for (int i = 0; i < 2; ++i) { int R, C; stage_rc(tid * 16 + i * 8192, R, C); const int Rb = Epi::PERM ? ((R & ~31) + perm32(R & 31)) : R;
        voffA[i] = (unsigned)(R * K + C) * 2u; voffB[i] = (unsigned)(Rb * K + C) * 2u; }
    const size_t kstep = (size_t)(BK * 2);
    const size_t hstep = (size_t)HALF * K * 2;
    const size_t tstep = 2 * hstep;
    const unsigned ldsw = (unsigned)wid * 1024u;
    const int aoff = lds_byte(wr * 64 + fr, fq * 8), boff = lds_byte(wc * 32 + fr, fq * 8);
#define PG8_SA(b, h) (((b) * 2 + (h)) * HTB)
#define PG8_SB(b, h) ((4 + (b) * 2 + (h)) * HTB)
#define PG8_STAGE(bufoff, gbase, voff) do { _Pragma("unroll") for (int _i = 0; _i < 2; ++_i) \
        __builtin_amdgcn_global_load_lds((const unsigned*)((const char*)(gbase) + (voff)[_i]), (PG8_LAS unsigned*)(lds + (bufoff) + ldsw + _i * 8192), 16, 0, 0); } while (0)
#define PG8_LDA(dst, b, h) do { _Pragma("unroll") for (int m = 0; m < 4; ++m) _Pragma("unroll") for (int k = 0; k < 2; ++k) dst[m][k] = *(const PG8_LAS bf16x8*)(lds + PG8_SA(b, h) + aoff + m * 2048 + k * 1024); } while (0)
#define PG8_LDB(dst, b, h) do { _Pragma("unroll") for (int n = 0; n < 2; ++n) _Pragma("unroll") for (int k = 0; k < 2; ++k) dst[n][k] = *(const PG8_LAS bf16x8*)(lds + PG8_SB(b, h) + boff + n * 2048 + k * 1024); } while (0)
#define PG8_MMA(ai, bj, At, Bt) do { __builtin_amdgcn_s_setprio(1); _Pragma("unroll") for (int m = 0; m < 4; ++m) _Pragma("unroll") for (int n = 0; n < 2; ++n) _Pragma("unroll") for (int k = 0; k < 2; ++k) \
        acc[ai][bj][m][n] = __builtin_amdgcn_mfma_f32_16x16x32_bf16(Bt[n][k], At[m][k], acc[ai][bj][m][n], 0, 0, 0); __builtin_amdgcn_s_setprio(0); } while (0)
#define PG8_WAIT_V(n) asm volatile("s_waitcnt vmcnt(" #n ")" ::: "memory")
#define PG8_WAIT_L(n) asm volatile("s_waitcnt lgkmcnt(" #n ")" ::: "memory")
#define PG8_BAR __builtin_amdgcn_s_barrier()
#define PG8_SCHED __builtin_amdgcn_sched_barrier(0)
    Unit cur, nxt; int ui = 0;
    if (!S.next(0, cur)) return;
    f32x4 acc[2][2][4][2];
#pragma unroll
    for (int a = 0; a < 2; ++a)
#pragma unroll
        for (int b = 0; b < 2; ++b)
#pragma unroll
            for (int m = 0; m < 4; ++m)
#pragma unroll
                for (int n = 0; n < 2; ++n) acc[a][b][m][n] = (f32x4){0.f, 0.f, 0.f, 0.f};
    bf16x8 At[4][2], B0[2][2], B1[2][2];
    const char* cA = (const char*)g.A + (size_t)cur.pm * tstep; const char* cB = (const char*)g.Bt + (size_t)cur.pn * tstep;
    S.a_ready(cur);
    if constexpr (SP2) {
        PG8_STAGE(PG8_SB(0, 0), cB, voffB); PG8_STAGE(PG8_SB(0, 1), cB + hstep, voffB); PG8_STAGE(PG8_SA(0, 0), cA, voffA); PG8_STAGE(PG8_SA(0, 1), cA + hstep, voffA);
        if (wr == 1) PG8_BAR;
        PG8_WAIT_V(2); PG8_BAR;
        PG8_STAGE(PG8_SB(1, 0), cB + kstep, voffB); PG8_STAGE(PG8_SA(1, 0), cA + kstep, voffA); PG8_STAGE(PG8_SB(1, 1), cB + hstep + kstep, voffB);
        PG8_WAIT_V(6); PG8_BAR;
    } else {
        PG8_STAGE(PG8_SB(0, 0), cB, voffB); PG8_STAGE(PG8_SA(0, 0), cA, voffA); PG8_STAGE(PG8_SB(0, 1), cB + hstep, voffB); PG8_STAGE(PG8_SA(0, 1), cA + hstep, voffA);
        if (wr == 1) PG8_BAR;
        PG8_WAIT_V(4); PG8_BAR;
        PG8_STAGE(PG8_SB(1, 0), cB + kstep, voffB); PG8_STAGE(PG8_SA(1, 0), cA + kstep, voffA); PG8_STAGE(PG8_SB(1, 1), cB + hstep + kstep, voffB);
        PG8_WAIT_V(6); PG8_BAR;
    }
    for (;;) {
        const bool has_next = S.next(ui + 1, nxt);
        const char* nA = has_next ? (const char*)g.A + (size_t)nxt.pm * tstep : cA; const char* nB = has_next ? (const char*)g.Bt + (size_t)nxt.pn * tstep : cB;
        for (int t = 0; t < nt; t += 2) {
            const bool last = (t == nt - 2);
            const char* a1 = cA + (size_t)(t + 1) * kstep;
            const char* a2 = last ? nA : cA + (size_t)(t + 2) * kstep; const char* b2 = last ? nB : cB + (size_t)(t + 2) * kstep;
            const char* a3 = a2 + kstep; const char* b3 = b2 + kstep;
            if (last && has_next) S.a_ready(nxt);
            if constexpr (SP2) {
            PG8_LDB(B0, 0, 0); PG8_LDB(B1, 0, 1); PG8_SCHED; PG8_LDA(At, 0, 0); PG8_STAGE(PG8_SA(1, 1), a1 + hstep, voffA);
            PG8_WAIT_V(8); PG8_WAIT_L(0); PG8_BAR; PG8_MMA(0, 0, At, B0); PG8_MMA(0, 1, At, B1); PG8_BAR; PG8_SCHED;
            PG8_LDA(At, 0, 1); PG8_STAGE(PG8_SB(0, 0), b2, voffB); PG8_STAGE(PG8_SB(0, 1), b2 + hstep, voffB); PG8_STAGE(PG8_SA(0, 0), a2, voffA);
            PG8_WAIT_V(8); PG8_WAIT_L(0); PG8_BAR; PG8_MMA(1, 0, At, B0); PG8_MMA(1, 1, At, B1); PG8_BAR; PG8_SCHED;
            PG8_LDB(B0, 1, 0); PG8_LDB(B1, 1, 1); PG8_SCHED; PG8_LDA(At, 1, 0); PG8_STAGE(PG8_SA(0, 1), a2 + hstep, voffA);
            PG8_WAIT_V(8); PG8_WAIT_L(0); PG8_BAR; PG8_MMA(0, 0, At, B0); PG8_MMA(0, 1, At, B1); PG8_BAR; PG8_SCHED;
            PG8_LDA(At, 1, 1); PG8_STAGE(PG8_SB(1, 0), b3, voffB); PG8_STAGE(PG8_SB(1, 1), b3 + hstep, voffB); PG8_STAGE(PG8_SA(1, 0), a3, voffA);
            PG8_WAIT_V(8); PG8_WAIT_L(0); PG8_BAR; PG8_MMA(1, 0, At, B0); PG8_MMA(1, 1, At, B1); PG8_BAR; PG8_SCHED;
            } else {
            PG8_LDB(B0, 0, 0); PG8_SCHED; PG8_LDA(At, 0, 0); PG8_STAGE(PG8_SA(1, 1), a1 + hstep, voffA);
            PG8_WAIT_L(8); PG8_BAR; PG8_WAIT_L(0); PG8_MMA(0, 0, At, B0); PG8_BAR; PG8_SCHED;
            PG8_LDB(B1, 0, 1); PG8_STAGE(PG8_SB(0, 0), b2, voffB);
            PG8_BAR; PG8_WAIT_L(0); PG8_MMA(0, 1, At, B1); PG8_BAR;
            PG8_LDA(At, 0, 1); PG8_STAGE(PG8_SA(0, 0), a2, voffA);
            PG8_BAR; PG8_WAIT_L(0); PG8_MMA(1, 0, At, B0); PG8_BAR; PG8_SCHED;
            PG8_STAGE(PG8_SB(0, 1), b2 + hstep, voffB);
            PG8_WAIT_V(6); PG8_BAR; PG8_MMA(1, 1, At, B1); PG8_BAR;
            PG8_LDB(B0, 1, 0); PG8_SCHED; PG8_LDA(At, 1, 0); PG8_STAGE(PG8_SA(0, 1), a2 + hstep, voffA);
            PG8_WAIT_L(8); PG8_BAR; PG8_WAIT_L(0); PG8_MMA(0, 0, At, B0); PG8_BAR; PG8_SCHED;
            PG8_LDB(B1, 1, 1); PG8_STAGE(PG8_SB(1, 0), b3, voffB);
            PG8_BAR; PG8_WAIT_L(0); PG8_MMA(0, 1, At, B1); PG8_BAR;
            PG8_LDA(At, 1, 1); PG8_STAGE(PG8_SA(1, 0), a3, voffA);
            PG8_BAR; PG8_WAIT_L(0); PG8_MMA(1, 0, At, B0); PG8_BAR; PG8_SCHED;
            PG8_STAGE(PG8_SB(1, 1), b3 + hstep, voffB);
            PG8_WAIT_V(6); PG8_BAR; PG8_MMA(1, 1, At, B1); PG8_BAR;
            }
        }
        if constexpr (ALIGN_EPI) { if (wr == 0) PG8_BAR; }
        if constexpr (!Epi::AFTER_DRAIN) { E(acc, cur, wr, wc, fr, fq); S.done(cur); }
        if (!has_next) break;
#pragma unroll
        for (int a = 0; a < 2; ++a)
#pragma unroll
            for (int b = 0; b < 2; ++b)
#pragma unroll
                for (int m = 0; m < 4; ++m)
#pragma unroll
                    for (int n = 0; n < 2; ++n) acc[a][b][m][n] = (f32x4){0.f, 0.f, 0.f, 0.f};
        cur = nxt; cA = nA; cB = nB; ++ui;
        if constexpr (ALIGN_EPI) { if (wr == 1) PG8_BAR; }
    }
    PG8_WAIT_V(0);
    if constexpr (!ALIGN_EPI) { if (wr == 0) PG8_BAR; }
    PG8_BAR;
    if constexpr (Epi::AFTER_DRAIN) { E.fused(acc, cur, wr, wc, fr, fq, lds, wid, lane); S.done(cur); }
#undef PG8_SA
#undef PG8_SB
#undef PG8_STAGE
#undef PG8_LDA
#undef PG8_LDB
#undef PG8_MMA
#undef PG8_WAIT_V
#undef PG8_WAIT_L
#undef PG8_BAR
#undef PG8_SCHED
}
}

#ifndef PG8_SP2
#define PG8_SP2 true
#endif
#ifndef PG8_ALIGN
#define PG8_ALIGN true
#endif

constexpr int S = 16384, DM = 1024, NIN = 2584, NINP = 2816, DFF = 4096, DEPTH = 4;
constexpr int NWAVES = 8, NTHREADS = 512;
constexpr float LN_EPS = 1e-5f;
constexpr float LOG2E = 1.4426950408889634f;
constexpr float QSCALE = 0.125f * LOG2E;
constexpr float DN_ALPHA = 1.681792830507429f;
constexpr int C_AQ = 0, C_AK = 256, C_AV = 512, C_BQ = 768, C_BK = 1024, C_BV = 1152, C_CQ = 1280, C_CKC = 1792, C_CVC = 1920,
              C_CKS = 2048, C_CVS = 2176, C_CKW = 2304, C_CVW = 2432, C_CG = 2560;
constexpr int NCMP = 1023, NSEL = 256;
constexpr int BIASLEN = 2048;

constexpr size_t MiB = 1u << 20;
constexpr size_t WS_CTL = 0, CTL_ZERO_BYTES = 1 * MiB;
constexpr size_t WS_MOD = 1 * MiB;
constexpr size_t WS_BIAS = 1 * MiB + 128 * 1024;
constexpr size_t WS_BMAX = 1 * MiB + 256 * 1024;
constexpr size_t WS_ROPE = 2 * MiB;
constexpr size_t WS_KC = 6 * MiB, WS_VC = 6 * MiB + 512 * 1024;
constexpr size_t WS_WIN = 8 * MiB;
constexpr size_t WS_WOUT = 30 * MiB;
constexpr size_t WS_W1 = 38 * MiB;
constexpr size_t WS_W2 = 70 * MiB;
constexpr size_t WS_CW1 = 102 * MiB;
constexpr size_t WS_RA = 110 * MiB, WS_RB = 142 * MiB;
constexpr size_t WS_BIG = 174 * MiB;
constexpr size_t WS_OWIN = 302 * MiB;
constexpr size_t WS_OA3 = 318 * MiB;
constexpr size_t WS_LSE = 342 * MiB;
constexpr size_t WS_END = 343 * MiB;

#define GAS __attribute__((address_space(1)))
#define LAS __attribute__((address_space(3)))
typedef unsigned short bf16;
typedef unsigned v4u __attribute__((ext_vector_type(4)));
typedef unsigned v2u __attribute__((ext_vector_type(2)));
typedef float f32x4 __attribute__((ext_vector_type(4)));
typedef float f32x2 __attribute__((ext_vector_type(2)));
#define LDS_WAIT() asm volatile("s_waitcnt lgkmcnt(0)" ::: "memory")
#define VM_WAIT() asm volatile("s_waitcnt vmcnt(0)" ::: "memory")
__device__ __forceinline__ unsigned f2bf(float f) { unsigned u = __builtin_bit_cast(unsigned, f); return (u + 0x7fffu + ((u >> 16) & 1u)) >> 16; }
__device__ __forceinline__ unsigned pk2(float lo, float hi) { return f2bf(lo) | (f2bf(hi) << 16); }
__device__ __forceinline__ float bf2f(unsigned short b) { return __uint_as_float((unsigned)b << 16); }
__device__ __forceinline__ float bflo(unsigned w) { return __uint_as_float(w << 16); }
__device__ __forceinline__ float bfhi(unsigned w) { return __uint_as_float(w & 0xffff0000u); }
__device__ __forceinline__ float wave_sum(float v) {
#pragma unroll
    for (int o = 1; o < 64; o <<= 1) v += __shfl_xor(v, o);
    return v;
}
__device__ __forceinline__ float wave_max(float v) {
#pragma unroll
    for (int o = 1; o < 64; o <<= 1) v = fmaxf(v, __shfl_xor(v, o));
    return v;
}

constexpr int RING_BYTES = 131072;
constexpr int LDSCTL_OFF = RING_BYTES, MISC_OFF = LDSCTL_OFF + 320;
constexpr int LDS_BYTES = 147456;

struct Args { const float* in[16]; float* out; unsigned char* ws; int ph_lo, ph_hi; };

struct Frame {
    LAS unsigned char* lds;
    int tid, lane, wave, G, vcu;
    unsigned char* ws;
    const float* in[16];
    float* out;
};
enum { I_X = 0, I_C, I_POS, I_WIN, I_WOUT, I_RELB, I_SINK, I_CPOS, I_CW1, I_CW2, I_MW1, I_MW2, I_ADAW, I_ADAB, I_LNG, I_LNB };

__device__ __forceinline__ int t5_bucket(int d) {
    if (d < 16) return d;
    int b = 16;
    b += d >= 22; b += d >= 30; b += d >= 40; b += d >= 54; b += d >= 73; b += d >= 99; b += d >= 134; b += d >= 182;
    b += d >= 246; b += d >= 332; b += d >= 450; b += d >= 609; b += d >= 825; b += d >= 1117; b += d >= 1513;
    return b;
}
__device__ const float ROPE_FREQ[32] = {1.000000000e+00f, 6.890442967e-01f, 4.747820497e-01f, 3.271458745e-01f, 2.254180014e-01f, 1.553229839e-01f, 1.070244238e-01f, 7.374456525e-02f,
    5.081327632e-02f, 3.501259908e-02f, 2.412523143e-02f, 1.662335359e-02f, 1.145422645e-02f, 7.892469876e-03f, 5.438261200e-03f, 3.747202922e-03f,
    2.581988927e-03f, 1.779104699e-03f, 1.225881977e-03f, 8.446869906e-04f, 5.820267834e-04f, 4.010422272e-04f, 2.763358643e-04f, 1.904076635e-04f,
    1.311993110e-04f, 9.040213627e-05f, 6.229108112e-05f, 4.292131416e-05f, 2.957468678e-05f, 2.037826926e-05f, 1.404153045e-05f, 9.675236470e-06f};
__device__ __forceinline__ void sincos_f(float a, float& c, float& s) {
    const float n = rintf(a * 0.636619772367581343f);
    float r = fmaf(-n, 1.5703125f, a); r = fmaf(-n, 0.0004838267923332751f, r); r = fmaf(-n, 2.5632829192545614e-12f, r);
    const float r2 = r * r;
    const float sp = fmaf(r * r2, fmaf(r2, fmaf(r2, fmaf(r2, 2.755731922e-6f, -1.984126984e-4f), 8.333333333e-3f), -1.666666667e-1f), r);
    const float cp = fmaf(r2, fmaf(r2, fmaf(r2, fmaf(r2, fmaf(r2, -2.755731922e-7f, 2.480158730e-5f), -1.388888889e-3f), 4.166666667e-2f), -0.5f), 1.0f);
    const int q = ((int)n) & 3;
    c = (q == 0) ? cp : (q == 1) ? -sp : (q == 2) ? -cp : sp;
    s = (q == 0) ? sp : (q == 1) ? cp : (q == 2) ? -sp : -cp;
}

template <int MODE>
__device__ __forceinline__ int colmap(int n) {
    if (MODE == 0) return n;
    if (n >= NIN) return -1;
    if (n >= C_BQ && n < C_BV) { const int hb = n & ~63, j = n & 63; return hb + (j >> 1) + 32 * (j & 1); }
    return n;
}
template <int MODE>
__device__ __forceinline__ void transpose_item(const float* W, int K, int N, int NP, bf16* WT, LAS float* scr, int item, int lane) {
    const int nblk = NP / 32, kb = item / nblk, nb = item % nblk, k0 = 64 * kb, n0 = 32 * nb;
    const int src = colmap<MODE>(n0 + (lane & 31));
#pragma unroll 8
    for (int i = 0; i < 32; ++i) { const int kk = 2 * i + (lane >> 5); scr[kk * 33 + (lane & 31)] = src >= 0 ? W[(size_t)(k0 + kk) * N + src] : 0.f; }
    LDS_WAIT(); asm volatile("" ::: "memory");
    const int c = lane & 7;
#pragma unroll
    for (int j = 0; j < 4; ++j) { const int n = (lane >> 3) + 8 * j; const LAS float* s = scr + (8 * c) * 33 + n;
        v4u o; o.x = pk2(s[0 * 33], s[1 * 33]); o.y = pk2(s[2 * 33], s[3 * 33]); o.z = pk2(s[4 * 33], s[5 * 33]); o.w = pk2(s[6 * 33], s[7 * 33]);
        *(v4u*)(WT + (size_t)(n0 + n) * K + k0 + 8 * c) = o; }
    LDS_WAIT(); asm volatile("" ::: "memory");
}

__device__ __forceinline__ void p0_prologue(Frame& F) {
    LAS float* scr = (LAS float*)(F.lds + F.wave * 16384);
    const int gw = F.vcu * NWAVES + F.wave, NGW = F.G * NWAVES;
    constexpr int I_IN = (DM / 64) * (NINP / 32), I_OUT = (DM / 64) * (DM / 32), I_1 = (DM / 64) * (DFF / 32), I_2 = (DFF / 64) * (DM / 32);
    constexpr int PER_LAYER = I_IN + I_OUT + I_1 + I_2;
    for (int it = gw; it < DEPTH * PER_LAYER; it += NGW) {
        const int l = it / PER_LAYER; int r = it % PER_LAYER;
        if (r < I_IN) { transpose_item<1>(F.in[I_WIN] + (size_t)l * DM * NIN, DM, NIN, NINP, (bf16*)(F.ws + WS_WIN) + (size_t)l * NINP * DM, scr, r, F.lane); continue; } r -= I_IN;
        if (r < I_OUT) { transpose_item<0>(F.in[I_WOUT] + (size_t)l * DM * DM, DM, DM, DM, (bf16*)(F.ws + WS_WOUT) + (size_t)l * DM * DM, scr, r, F.lane); continue; } r -= I_OUT;
        if (r < I_1) { transpose_item<0>(F.in[I_MW1] + (size_t)l * DM * DFF, DM, DFF, DFF, (bf16*)(F.ws + WS_W1) + (size_t)l * DFF * DM, scr, r, F.lane); continue; } r -= I_1;
        transpose_item<0>(F.in[I_MW2] + (size_t)l * DFF * DM, DFF, DM, DM, (bf16*)(F.ws + WS_W2) + (size_t)l * DM * DFF, scr, r, F.lane);
    }
    {
        __syncthreads();
        LAS float* red = (LAS float*)F.lds;
        const int nl = F.tid & 63, kp = F.tid >> 6;
        for (int it = F.vcu; it < DEPTH * 96; it += F.G) {
            const int l = it / 96, n = (it % 96) * 64 + nl;
            const float* w = F.in[I_ADAW] + (size_t)l * DM * 6144 + n;
            const float* c = F.in[I_C];
            float a = 0.f;
#pragma unroll 8
            for (int k = kp * 128; k < kp * 128 + 128; ++k) { const float cv = c[k]; a += (cv / (1.0f + __expf(-cv))) * w[(size_t)k * 6144]; }
            red[kp * 64 + nl] = a;
            __syncthreads();
            if (kp == 0) { float s = F.in[I_ADAB][l * 6144 + n];
#pragma unroll
                for (int j = 0; j < 8; ++j) s += red[j * 64 + nl];
                ((float*)(F.ws + WS_MOD))[l * 6144 + n] = s; }
            __syncthreads();
        }
    }
    {
        const int gt = F.vcu * NTHREADS + F.tid, NGT = F.G * NTHREADS;
        const int* pos = (const int*)F.in[I_POS];
        f32x2* rt = (f32x2*)(F.ws + WS_ROPE);
        for (int e = gt; e < S * 32; e += NGT) {
            const int r = e >> 5, i = e & 31;
            const float ang = (float)pos[r] * ROPE_FREQ[i];
            float cs, sn; sincos_f(ang, cs, sn);
            rt[e] = (f32x2){cs, sn};
        }
        if (gt < 12) { float m = -1e30f; for (int b = 0; b < 32; ++b) m = fmaxf(m, F.in[I_RELB][b * 12 + gt] * LOG2E); ((float*)(F.ws + WS_BMAX))[gt] = m; }
        float* bt = (float*)(F.ws + WS_BIAS);
        for (int e = gt; e < 12 * BIASLEN; e += NGT) {
            const int h = e / BIASLEN, d = e % BIASLEN;
            bt[e] = F.in[I_RELB][t5_bucket(d) * 12 + h] * LOG2E;
        }
    }
}

template <int MODE>
__device__ __forceinline__ void row_pass(Frame& F, const float* xin, float* xout, bf16* H, const float* lng, const float* lnb, const float* sc, const float* sh) {
    const int gw = F.vcu * NWAVES + F.wave, NGW = F.G * NWAVES;
    for (int m = gw; m < S; m += NGW) {
        const f32x4* xr = (const f32x4*)(xin + (size_t)m * DM) + F.lane;
        f32x4 v[4];
#pragma unroll
        for (int j = 0; j < 4; ++j) v[j] = xr[64 * j];
        if (MODE != 0) {
            float s = 0.f;
#pragma unroll
            for (int j = 0; j < 4; ++j) s += (v[j].x + v[j].y) + (v[j].z + v[j].w);
            const float mean = wave_sum(s) * (1.f / DM); float s2 = 0.f;
#pragma unroll
            for (int j = 0; j < 4; ++j) { v[j] = v[j] - mean; s2 += (v[j].x * v[j].x + v[j].y * v[j].y) + (v[j].z * v[j].z + v[j].w * v[j].w); }
            const float rstd = 1.f / sqrtf(wave_sum(s2) * (1.f / DM) + LN_EPS);
            f32x4* xo = (f32x4*)(xout + (size_t)m * DM) + F.lane;
#pragma unroll
            for (int j = 0; j < 4; ++j) { const f32x4 g = ((const f32x4*)lng)[F.lane + 64 * j], b = ((const f32x4*)lnb)[F.lane + 64 * j]; v[j] = v[j] * rstd * g + b; xo[64 * j] = v[j]; }
        }
        if (MODE != 2) {
            v2u* o8 = (v2u*)(H + (size_t)m * DM) + F.lane;
#pragma unroll
            for (int j = 0; j < 4; ++j) { const f32x4 a = ((const f32x4*)sc)[F.lane + 64 * j] + 1.0f, b = ((const f32x4*)sh)[F.lane + 64 * j]; const f32x4 h = v[j] * a + b;
                o8[64 * j] = (v2u){pk2(h.x, h.y), pk2(h.z, h.w)}; }
        }
    }
}

typedef GAS unsigned gu32;
typedef GAS unsigned long long gu64;
#define RLX_AGENT __ATOMIC_RELAXED, __HIP_MEMORY_SCOPE_AGENT
__device__ __forceinline__ unsigned long long rt() { return __builtin_amdgcn_s_memrealtime(); }

#define XB_TMO      128
#define XB_XCNT(j)  (256  + 64 * (j))
#define XB_XSUB(j)  (1280 + 64 * (j))
#define XB_XGEN(j)  (2304 + 64 * (j))
#define XB_TOP      3328
#define XB_TOPGEN   3392
#define XCD_BAR_WORDS 3456
#define XB_SPIN_CAP (1u << 18)

__device__ __forceinline__ unsigned xb_ld(unsigned* p)              { return __hip_atomic_load(p, __ATOMIC_RELAXED, __HIP_MEMORY_SCOPE_AGENT); }
__device__ __forceinline__ unsigned xb_add(unsigned* p, unsigned v) { return __hip_atomic_fetch_add(p, v, __ATOMIC_RELAXED, __HIP_MEMORY_SCOPE_AGENT); }
__device__ __forceinline__ unsigned xb_xcc_id() { return (unsigned)__builtin_amdgcn_s_getreg((3 << 11) | 20) & 0xFu; }
#define XB_SPIN(cond, bar) do { unsigned _sp = 0; while (cond) { __builtin_amdgcn_s_sleep(1); \
    if ((++_sp & 255u) == 0u) { if (xb_ld(&(bar)[XB_TMO])) break; if (_sp > XB_SPIN_CAP) { atomicAdd(&(bar)[XB_TMO], 1u); break; } } } } while (0)

struct XcdBarrier {
    unsigned* bar; unsigned x;
    volatile LAS unsigned* st;
};

__device__ __forceinline__ XcdBarrier xcd_barrier_post(unsigned* bar, volatile LAS unsigned* st) {
    XcdBarrier b; b.bar = bar; b.x = xb_xcc_id(); b.st = st;
    if (threadIdx.x == 0) (void)xb_add(&bar[XB_XCNT(b.x)], 1u);
    return b;
}
__device__ __forceinline__ void xcd_barrier_complete(unsigned* bar, unsigned x, unsigned& nloc, unsigned& nx) {
    const unsigned G = gridDim.x * gridDim.y * gridDim.z;
    unsigned sum, cnt, mine, sp = 0u;
    for (;;) {
        sum = 0u; cnt = 0u; mine = 0u;
#pragma unroll
        for (unsigned j = 0; j < 16; ++j) { const unsigned c = xb_ld(&bar[XB_XCNT(j)]); sum += c; cnt += (c > 0u) ? 1u : 0u; mine = (j == x) ? c : mine; }
        if (sum == G) break;
        __builtin_amdgcn_s_sleep(1);
        if ((++sp & 255u) == 0u) { if (xb_ld(&bar[XB_TMO])) break; if (sp > XB_SPIN_CAP) { atomicAdd(&bar[XB_TMO], 1u); break; } }
    }
    nloc = mine > 0u ? mine : 1u; nx = cnt > 0u ? cnt : 1u;
}

__device__ __forceinline__ void xcd_barrier(const XcdBarrier& b) {
    asm volatile("s_waitcnt vmcnt(0)" ::: "memory");
    __syncthreads();
    if (threadIdx.x == 0) {
        unsigned* bar = b.bar;
        __builtin_amdgcn_s_waitcnt(0);
        unsigned nloc = b.st[0], nx = b.st[1];
        if (nloc == 0u) { xcd_barrier_complete(bar, b.x, nloc, nx); b.st[0] = nloc; b.st[1] = nx; }
        const unsigned old = xb_add(&bar[XB_XSUB(b.x)], 1u);
        const unsigned gen = old / nloc;
        if (old + 1u == (gen + 1u) * nloc) {
            __builtin_amdgcn_fence(__ATOMIC_RELEASE, "agent");
            asm volatile("s_waitcnt vmcnt(0)" ::: "memory");
            const unsigned og = xb_add(&bar[XB_TOP], 1u);
            const unsigned tg = og / nx;
            if (og + 1u == (tg + 1u) * nx) xb_add(&bar[XB_TOPGEN], 1u);
            else XB_SPIN(xb_ld(&bar[XB_TOPGEN]) == tg, bar);
            __builtin_amdgcn_fence(__ATOMIC_ACQUIRE, "agent");
            xb_add(&bar[XB_XGEN(b.x)], 1u);
            asm volatile("s_waitcnt vmcnt(0)" ::: "memory");
        } else {
            XB_SPIN(xb_ld(&bar[XB_XGEN(b.x)]) == gen, bar);
            __builtin_amdgcn_fence(__ATOMIC_ACQUIRE, "agent");
            asm volatile("s_waitcnt vmcnt(0)" ::: "memory");
        }
    }
    __syncthreads();
}


__device__ __forceinline__ float ld_elem(const bf16* p) { return bf2f(*p); }
__device__ __forceinline__ float ld_elem(const float* p) { return *p; }
template <int G>
__device__ __forceinline__ void dot64(const bf16* k, const LAS float* qs, float (&s)[G]) {
    const v4u* kp = (const v4u*)k;
#pragma unroll 2
    for (int c = 0; c < 8; ++c) { const v4u w = kp[c];
        float kv[8] = {bflo(w.x), bfhi(w.x), bflo(w.y), bfhi(w.y), bflo(w.z), bfhi(w.z), bflo(w.w), bfhi(w.w)};
#pragma unroll
        for (int g = 0; g < G; ++g) { const LAS f32x4* q4 = (const LAS f32x4*)(qs + g * 64 + c * 8); const f32x4 a = q4[0], b = q4[1];
            s[g] += kv[0] * a.x + kv[1] * a.y + kv[2] * a.z + kv[3] * a.w + kv[4] * b.x + kv[5] * b.y + kv[6] * b.z + kv[7] * b.w; } }
}
template <int G>
__device__ __forceinline__ void dot64(const float* k, const LAS float* qs, float (&s)[G]) {
    const f32x4* kp = (const f32x4*)k;
#pragma unroll 2
    for (int c = 0; c < 16; ++c) { const f32x4 w = kp[c];
#pragma unroll
        for (int g = 0; g < G; ++g) { const f32x4 a = *(const LAS f32x4*)(qs + g * 64 + c * 4); s[g] += w.x * a.x + w.y * a.y + w.z * a.z + w.w * a.w; } }
}
template <int G, class KT, class KeyFn>
__device__ __forceinline__ void wave_attend(const KT* K, const KT* V, const LAS float* qs, int nk, const KeyFn& kf, float (&m)[G], float (&l)[G], float (&o)[G], int lane) {
    for (int base = 0; base < nk; base += 64) {
        const int i = base + lane;
        long off = 0; float s[G], p[G];
#pragma unroll
        for (int g = 0; g < G; ++g) s[g] = 0.f;
        bool valid = false;
        if (i < nk) valid = kf(i, off, s);
        const LAS float* qo = qs; asm volatile("" : "+v"(qo));
        if (valid) dot64<G>(K + off, qo, s);
        const unsigned long long mask = __ballot(valid);
        if (mask == 0ull) continue;
#pragma unroll
        for (int g = 0; g < G; ++g) {
            const float sv = valid ? s[g] : -1e30f;
            const float mn = fmaxf(m[g], wave_max(sv));
            const float scl = exp2f(m[g] - mn);
            p[g] = valid ? exp2f(sv - mn) : 0.f;
            l[g] = l[g] * scl + wave_sum(p[g]); o[g] *= scl; m[g] = mn;
        }
#pragma unroll 2
        for (int j = 0; j < 64; ++j) {
            if (!((mask >> j) & 1ull)) continue;
            const unsigned olo = __builtin_amdgcn_readlane((unsigned)(unsigned long long)off, j), ohi = __builtin_amdgcn_readlane((unsigned)((unsigned long long)off >> 32), j);
            const long oj = (long)(((unsigned long long)ohi << 32) | olo);
            const float v = ld_elem(V + oj + lane);
#pragma unroll
            for (int g = 0; g < G; ++g) o[g] += __uint_as_float(__builtin_amdgcn_readlane(__float_as_uint(p[g]), j)) * v;
        }
    }
}

struct KeyA { int p, r; const float* bias; __device__ __forceinline__ bool operator()(int i, long& off, float (&b)[1]) const {
    const int row = p - r * i; if (row < 0) return false; off = (long)row * NINP; const int d = r * i; b[0] = bias[d < BIASLEN ? d : BIASLEN - 1]; return true; } };
struct KeyB { int p; __device__ __forceinline__ bool operator()(int i, long& off, float (&b)[2]) const {
    const int row = p - i; if (row < 0) return false; off = (long)row * NINP; return true; } };
struct KeyW { int p; const float* bias; __device__ __forceinline__ bool operator()(int i, long& off, float (&b)[4]) const {
    const int row = p - i; if (row < 0) return false; off = (long)row * NINP;
#pragma unroll
    for (int g = 0; g < 4; ++g) b[g] = bias[g * BIASLEN + i]; return true; } };

__device__ __forceinline__ void load_q(const bf16* q, LAS float* qs, int lane) { qs[lane] = bf2f(q[lane]); }

__device__ __forceinline__ void p2_token_attention(Frame& F, int layer, const bf16* PROJ, bf16* MIXED, bf16* OWIN) {
    LAS float* qs = (LAS float*)(F.lds + F.wave * 2048);
    const int gw = F.vcu * NWAVES + F.wave, NGW = F.G * NWAVES, lane = F.lane;
    const float* bias2 = (const float*)(F.ws + WS_BIAS);
    for (int it = gw; it < S * 4; it += NGW) {
        const int p = it >> 2, h = it & 3;
        load_q(PROJ + (size_t)p * NINP + C_AQ + h * 64, qs, lane); LDS_WAIT(); asm volatile("" ::: "memory");
        float m[1] = {-1e30f}, l[1] = {0.f}, o[1] = {0.f};
        const bf16* K = PROJ + C_AK + h * 64; const bf16* V = PROJ + C_AV + h * 64;
#pragma unroll 1
        for (int c = 0; c < 3; ++c) { const int r = c == 0 ? 1 : (c == 1 ? 4 : 16); KeyA kf{p, r, bias2 + h * BIASLEN}; wave_attend<1>(K, V, qs, 129, kf, m, l, o, lane); }
        MIXED[(size_t)p * DM + h * 64 + lane] = (bf16)f2bf(o[0] / l[0]);
        LDS_WAIT(); asm volatile("" ::: "memory");
    }
    for (int it = gw; it < S * 2; it += NGW) {
        const int p = it >> 1, kvh = it & 1;
        load_q(PROJ + (size_t)p * NINP + C_BQ + (2 * kvh) * 64, qs, lane); load_q(PROJ + (size_t)p * NINP + C_BQ + (2 * kvh + 1) * 64, qs + 64, lane); LDS_WAIT(); asm volatile("" ::: "memory");
        float m[2] = {-1e30f, -1e30f}, l[2] = {0.f, 0.f}, o[2] = {0.f, 0.f};
        KeyB kf{p}; wave_attend<2>(PROJ + C_BK + kvh * 64, PROJ + C_BV + kvh * 64, qs, 128, kf, m, l, o, lane);
#pragma unroll
        for (int g = 0; g < 2; ++g) { const float sk = F.in[I_SINK][layer * 4 + 2 * kvh + g] * LOG2E; const float mn = fmaxf(m[g], sk); const float scl = exp2f(m[g] - mn);
            const float den = l[g] * scl + exp2f(sk - mn); MIXED[(size_t)p * DM + 256 + (2 * kvh + g) * 64 + lane] = (bf16)f2bf(o[g] * scl / den); }
        LDS_WAIT(); asm volatile("" ::: "memory");
    }
    for (int it = gw; it < S * 2; it += NGW) {
        const int p = it >> 1, kvh = it & 1;
#pragma unroll
        for (int g = 0; g < 4; ++g) load_q(PROJ + (size_t)p * NINP + C_CQ + (4 * kvh + g) * 64, qs + g * 64, lane);
        LDS_WAIT(); asm volatile("" ::: "memory");
        float m[4] = {-1e30f, -1e30f, -1e30f, -1e30f}, l[4] = {0.f, 0.f, 0.f, 0.f}, o[4] = {0.f, 0.f, 0.f, 0.f};
        KeyW kf{p, bias2 + (4 + 4 * kvh) * BIASLEN}; wave_attend<4>(PROJ + C_CKW + kvh * 64, PROJ + C_CVW + kvh * 64, qs, 512, kf, m, l, o, lane);
#pragma unroll
        for (int g = 0; g < 4; ++g) OWIN[(size_t)p * 512 + (4 * kvh + g) * 64 + lane] = (bf16)f2bf(o[g] / l[g]);
        LDS_WAIT(); asm volatile("" ::: "memory");
    }
}

__device__ __forceinline__ float gelu_tanh(float x) { const float u = 0.7978845608028654f * (x + 0.044715f * x * x * x); return 0.5f * x * (1.0f + tanhf(u)); }
__device__ __forceinline__ void p2_compress(Frame& F, int layer, const bf16* PROJ) {
    LAS float* flat = (LAS float*)F.lds;
    LAS float* hid = flat + 8 * 2048;
    const int tid = F.tid;
    for (int it = F.vcu; it < 2 * 256; it += F.G) {
        const int kv = it >> 8, rg = it & 255;
        const float* pos = F.in[I_CPOS] + ((size_t)layer * 2 + kv) * 2048;
        const float* w1 = F.in[I_CW1] + ((size_t)layer * 2 + kv) * 2048 * 256;
        const float* w2 = F.in[I_CW2] + ((size_t)layer * 2 + kv) * 256 * 64;
        float* outp = (float*)(F.ws + (kv ? WS_VC : WS_KC));
        __syncthreads();
        for (int e = tid; e < 8 * 2048; e += NTHREADS) {
            const int r = e >> 11, f = e & 2047, R = rg * 8 + r, i = R >> 1, hk = R & 1, t = f >> 6, d = f & 63;
            float v = 0.f;
            if (i < NCMP) v = bf2f(PROJ[(size_t)(16 * i + t) * NINP + (kv ? C_CVC : C_CKC) + hk * 64 + d]) + pos[f];
            flat[e] = v;
        }
        __syncthreads();
        { const int j = tid & 255, half = tid >> 8; float a[4] = {0.f, 0.f, 0.f, 0.f}; const LAS float* fl = flat + half * 4 * 2048;
#pragma unroll 4
            for (int f = 0; f < 2048; ++f) { const float w = w1[(size_t)f * 256 + j];
#pragma unroll
                for (int r = 0; r < 4; ++r) a[r] += fl[r * 2048 + f] * w; }
#pragma unroll
            for (int r = 0; r < 4; ++r) hid[(half * 4 + r) * 256 + j] = gelu_tanh(a[r]); }
        __syncthreads();
        { const int r = tid >> 6, e = tid & 63, R = rg * 8 + r; float a = 0.f;
#pragma unroll 8
            for (int j = 0; j < 256; ++j) a += hid[r * 256 + j] * w2[j * 64 + e];
            if ((R >> 1) < NCMP) outp[(size_t)R * 64 + e] = a; }
    }
    __syncthreads();
}

struct KeyCmp { int g; __device__ __forceinline__ bool operator()(int i, long& off, float (&b)[4]) const { off = ((long)i * 2 + g) * 64; return true; } };
struct KeySel { int p, blk; const float* bias; __device__ __forceinline__ bool operator()(int i, long& off, float (&b)[4]) const {
    const int kpos = blk * 64 + i; if (kpos > p) return false; off = (long)kpos * NINP; const int d = p - kpos;
#pragma unroll
    for (int g = 0; g < 4; ++g) b[g] = bias[g * BIASLEN + (d < BIASLEN ? d : BIASLEN - 1)]; return true; } };

__device__ __forceinline__ void p3_nsa(Frame& F, int layer, const bf16* PROJ, const bf16* OWIN, bf16* MIXED) {
    LAS float* qs = (LAS float*)(F.lds + F.wave * 8192);
    LAS float* imp = qs + 256;
    const int gw = F.vcu * NWAVES + F.wave, NGW = F.G * NWAVES, lane = F.lane;
    const float* bias2 = (const float*)(F.ws + WS_BIAS);
    const float* KC = (const float*)(F.ws + WS_KC); const float* VC = (const float*)(F.ws + WS_VC);
    for (int it = gw; it < S * 2; it += NGW) {
        const int p = it >> 1, kvh = it & 1;
#pragma unroll
        for (int g = 0; g < 4; ++g) load_q(PROJ + (size_t)p * NINP + C_CQ + (4 * kvh + g) * 64, qs + g * 64, lane);
        for (int e = lane; e < 1040; e += 64) imp[e] = 0.f;
        LDS_WAIT(); asm volatile("" ::: "memory");
        int nv = p >= 31 ? ((p - 31) >> 4) + 1 : 0; if (nv > NCMP) nv = NCMP;
        float m1[4] = {-1e30f, -1e30f, -1e30f, -1e30f}, l1[4] = {0.f, 0.f, 0.f, 0.f}, o1[4] = {0.f, 0.f, 0.f, 0.f};
        { KeyCmp kf{kvh}; wave_attend<4>(KC, VC, qs, nv, kf, m1, l1, o1, lane); }
        for (int base = 0; base < nv; base += 64) { const int i = base + lane;
            const LAS float* qo = qs; asm volatile("" : "+v"(qo));
            if (i < nv) { float s[4] = {0.f, 0.f, 0.f, 0.f}; dot64<4>(KC + ((size_t)i * 2 + kvh) * 64, qo, s); float a = 0.f;
#pragma unroll
                for (int g = 0; g < 4; ++g) a += exp2f(s[g] - m1[g]) / fmaxf(l1[g], 1e-30f);
                imp[1 + i] = a; } }
        LDS_WAIT(); asm volatile("" ::: "memory");
        const int cur = p >> 6;
        float sc[4];
#pragma unroll
        for (int c = 0; c < 4; ++c) { const int j = lane + 64 * c; const LAS float* q = imp + 4 * j;
            const float is = 0.5f * q[0] + q[1] + q[2] + q[3] + 0.5f * q[4];
            const bool forced = (j == 0) || (j == cur) || (j == cur - 1);
            sc[c] = forced ? 1e4f : ((j * 64 <= p) ? is : -1e30f); }
        float m2[4] = {-1e30f, -1e30f, -1e30f, -1e30f}, l2[4] = {0.f, 0.f, 0.f, 0.f}, o2[4] = {0.f, 0.f, 0.f, 0.f};
#pragma unroll 1
        for (int k = 0; k < 16; ++k) {
            float bv = sc[0]; int bi = lane;
#pragma unroll
            for (int c = 1; c < 4; ++c) if (sc[c] > bv) { bv = sc[c]; bi = lane + 64 * c; }
#pragma unroll
            for (int off = 1; off < 64; off <<= 1) { const float ov = __shfl_xor(bv, off); const int oi = __shfl_xor(bi, off); if (ov > bv || (ov == bv && oi < bi)) { bv = ov; bi = oi; } }
#pragma unroll
            for (int c = 0; c < 4; ++c) if (bi == lane + 64 * c) sc[c] = -3e38f;
            if (bi * 64 <= p) { KeySel kf{p, bi, bias2 + (4 + 4 * kvh) * BIASLEN}; wave_attend<4>(PROJ + C_CKS + kvh * 64, PROJ + C_CVS + kvh * 64, qs, 64, kf, m2, l2, o2, lane); }
        }
#pragma unroll
        for (int g = 0; g < 4; ++g) { const int H = 4 * kvh + g;
            const float g0 = bf2f(PROJ[(size_t)p * NINP + C_CG + H * 3 + 0]), g1 = bf2f(PROJ[(size_t)p * NINP + C_CG + H * 3 + 1]), g2 = bf2f(PROJ[(size_t)p * NINP + C_CG + H * 3 + 2]);
            const float ocmp = o1[g] / fmaxf(l1[g], 1e-30f), oslc = o2[g] / l2[g], owin = bf2f(OWIN[(size_t)p * 512 + H * 64 + lane]);
            MIXED[(size_t)p * DM + 512 + H * 64 + lane] = (bf16)f2bf(g0 * ocmp + g1 * oslc + g2 * owin); }
        LDS_WAIT(); asm volatile("" ::: "memory");
    }
}


namespace ba {
typedef short bf16x8 __attribute__((ext_vector_type(8)));
typedef short s16x4 __attribute__((ext_vector_type(4)));
typedef short v4i16_t __attribute__((ext_vector_type(4)));
typedef float f32x16 __attribute__((ext_vector_type(16)));
typedef float f32x2_t __attribute__((ext_vector_type(2))); typedef __bf16 bf16x2_t __attribute__((ext_vector_type(2)));
typedef LAS const char* lds_cptr;
__device__ __forceinline__ unsigned cvtpk(float lo, float hi) { f32x2_t v = {lo, hi}; bf16x2_t b = __builtin_convertvector(v, bf16x2_t); return __builtin_bit_cast(unsigned, b); }
__device__ __forceinline__ s16x4 vtr(lds_cptr p) { return __builtin_bit_cast(s16x4, __builtin_amdgcn_ds_read_tr16_b64_v4i16((LAS v4i16_t*)p)); }
__device__ __forceinline__ float half_sum(float x) { auto rr = __builtin_amdgcn_permlane32_swap(__float_as_uint(x), __float_as_uint(x), false, false); return __uint_as_float(rr[0]) + __uint_as_float(rr[1]); }
constexpr int KIMG = 0, VIMG = 49152, TBL = 98304, WSCR = 108544, KMAX = 110592;

struct Unit {
    const bf16* Q; const bf16* K; const bf16* V;
    bf16* O; int opitch;
    float* lse; int lse_pitch;
    const float* bias;
    const float* bmax;
    const float* sink;
    int rs, rho, u0;
    int W, Wp;
};

template <int NT, int NH>
__device__ __forceinline__ void run_unit(LAS unsigned char* lds, const Unit& U, int wave, int lane, int tid) {
    static_assert(NT * NH == 8, "one wave-task per wave");
    const int r32 = lane & 31, hi = lane >> 5;
    const int NQ = 32 * NT, NKT = U.Wp + NQ, nch = (NKT + 383) / 384, CH = NKT / nch;
    const int tile = wave % NT, hl = wave / NT, uw = U.u0 + 32 * tile;
    const int TW = U.Wp + 64;
    __syncthreads();
    for (int e = tid; e < NH * TW; e += NTHREADS) { const int h = e / TW, dist = e % TW - 32;
        float v = -1e30f; if (dist >= 0 && dist <= U.W) { v = 0.f; if (U.bias) { const int td = dist * U.rs; v = U.bias[h * BIASLEN + (td < BIASLEN ? td : BIASLEN - 1)]; } }
        ((LAS float*)(lds + TBL))[e] = v; }
    if (tid == 0) *(LAS unsigned*)(lds + KMAX) = 0u;
    __syncthreads();
    { float mx = 0.f;
      for (int idx = tid; idx < NKT * 8; idx += NTHREADS) { const int n = idx >> 3, c = idx & 7, u = U.u0 - U.Wp + n; float s = 0.f;
          if (u >= 0) { const v4u w = *(const v4u*)(U.K + (size_t)(U.rho + U.rs * u) * NINP + c * 8);
              const float a0 = bflo(w.x), a1 = bfhi(w.x), a2 = bflo(w.y), a3 = bfhi(w.y), a4 = bflo(w.z), a5 = bfhi(w.z), a6 = bflo(w.w), a7 = bfhi(w.w);
              s = a0 * a0 + a1 * a1 + a2 * a2 + a3 * a3 + a4 * a4 + a5 * a5 + a6 * a6 + a7 * a7; }
          s += __shfl_xor(s, 1); s += __shfl_xor(s, 2); s += __shfl_xor(s, 4); mx = fmaxf(mx, s); }
      mx = wave_max(mx);
      if (lane == 0) __hip_atomic_fetch_max((LAS unsigned*)(lds + KMAX), __float_as_uint(mx), __ATOMIC_RELAXED, __HIP_MEMORY_SCOPE_WORKGROUP); }
    const int qtok = U.rho + U.rs * (uw + r32);
    bf16x8 qr[4]; float qn = 0.f;
    { const bf16* qp = U.Q + (size_t)qtok * NINP + hl * 64 + hi * 8;
#pragma unroll
      for (int d0 = 0; d0 < 4; ++d0) { qr[d0] = *(const bf16x8*)(qp + d0 * 16);
#pragma unroll
          for (int j = 0; j < 8; ++j) { const float x = bf2f((unsigned short)qr[d0][j]); qn += x * x; } }
      qn = half_sum(qn); }
    __syncthreads();
    const float kmax2 = __uint_as_float(*(LAS unsigned*)(lds + KMAX));
    float M = sqrtf(qn * kmax2) * 1.0002f + 1e-6f;
    if (U.bmax) M += fmaxf(U.bmax[hl], 0.f);
    float sink2 = 0.f; if (U.sink) { sink2 = U.sink[hl] * LOG2E; M = fmaxf(M, sink2); }
    f32x16 negm;
#pragma unroll
    for (int r = 0; r < 16; ++r) negm[r] = -M;
    f32x16 o0 = {}, o1 = {}; float lsum = 0.f;
    const LAS float* tbl = (const LAS float*)(lds + TBL) + hl * TW;
    for (int ck = 0; ck < nch; ++ck) {
        const int kc0 = U.u0 - U.Wp + ck * CH;
        if (ck > 0) __syncthreads();
        for (int idx = tid; idx < CH * 16; idx += NTHREADS) { const int n = idx >> 4, isv = (idx >> 3) & 1, c = idx & 7, u = kc0 + n;
            v4u w = {0u, 0u, 0u, 0u};
            if (u >= 0) w = *(const v4u*)((isv ? U.V : U.K) + (size_t)(U.rho + U.rs * u) * NINP + c * 8);
            if (isv) *(LAS v4u*)(lds + VIMG + (c >> 2) * (CH * 64) + n * 64 + (c & 3) * 16) = w;
            else     *(LAS v4u*)(lds + KIMG + c * (CH * 16) + n * 16) = w; }
        __syncthreads();
        const int nbt = U.Wp / 32 + 1;
        for (int t = 0; t < nbt; ++t) {
            const int kt0 = uw - U.Wp + 32 * t, kl = kt0 - kc0;
            if (kt0 < 0 || kl < 0 || kl >= CH) continue;
            f32x16 s;
            { const lds_cptr kb = (lds_cptr)(lds + KIMG) + hi * (CH * 16) + (kl + r32) * 16;
#pragma unroll
              for (int d0 = 0; d0 < 4; ++d0) { const bf16x8 kf = *(const LAS bf16x8*)(kb + d0 * (2 * CH * 16));
                  s = __builtin_amdgcn_mfma_f32_32x32x16_bf16(kf, qr[d0], d0 == 0 ? negm : s, 0, 0, 0); } }
            { const LAS float* tb = tbl + (U.Wp - 32 * t) + r32 - 4 * hi + 32 - 27;
#pragma unroll
              for (int r = 0; r < 16; ++r) s[r] = __builtin_amdgcn_exp2f(s[r] + tb[27 - ((r & 3) + 8 * (r >> 2))]); }
            float ps = 0.f;
#pragma unroll
            for (int r = 0; r < 16; ++r) ps += s[r];
            lsum += ps;
            bf16x8 pa0, pa1;
            { v4u w0 = {cvtpk(s[0], s[1]), cvtpk(s[2], s[3]), cvtpk(s[4], s[5]), cvtpk(s[6], s[7])}, w1 = {cvtpk(s[8], s[9]), cvtpk(s[10], s[11]), cvtpk(s[12], s[13]), cvtpk(s[14], s[15])};
              pa0 = __builtin_bit_cast(bf16x8, w0); pa1 = __builtin_bit_cast(bf16x8, w1); }
            { const lds_cptr vp = (lds_cptr)(lds + VIMG) + ((lane >> 4) & 1) * 32 + (lane & 3) * 8 + (kl + 4 * hi + ((lane & 15) >> 2)) * 64;
#pragma unroll
              for (int dh = 0; dh < 2; ++dh)
#pragma unroll
                  for (int g = 0; g < 2; ++g) { const s16x4 lo = vtr(vp + dh * (CH * 64) + g * 1024), hv = vtr(vp + dh * (CH * 64) + g * 1024 + 512);
                      const bf16x8 vf = {lo[0], lo[1], lo[2], lo[3], hv[0], hv[1], hv[2], hv[3]};
                      if (dh == 0) o0 = __builtin_amdgcn_mfma_f32_32x32x16_bf16(g == 0 ? pa0 : pa1, vf, o0, 0, 0, 0);
                      else         o1 = __builtin_amdgcn_mfma_f32_32x32x16_bf16(g == 0 ? pa0 : pa1, vf, o1, 0, 0, 0); } }
        }
    }
    float l = half_sum(lsum);
    if (U.sink) l += exp2f(sink2 - M);
    LAS float* wsf = (LAS float*)(lds + WSCR) + wave * 64;
    if (hi == 0) wsf[r32] = 1.0f / l;
    if (U.lse && hi == 0) U.lse[(size_t)qtok * U.lse_pitch + hl] = M + log2f(l);
    LDS_WAIT(); asm volatile("" ::: "memory");
#pragma unroll
    for (int r = 0; r < 16; ++r) { const int qo = (r & 3) + 8 * (r >> 2) + 4 * hi; const float rl = wsf[qo];
        bf16* op = U.O + (size_t)(U.rho + U.rs * (uw + qo)) * U.opitch + hl * 64 + r32;
        op[0] = (bf16)f2bf(o0[r] * rl); op[32] = (bf16)f2bf(o1[r] * rl); }
}
}

constexpr int P2_NA = 3 * 4 * 64, P2_NB = 2 * 128, P2_NC = 2 * 256, P2_NUNITS = P2_NA + P2_NB + P2_NC;
__device__ __forceinline__ void p2_banded(Frame& F, int layer, const bf16* PROJ, bf16* MIXED, bf16* OWIN) {
    const float* bias2 = (const float*)(F.ws + WS_BIAS); const float* bmax = (const float*)(F.ws + WS_BMAX);
    bf16* OA3 = (bf16*)(F.ws + WS_OA3); float* LSE = (float*)(F.ws + WS_LSE);
    for (int it = F.vcu; it < P2_NUNITS; it += F.G) {
        ba::Unit U{};
        if (it < P2_NC) { const int kvh = it & 1, blk = it >> 1;
            U.Q = PROJ + C_CQ + kvh * 256; U.K = PROJ + C_CKW + kvh * 64; U.V = PROJ + C_CVW + kvh * 64; U.O = OWIN + kvh * 256; U.opitch = 512;
            U.bias = bias2 + (4 + 4 * kvh) * BIASLEN; U.bmax = bmax + 4 + 4 * kvh; U.rs = 1; U.rho = 0; U.u0 = blk * 64; U.W = 511; U.Wp = 512;
            ba::run_unit<2, 4>(F.lds, U, F.wave, F.lane, F.tid);
        } else if (it < P2_NC + P2_NA) { const int a = it - P2_NC, h = a & 3, c = (a >> 2) % 3, blk = (a >> 2) / 3;
            const int rs = c == 0 ? 1 : (c == 1 ? 4 : 16), per = S / rs / 256;
            const int rho = blk / per, ub = blk % per;
            U.Q = PROJ + C_AQ + h * 64; U.K = PROJ + C_AK + h * 64; U.V = PROJ + C_AV + h * 64; U.O = OA3 + (size_t)c * S * 256 + h * 64; U.opitch = 256;
            U.lse = LSE + (size_t)c * S * 4 + h; U.lse_pitch = 4;
            U.bias = bias2 + h * BIASLEN; U.bmax = bmax + h; U.rs = rs; U.rho = rho; U.u0 = ub * 256; U.W = 128; U.Wp = 128;
            ba::run_unit<8, 1>(F.lds, U, F.wave, F.lane, F.tid);
        } else { const int b = it - P2_NC - P2_NA, kvh = b & 1, blk = b >> 1;
            U.Q = PROJ + C_BQ + kvh * 128; U.K = PROJ + C_BK + kvh * 64; U.V = PROJ + C_BV + kvh * 64; U.O = MIXED + 256 + kvh * 128; U.opitch = DM;
            U.sink = F.in[I_SINK] + layer * 4 + 2 * kvh; U.rs = 1; U.rho = 0; U.u0 = blk * 128; U.W = 127; U.Wp = 128;
            ba::run_unit<4, 2>(F.lds, U, F.wave, F.lane, F.tid);
        }
    }
    __syncthreads();
}
__device__ __forceinline__ void merge_dilated(Frame& F, bf16* MIXED) {
    const bf16* OA3 = (const bf16*)(F.ws + WS_OA3); const float* LSE = (const float*)(F.ws + WS_LSE);
    const int gw = F.vcu * NWAVES + F.wave, NGW = F.G * NWAVES, lane = F.lane, h = lane >> 4;
    for (int p = gw; p < S; p += NGW) {
        const float l0 = LSE[(size_t)p * 4 + h], l1 = LSE[(size_t)(S + p) * 4 + h], l2 = LSE[(size_t)(2 * S + p) * 4 + h];
        const float mx = fmaxf(l0, fmaxf(l1, l2)); const float e0 = exp2f(l0 - mx), e1 = exp2f(l1 - mx), e2 = exp2f(l2 - mx), inv = 1.0f / (e0 + e1 + e2);
        const v2u a = *(const v2u*)(OA3 + (size_t)p * 256 + lane * 4), b = *(const v2u*)(OA3 + (size_t)(S + p) * 256 + lane * 4), c = *(const v2u*)(OA3 + (size_t)(2 * S + p) * 256 + lane * 4);
        const float w0 = e0 * inv, w1 = e1 * inv, w2 = e2 * inv;
        const float r0 = w0 * bflo(a.x) + w1 * bflo(b.x) + w2 * bflo(c.x), r1 = w0 * bfhi(a.x) + w1 * bfhi(b.x) + w2 * bfhi(c.x);
        const float r2 = w0 * bflo(a.y) + w1 * bflo(b.y) + w2 * bflo(c.y), r3 = w0 * bfhi(a.y) + w1 * bfhi(b.y) + w2 * bfhi(c.y);
        *(v2u*)(MIXED + (size_t)p * DM + lane * 4) = (v2u){pk2(r0, r1), pk2(r2, r3)};
    }
}

constexpr int N_PHASES = 2 + 8 * DEPTH;
__device__ __forceinline__ void run_phase(Frame& F, int ph) {
    unsigned char* ws = F.ws;
    const float* mod = (const float*)(ws + WS_MOD);
    if (ph == 0) { p0_prologue(F); return; }
    if (ph == 1) { row_pass<0>(F, F.in[I_X], nullptr, (bf16*)(ws + WS_RA), nullptr, nullptr, mod + 1024, mod + 0); return; }
    const int l = (ph - 2) >> 3, sub = (ph - 2) & 7;
    const float* modl = mod + l * 6144;
    bf16* bufX = (bf16*)(ws + ((l & 1) ? WS_RB : WS_RA));
    bf16* bufY = (bf16*)(ws + ((l & 1) ? WS_RA : WS_RB));
    bf16* PROJ = (bf16*)(ws + WS_BIG); bf16* HID = (bf16*)(ws + WS_BIG); bf16* OWIN = (bf16*)(ws + WS_OWIN);
    const float* xres = (l == 0) ? F.in[I_X] : F.out;
    switch (sub) {
    case 0: {
        pg8::Gemm g{bufX, (const bf16*)(ws + WS_WIN) + (size_t)l * NINP * DM, S, NINP, DM}; pg8::StaticOrder So; So.init(S, NINP, F.G, (int)blockIdx.x);
        pg8::EpiInProj E{PROJ, NINP, (const float*)(ws + WS_ROPE), QSCALE};
        pg8::gemm_phase<pg8::EpiInProj, pg8::StaticOrder, PG8_ALIGN, PG8_SP2>(F.lds, g, So, E, F.wave);
    } break;
    case 1: p2_compress(F, l, PROJ); p2_banded(F, l, PROJ, bufY, OWIN); break;
    case 2: merge_dilated(F, bufY); p3_nsa(F, l, PROJ, OWIN, bufY); break;
    case 3: {
        pg8::Gemm g{bufY, (const bf16*)(ws + WS_WOUT) + (size_t)l * DM * DM, S, DM, DM}; pg8::StaticOrder So; So.init(S, DM, F.G, (int)blockIdx.x);
        pg8::EpiResid E{xres, F.out, DM, modl + 2048, DN_ALPHA};
        pg8::gemm_phase<pg8::EpiResid, pg8::StaticOrder, PG8_ALIGN, PG8_SP2>(F.lds, g, So, E, F.wave);
    } break;
    case 4: row_pass<1>(F, F.out, F.out, bufX, F.in[I_LNG] + (l * 2 + 0) * DM, F.in[I_LNB] + (l * 2 + 0) * DM, modl + 4096, modl + 3072); break;
    case 5: {
        pg8::Gemm g{bufX, (const bf16*)(ws + WS_W1) + (size_t)l * DFF * DM, S, DFF, DM}; pg8::StaticOrder So; So.init(S, DFF, F.G, (int)blockIdx.x);
        pg8::EpiRelu2 E{HID, DFF};
        pg8::gemm_phase<pg8::EpiRelu2, pg8::StaticOrder, PG8_ALIGN, PG8_SP2>(F.lds, g, So, E, F.wave);
    } break;
    case 6: {
        pg8::Gemm g{HID, (const bf16*)(ws + WS_W2) + (size_t)l * DM * DFF, S, DM, DFF}; pg8::StaticOrder So; So.init(S, DM, F.G, (int)blockIdx.x);
        pg8::EpiResid E{F.out, F.out, DM, modl + 5120, DN_ALPHA};
        pg8::gemm_phase<pg8::EpiResid, pg8::StaticOrder, PG8_ALIGN, PG8_SP2>(F.lds, g, So, E, F.wave);
    } break;
    default: {
        if (l + 1 < DEPTH) row_pass<1>(F, F.out, F.out, bufY, F.in[I_LNG] + (l * 2 + 1) * DM, F.in[I_LNB] + (l * 2 + 1) * DM, modl + 6144 + 1024, modl + 6144 + 0);
        else row_pass<2>(F, F.out, F.out, nullptr, F.in[I_LNG] + (l * 2 + 1) * DM, F.in[I_LNB] + (l * 2 + 1) * DM, nullptr, nullptr);
    } break;
    }
}

__global__ void __launch_bounds__(NTHREADS, 2) fwd_kernel(Args args) {
    extern __shared__ __attribute__((aligned(16))) unsigned char lds[];
    Frame F;
    F.lds = (LAS unsigned char*)lds;
    F.tid = threadIdx.x; F.lane = F.tid & 63; F.wave = __builtin_amdgcn_readfirstlane(F.tid >> 6);
    F.G = gridDim.x; { const int bx = blockIdx.x; F.vcu = (F.G % 8 == 0) ? (bx % 8) * (F.G / 8) + bx / 8 : bx; }
    F.ws = args.ws; F.out = args.out;
#pragma unroll
    for (int i = 0; i < 16; ++i) F.in[i] = args.in[i];
    for (int u = F.tid; u < (LDS_BYTES - LDSCTL_OFF) / 4; u += NTHREADS) ((LAS unsigned*)(F.lds + LDSCTL_OFF))[u] = 0u;
    __syncthreads();
    const int wave0 = __builtin_amdgcn_readfirstlane(threadIdx.x >> 6);
    const bool multi = (args.ph_hi - args.ph_lo) > 1;
    XcdBarrier bar; bar.bar = (unsigned*)(F.ws + WS_CTL) + 4096; bar.x = 0; bar.st = nullptr;
    if (multi) bar = xcd_barrier_post((unsigned*)(F.ws + WS_CTL) + 4096, (volatile LAS unsigned*)(F.lds + MISC_OFF) + 8);
    for (int ph = args.ph_lo; ph < args.ph_hi; ++ph) {
        { int ln = __builtin_amdgcn_mbcnt_hi(~0u, __builtin_amdgcn_mbcnt_lo(~0u, 0u)); asm volatile("" : "+v"(ln)); F.lane = ln; F.wave = wave0; F.tid = wave0 * 64 + ln; }
        run_phase(F, ph);
        if (ph + 1 < args.ph_hi) xcd_barrier(bar);
    }
}

#ifndef N_LAUNCH_MODE
#define N_LAUNCH_MODE 1
#endif
extern "C" void kernel_launch(void* const* d_in, const int* in_sizes, int n_in, void* d_out, int out_size, void* d_ws, size_t ws_size, hipStream_t stream) {
    static int grid = 0;
    if (grid == 0) {
        if (n_in != 16 || out_size != S * DM || ws_size < WS_END) { fprintf(stderr, "kernel_launch: unexpected shapes (n_in %d out %d ws %zu)\n", n_in, out_size, ws_size); grid = -1; return; }
        int dev = 0, cus = 0;
        if (hipGetDevice(&dev) != hipSuccess || hipDeviceGetAttribute(&cus, hipDeviceAttributeMultiprocessorCount, dev) != hipSuccess) { grid = -1; return; }
        if (hipFuncSetAttribute((const void*)fwd_kernel, hipFuncAttributeMaxDynamicSharedMemorySize, LDS_BYTES) != hipSuccess) { fprintf(stderr, "kernel_launch: hipFuncSetAttribute failed\n"); grid = -1; return; }
        int per_cu = 0;
        if (hipOccupancyMaxActiveBlocksPerMultiprocessor(&per_cu, (const void*)fwd_kernel, NTHREADS, LDS_BYTES) != hipSuccess || per_cu < 1) fprintf(stderr, "kernel_launch: occupancy query says %d\n", per_cu);
        (void)hipGetLastError();
        grid = cus;
    }
    if (grid < 0) return;
    (void)hipMemsetAsync((char*)d_ws + WS_CTL, 0, CTL_ZERO_BYTES, stream);
    Args a{};
    for (int i = 0; i < 16; ++i) a.in[i] = (const float*)d_in[i];
    a.out = (float*)d_out; a.ws = (unsigned char*)d_ws;
#if N_LAUNCH_MODE == 1
    a.ph_lo = 0; a.ph_hi = N_PHASES;
    hipLaunchKernelGGL(fwd_kernel, dim3(grid), dim3(NTHREADS), LDS_BYTES, stream, a);
#else
    for (int ph = 0; ph < N_PHASES; ++ph) { a.ph_lo = ph; a.ph_hi = ph + 1; hipLaunchKernelGGL(fwd_kernel, dim3(grid), dim3(NTHREADS), LDS_BYTES, stream, a); }
#endif
}
```

```cpp
#include <hip/hip_runtime.h>
#include <cstdio>
#include <cstdint>
#include <cmath>
namespace pg8 {
#define PG8_LAS __attribute__((address_space(3)))
typedef unsigned short bf16_t;
typedef short bf16x8 __attribute__((ext_vector_type(8)));
typedef float f32x4 __attribute__((ext_vector_type(4)));
typedef unsigned u32x4 __attribute__((ext_vector_type(4)));
constexpr int BM = 256, BK = 64, HALF = 128, HTB = HALF * BK * 2  , STAGE_BYTES = 8 * HTB, NXCD = 8, WGM = 8;

__host__ __device__ __forceinline__ int lds_byte(int r, int c) { const int st = (r >> 4) * 2 + (c >> 5), rr = r & 15, cc = c & 31, ob = rr * 64 + cc * 2; return st * 1024 + (ob ^ (((ob >> 9) & 1) << 5)); }
__host__ __device__ __forceinline__ void stage_rc(int b, int& R, int& C) { const int st = b / 1024, sb = b % 1024, swz = sb ^ (((sb >> 9) & 1) << 5); R = (st >> 1) * 16 + swz / 64; C = (st & 1) * 32 + (swz % 64) / 2; }
__host__ __device__ __forceinline__ int perm32(int rho) { const int n = rho >> 4, i = rho & 15; return 8 * (i >> 2) + 4 * n + (i & 3); }

struct Unit { int pm, pn; };
struct Gemm { const bf16_t* A; const bf16_t* Bt; int M, N, K; };

struct StaticOrder {
    int nM, nN, nwg, G, c;
    __host__ __device__ void init(int M, int N, int G_, int c_) { nM = M / BM; nN = N / BM; nwg = nM * nN; G = G_; c = c_; }
    __host__ __device__ bool next(int i, Unit& u) const {
        const long L = (long)i * G + c; if (L >= nwg) return false;
        int wgid = (int)L; { const int q = nwg / NXCD, r = nwg % NXCD, xcd = wgid % NXCD, off = wgid / NXCD; wgid = (xcd < r ? xcd * (q + 1) : r * (q + 1) + (xcd - r) * q) + off; }
        const int nig = WGM * nN, gid = wgid / nig, fm = gid * WGM, gsz = (nM - fm) < WGM ? (nM - fm) : WGM;
        u.pm = fm + ((wgid % nig) % gsz); u.pn = (wgid % nig) / gsz; return true;
    }
    __device__ __forceinline__ void a_ready(const Unit&) const {}
    __device__ __forceinline__ void done(const Unit&) const {}
};


__device__ __forceinline__ unsigned cvt_pk_bf16(float lo, float hi) { unsigned r; asm volatile("v_cvt_pk_bf16_f32 %0, %1, %2" : "=v"(r) : "v"(lo), "v"(hi)); return r; }
typedef float f32x2 __attribute__((ext_vector_type(2)));

struct EpiInProj {
    static constexpr bool PERM = true, AFTER_DRAIN = false;
    bf16_t* O; int ldc; const float* rope; float qscale;
    __device__ __forceinline__ void operator()(const f32x4 (&acc)[2][2][4][2], const Unit& u, int wr, int wc, int fr, int fq) const {
        const int row0 = u.pm * BM + wr * 64 + fr; const int col0 = u.pn * BM + wc * 32 + 8 * fq;
        const int i0 = 16 * (wc & 1) + 4 * fq;
#pragma unroll
        for (int bj = 0; bj < 2; ++bj) {
            const int pn = u.pn;
            const bool do_rope = (pn == 3) || (pn == 4 && bj == 0);
            const bool do_sig = (pn == 10);
            const float sc = (pn == 0 || pn == 3 || pn == 5 || pn == 6) ? qscale : 1.0f;
#pragma unroll
            for (int ai = 0; ai < 2; ++ai)
#pragma unroll
                for (int m = 0; m < 4; ++m) {
                    const int row = row0 + ai * HALF + m * 16;
                    f32x4 v0 = acc[ai][bj][m][0], v1 = acc[ai][bj][m][1];
                    if (do_rope) {
                        const f32x4* rp = (const f32x4*)(rope + ((size_t)row * 32 + i0) * 2);
                        const f32x4 c01 = rp[0], c23 = rp[1];
                        f32x4 w0, w1;
                        w0[0] = v0[0] * c01[0] - v0[1] * c01[1]; w0[1] = v0[1] * c01[0] + v0[0] * c01[1];
                        w0[2] = v0[2] * c01[2] - v0[3] * c01[3]; w0[3] = v0[3] * c01[2] + v0[2] * c01[3];
                        w1[0] = v1[0] * c23[0] - v1[1] * c23[1]; w1[1] = v1[1] * c23[0] + v1[0] * c23[1];
                        w1[2] = v1[2] * c23[2] - v1[3] * c23[3]; w1[3] = v1[3] * c23[2] + v1[2] * c23[3];
                        v0 = w0; v1 = w1;
                    }
                    if (do_sig) {
#pragma unroll
                        for (int e = 0; e < 4; ++e) { v0[e] = 1.0f / (1.0f + __expf(-v0[e])); v1[e] = 1.0f / (1.0f + __expf(-v1[e])); }
                    }
                    v0 = v0 * sc; v1 = v1 * sc;
                    u32x4 w; w.x = cvt_pk_bf16(v0[0], v0[1]); w.y = cvt_pk_bf16(v0[2], v0[3]); w.z = cvt_pk_bf16(v1[0], v1[1]); w.w = cvt_pk_bf16(v1[2], v1[3]);
                    *(u32x4*)(O + (size_t)row * ldc + col0 + bj * HALF) = w;
                }
        }
    }
};
struct EpiRelu2 {
    static constexpr bool PERM = true, AFTER_DRAIN = false;
    bf16_t* O; int ldc;
    __device__ __forceinline__ void operator()(const f32x4 (&acc)[2][2][4][2], const Unit& u, int wr, int wc, int fr, int fq) const {
        const int row0 = u.pm * BM + wr * 64 + fr; const int col0 = u.pn * BM + wc * 32 + 8 * fq;
#pragma unroll
        for (int ai = 0; ai < 2; ++ai)
#pragma unroll
            for (int m = 0; m < 4; ++m) { bf16_t* rowp = O + (size_t)(row0 + ai * HALF + m * 16) * ldc + col0;
#pragma unroll
                for (int bj = 0; bj < 2; ++bj) { f32x4 v0 = acc[ai][bj][m][0], v1 = acc[ai][bj][m][1];
#pragma unroll
                    for (int e = 0; e < 4; ++e) { const float a = fmaxf(v0[e], 0.f), b = fmaxf(v1[e], 0.f); v0[e] = a * a; v1[e] = b * b; }
                    u32x4 w; w.x = cvt_pk_bf16(v0[0], v0[1]); w.y = cvt_pk_bf16(v0[2], v0[3]); w.z = cvt_pk_bf16(v1[0], v1[1]); w.w = cvt_pk_bf16(v1[2], v1[3]);
                    *(u32x4*)(rowp + bj * HALF) = w; } }
    }
};
struct EpiResid {
    static constexpr bool PERM = false, AFTER_DRAIN = false;
    const float* base; float* out; int ldc; const float* gate; float alpha;
    __device__ __forceinline__ void operator()(const f32x4 (&acc)[2][2][4][2], const Unit& u, int wr, int wc, int fr, int fq) const {
        const int col0 = u.pn * BM + wc * 32 + 4 * fq;
#pragma unroll
        for (int bj = 0; bj < 2; ++bj)
#pragma unroll
            for (int n = 0; n < 2; ++n) { const f32x4 gv = *(const f32x4*)(gate + col0 + bj * HALF + n * 16) + 1.0f;
#pragma unroll
                for (int ai = 0; ai < 2; ++ai)
#pragma unroll
                    for (int m = 0; m < 4; ++m) { const size_t off = (size_t)(u.pm * BM + ai * HALF + wr * 64 + m * 16 + fr) * ldc + col0 + bj * HALF + n * 16;
                        const f32x4 bs = *(const f32x4*)(base + off); *(f32x4*)(out + off) = bs * alpha + gv * acc[ai][bj][m][n]; } }
    }
};
template <class Epi, class Sched, bool ALIGN_EPI = false, bool SP2 = false>
__device__ __forceinline__ void gemm_phase(PG8_LAS unsigned char* lds, const Gemm g, const Sched& S, const Epi& E, const int wid  ) {
    int lane_ = __builtin_amdgcn_mbcnt_hi(~0u, __builtin_amdgcn_mbcnt_lo(~0u, 0u)); asm volatile("" : "+v"(lane_));
    const int lane = lane_, tid = wid * 64 + lane, wr = wid >> 2, wc = wid & 3, fr = lane & 15, fq = lane >> 4;
    const int K = g.K, nt = K / BK;
    unsigned voffA[2], voffB[2];
#pragma unroll
    for (int i = 0; i < 2; ++i) { int R, C; stage_rc(tid * 16 + i * 8192, R, C); const int Rb = Epi::PERM ? ((R & ~31) + perm32(R & 31)) : R;
        voffA[i] = (unsigned)(R * K + C) * 2u; voffB[i] = (unsigned)(Rb * K + C) * 2u; }
    const size_t kstep = (size_t)(BK * 2);
    const size_t hstep = (size_t)HALF * K * 2;
    const size_t tstep = 2 * hstep;
    const unsigned ldsw = (unsigned)wid * 1024u;
    const int aoff = lds_byte(wr * 64 + fr, fq * 8), boff = lds_byte(wc * 32 + fr, fq * 8);
#define PG8_SA(b, h) (((b) * 2 + (h)) * HTB)
#define PG8_SB(b, h) ((4 + (b) * 2 + (h)) * HTB)
#define PG8_STAGE(bufoff, gbase, voff) do { _Pragma("unroll") for (int _i = 0; _i < 2; ++_i) \
        __builtin_amdgcn_global_load_lds((const unsigned*)((const char*)(gbase) + (voff)[_i]), (PG8_LAS unsigned*)(lds + (bufoff) + ldsw + _i * 8192), 16, 0, 0); } while (0)
#define PG8_LDA(dst, b, h) do { _Pragma("unroll") for (int m = 0; m < 4; ++m) _Pragma("unroll") for (int k = 0; k < 2; ++k) dst[m][k] = *(const PG8_LAS bf16x8*)(lds + PG8_SA(b, h) + aoff + m * 2048 + k * 1024); } while (0)
#define PG8_LDB(dst, b, h) do { _Pragma("unroll") for (int n = 0; n < 2; ++n) _Pragma("unroll") for (int k = 0; k < 2; ++k) dst[n][k] = *(const PG8_LAS bf16x8*)(lds + PG8_SB(b, h) + boff + n * 2048 + k * 1024); } while (0)
#define PG8_MMA(ai, bj, At, Bt) do { __builtin_amdgcn_s_setprio(1); _Pragma("unroll") for (int m = 0; m < 4; ++m) _Pragma("unroll") for (int n = 0; n < 2; ++n) _Pragma("unroll") for (int k = 0; k < 2; ++k) \
        acc[ai][bj][m][n] = __builtin_amdgcn_mfma_f32_16x16x32_bf16(Bt[n][k], At[m][k], acc[ai][bj][m][n], 0, 0, 0); __builtin_amdgcn_s_setprio(0); } while (0)
#define PG8_WAIT_V(n) asm volatile("s_waitcnt vmcnt(" #n ")" ::: "memory")
#define PG8_WAIT_L(n) asm volatile("s_waitcnt lgkmcnt(" #n ")" ::: "memory")
#define PG8_BAR __builtin_amdgcn_s_barrier()
#define PG8_SCHED __builtin_amdgcn_sched_barrier(0)
    Unit cur, nxt; int ui = 0;
    if (!S.next(0, cur)) return;
    f32x4 acc[2][2][4][2];
#pragma unroll
    for (int a = 0; a < 2; ++a)
#pragma unroll
        for (int b = 0; b < 2; ++b)
#pragma unroll
            for (int m = 0; m < 4; ++m)
#pragma unroll
                for (int n = 0; n < 2; ++n) acc[a][b][m][n] = (f32x4){0.f, 0.f, 0.f, 0.f};
    bf16x8 At[4][2], B0[2][2], B1[2][2];
    const char* cA = (const char*)g.A + (size_t)cur.pm * tstep; const char* cB = (const char*)g.Bt + (size_t)cur.pn * tstep;
    S.a_ready(cur);
    if constexpr (SP2) {
        PG8_STAGE(PG8_SB(0, 0), cB, voffB); PG8_STAGE(PG8_SB(0, 1), cB + hstep, voffB); PG8_STAGE(PG8_SA(0, 0), cA, voffA); PG8_STAGE(PG8_SA(0, 1), cA + hstep, voffA);
        if (wr == 1) PG8_BAR;
        PG8_WAIT_V(2); PG8_BAR;
        PG8_STAGE(PG8_SB(1, 0), cB + kstep, voffB); PG8_STAGE(PG8_SA(1, 0), cA + kstep, voffA); PG8_STAGE(PG8_SB(1, 1), cB + hstep + kstep, voffB);
        PG8_WAIT_V(6); PG8_BAR;
    } else {
        PG8_STAGE(PG8_SB(0, 0), cB, voffB); PG8_STAGE(PG8_SA(0, 0), cA, voffA); PG8_STAGE(PG8_SB(0, 1), cB + hstep, voffB); PG8_STAGE(PG8_SA(0, 1), cA + hstep, voffA);
        if (wr == 1) PG8_BAR;
        PG8_WAIT_V(4); PG8_BAR;
        PG8_STAGE(PG8_SB(1, 0), cB + kstep, voffB); PG8_STAGE(PG8_SA(1, 0), cA + kstep, voffA); PG8_STAGE(PG8_SB(1, 1), cB + hstep + kstep, voffB);
        PG8_WAIT_V(6); PG8_BAR;
    }
    for (;;) {
        const bool has_next = S.next(ui + 1, nxt);
        const char* nA = has_next ? (const char*)g.A + (size_t)nxt.pm * tstep : cA; const char* nB = has_next ? (const char*)g.Bt + (size_t)nxt.pn * tstep : cB;
        for (int t = 0; t < nt; t += 2) {
            const bool last = (t == nt - 2);
            const char* a1 = cA + (size_t)(t + 1) * kstep;
            const char* a2 = last ? nA : cA + (size_t)(t + 2) * kstep; const char* b2 = last ? nB : cB + (size_t)(t + 2) * kstep;
            const char* a3 = a2 + kstep; const char* b3 = b2 + kstep;
            if (last && has_next) S.a_ready(nxt);
            if constexpr (SP2) {
            PG8_LDB(B0, 0, 0); PG8_LDB(B1, 0, 1); PG8_SCHED; PG8_LDA(At, 0, 0); PG8_STAGE(PG8_SA(1, 1), a1 + hstep, voffA);
            PG8_WAIT_V(8); PG8_WAIT_L(0); PG8_BAR; PG8_MMA(0, 0, At, B0); PG8_MMA(0, 1, At, B1); PG8_BAR; PG8_SCHED;
            PG8_LDA(At, 0, 1); PG8_STAGE(PG8_SB(0, 0), b2, voffB); PG8_STAGE(PG8_SB(0, 1), b2 + hstep, voffB); PG8_STAGE(PG8_SA(0, 0), a2, voffA);
            PG8_WAIT_V(8); PG8_WAIT_L(0); PG8_BAR; PG8_MMA(1, 0, At, B0); PG8_MMA(1, 1, At, B1); PG8_BAR; PG8_SCHED;
            PG8_LDB(B0, 1, 0); PG8_LDB(B1, 1, 1); PG8_SCHED; PG8_LDA(At, 1, 0); PG8_STAGE(PG8_SA(0, 1), a2 + hstep, voffA);
            PG8_WAIT_V(8); PG8_WAIT_L(0); PG8_BAR; PG8_MMA(0, 0, At, B0); PG8_MMA(0, 1, At, B1); PG8_BAR; PG8_SCHED;
            PG8_LDA(At, 1, 1); PG8_STAGE(PG8_SB(1, 0), b3, voffB); PG8_STAGE(PG8_SB(1, 1), b3 + hstep, voffB); PG8_STAGE(PG8_SA(1, 0), a3, voffA);
            PG8_WAIT_V(8); PG8_WAIT_L(0); PG8_BAR; PG8_MMA(1, 0, At, B0); PG8_MMA(1, 1, At, B1); PG8_BAR; PG8_SCHED;
            } else {
            PG8_LDB(B0, 0, 0); PG8_SCHED; PG8_LDA(At, 0, 0); PG8_STAGE(PG8_SA(1, 1), a1 + hstep, voffA);
            PG8_WAIT_L(8); PG8_BAR; PG8_WAIT_L(0); PG8_MMA(0, 0, At, B0); PG8_BAR; PG8_SCHED;
            PG8_LDB(B1, 0, 1); PG8_STAGE(PG8_SB(0, 0), b2, voffB);
            PG8_BAR; PG8_WAIT_L(0); PG8_MMA(0, 1, At, B1); PG8_BAR;
            PG8_LDA(At, 0, 1); PG8_STAGE(PG8_SA(0, 0), a2, voffA);
            PG8_BAR; PG8_WAIT_L(0); PG8_MMA(1, 0, At, B0); PG8_BAR; PG8_SCHED;
            PG8_STAGE(PG8_SB(0, 1), b2 + hstep, voffB);
            PG8_WAIT_V(6); PG8_BAR; PG8_MMA(1, 1, At, B1); PG8_BAR;
            PG8_LDB(B0, 1, 0); PG8_SCHED; PG8_LDA(At, 1, 0); PG8_STAGE(PG8_SA(0, 1), a2 + hstep, voffA);
            PG8_WAIT_L(8); PG8_BAR; PG8_WAIT_L(0); PG8_MMA(0, 0, At, B0); PG8_BAR; PG8_SCHED;
            PG8_LDB(B1, 1, 1); PG8_STAGE(PG8_SB(1, 0), b3, voffB);
            PG8_BAR; PG8_WAIT_L(0); PG8_MMA(0, 1, At, B1); PG8_BAR;
            PG8_LDA(At, 1, 1); PG8_STAGE(PG8_SA(1, 0), a3, voffA);
            PG8_BAR; PG8_WAIT_L(0); PG8_MMA(1, 0, At, B0); PG8_BAR; PG8_SCHED;
            PG8_STAGE(PG8_SB(1, 1), b3 + hstep, voffB);
            PG8_WAIT_V(6); PG8_BAR; PG8_MMA(1, 1, At, B1); PG8_BAR;
            }
        }
        if constexpr (ALIGN_EPI) { if (wr == 0) PG8_BAR; }
        if constexpr (!Epi::AFTER_DRAIN) { E(acc, cur, wr, wc, fr, fq); S.done(cur); }
        if (!has_next) break;
#pragma unroll
        for (int a = 0; a < 2; ++a)
#pragma unroll
            for (int b = 0; b < 2; ++b)
#pragma unroll
                for (int m = 0; m < 4; ++m)
#pragma unroll
                    for (int n = 0; n < 2; ++n) acc[a][b][m][n] = (f32x4){0.f, 0.f, 0.f, 0.f};
        cur = nxt; cA = nA; cB = nB; ++ui;
        if constexpr (ALIGN_EPI) { if (wr == 1) PG8_BAR; }
    }
    PG8_WAIT_V(0);
    if constexpr (!ALIGN_EPI) { if (wr == 0) PG8_BAR; }
    PG8_BAR;
    if constexpr (Epi::AFTER_DRAIN) { E.fused(acc, cur, wr, wc, fr, fq, lds, wid, lane); S.done(cur); }
#undef PG8_SA
#undef PG8_SB
#undef PG8_STAGE
#undef PG8_LDA
#undef PG8_LDB
#undef PG8_MMA
#undef PG8_WAIT_V
#undef PG8_WAIT_L
#undef PG8_BAR
#undef PG8_SCHED
}
}

#ifndef PG8_SP2
#define PG8_SP2 true
#endif
#ifndef PG8_ALIGN
#define PG8_ALIGN true
#endif

constexpr int S = 16384, DM = 1024, NIN = 2584, NINP = 2816, DFF = 4096, DEPTH = 4;
constexpr int NWAVES = 8, NTHREADS = 512;
constexpr float LN_EPS = 1e-5f;
constexpr float LOG2E = 1.4426950408889634f;
constexpr float QSCALE = 0.125f * LOG2E;
constexpr float DN_ALPHA = 1.681792830507429f;
constexpr int C_AQ = 0, C_AK = 256, C_AV = 512, C_BQ = 768, C_BK = 1024, C_BV = 1152, C_CQ = 1280, C_CKC = 1792, C_CVC = 1920,
              C_CKS = 2048, C_CVS = 2176, C_CKW = 2304, C_CVW = 2432, C_CG = 2560;
constexpr int NCMP = 1023, NSEL = 256;
constexpr int BIASLEN = 2048;

constexpr size_t MiB = 1u << 20;
constexpr size_t WS_CTL = 0, CTL_ZERO_BYTES = 1 * MiB;
constexpr size_t WS_MOD = 1 * MiB;
constexpr size_t WS_BIAS = 1 * MiB + 128 * 1024;
constexpr size_t WS_BMAX = 1 * MiB + 256 * 1024;
constexpr size_t WS_ROPE = 2 * MiB;
constexpr size_t WS_KC = 6 * MiB, WS_VC = 6 * MiB + 512 * 1024;
constexpr size_t WS_WIN = 8 * MiB;
constexpr size_t WS_WOUT = 30 * MiB;
constexpr size_t WS_W1 = 38 * MiB;
constexpr size_t WS_W2 = 70 * MiB;
constexpr size_t WS_CW1 = 102 * MiB;
constexpr size_t WS_RA = 110 * MiB, WS_RB = 142 * MiB;
constexpr size_t WS_BIG = 174 * MiB;
constexpr size_t WS_OWIN = WS_BIG + 88 * MiB;
constexpr size_t WS_OA3 = WS_BIG + 104 * MiB;
constexpr size_t WS_OCMP = 302 * MiB;
constexpr size_t WS_SELB = 318 * MiB;
constexpr size_t WS_LSE = 319 * MiB;
constexpr size_t WS_END = 320 * MiB;
constexpr size_t WS_KCB = 7 * MiB, WS_VCB = 7 * MiB + 512 * 1024;
constexpr int CW_MAX = 16384;

#define GAS __attribute__((address_space(1)))
#define LAS __attribute__((address_space(3)))
typedef unsigned short bf16;
typedef unsigned v4u __attribute__((ext_vector_type(4)));
typedef unsigned v2u __attribute__((ext_vector_type(2)));
typedef float f32x4 __attribute__((ext_vector_type(4)));
typedef float f32x2 __attribute__((ext_vector_type(2)));
#define LDS_WAIT() asm volatile("s_waitcnt lgkmcnt(0)" ::: "memory")
#define VM_WAIT() asm volatile("s_waitcnt vmcnt(0)" ::: "memory")
__device__ __forceinline__ unsigned f2bf(float f) { unsigned u = __builtin_bit_cast(unsigned, f); return (u + 0x7fffu + ((u >> 16) & 1u)) >> 16; }
__device__ __forceinline__ unsigned pk2(float lo, float hi) { return f2bf(lo) | (f2bf(hi) << 16); }
__device__ __forceinline__ float bf2f(unsigned short b) { return __uint_as_float((unsigned)b << 16); }
__device__ __forceinline__ float bflo(unsigned w) { return __uint_as_float(w << 16); }
__device__ __forceinline__ float bfhi(unsigned w) { return __uint_as_float(w & 0xffff0000u); }
__device__ __forceinline__ float wave_sum(float v) {
#pragma unroll
    for (int o = 1; o < 64; o <<= 1) v += __shfl_xor(v, o);
    return v;
}
__device__ __forceinline__ float wave_max(float v) {
#pragma unroll
    for (int o = 1; o < 64; o <<= 1) v = fmaxf(v, __shfl_xor(v, o));
    return v;
}

constexpr int RING_BYTES = 153600;
constexpr int LDSCTL_OFF = RING_BYTES, MISC_OFF = LDSCTL_OFF + 320;
constexpr int LDS_BYTES = 155648;

struct Args { const float* in[16]; float* out; unsigned char* ws; int ph_lo, ph_hi; };

struct Frame {
    LAS unsigned char* lds;
    int tid, lane, wave, G, vcu;
    unsigned char* ws;
    const float* in[16];
    float* out;
};
enum { I_X = 0, I_C, I_POS, I_WIN, I_WOUT, I_RELB, I_SINK, I_CPOS, I_CW1, I_CW2, I_MW1, I_MW2, I_ADAW, I_ADAB, I_LNG, I_LNB };

__device__ __forceinline__ int t5_bucket(int d) {
    if (d < 16) return d;
    int b = 16;
    b += d >= 22; b += d >= 30; b += d >= 40; b += d >= 54; b += d >= 73; b += d >= 99; b += d >= 134; b += d >= 182;
    b += d >= 246; b += d >= 332; b += d >= 450; b += d >= 609; b += d >= 825; b += d >= 1117; b += d >= 1513;
    return b;
}
__device__ const float ROPE_FREQ[32] = {1.000000000e+00f, 6.890442967e-01f, 4.747820497e-01f, 3.271458745e-01f, 2.254180014e-01f, 1.553229839e-01f, 1.070244238e-01f, 7.374456525e-02f,
    5.081327632e-02f, 3.501259908e-02f, 2.412523143e-02f, 1.662335359e-02f, 1.145422645e-02f, 7.892469876e-03f, 5.438261200e-03f, 3.747202922e-03f,
    2.581988927e-03f, 1.779104699e-03f, 1.225881977e-03f, 8.446869906e-04f, 5.820267834e-04f, 4.010422272e-04f, 2.763358643e-04f, 1.904076635e-04f,
    1.311993110e-04f, 9.040213627e-05f, 6.229108112e-05f, 4.292131416e-05f, 2.957468678e-05f, 2.037826926e-05f, 1.404153045e-05f, 9.675236470e-06f};
__device__ __forceinline__ void sincos_f(float a, float& c, float& s) {
    const float n = rintf(a * 0.636619772367581343f);
    float r = fmaf(-n, 1.5703125f, a); r = fmaf(-n, 0.0004838267923332751f, r); r = fmaf(-n, 2.5632829192545614e-12f, r);
    const float r2 = r * r;
    const float sp = fmaf(r * r2, fmaf(r2, fmaf(r2, fmaf(r2, 2.755731922e-6f, -1.984126984e-4f), 8.333333333e-3f), -1.666666667e-1f), r);
    const float cp = fmaf(r2, fmaf(r2, fmaf(r2, fmaf(r2, fmaf(r2, -2.755731922e-7f, 2.480158730e-5f), -1.388888889e-3f), 4.166666667e-2f), -0.5f), 1.0f);
    const int q = ((int)n) & 3;
    c = (q == 0) ? cp : (q == 1) ? -sp : (q == 2) ? -cp : sp;
    s = (q == 0) ? sp : (q == 1) ? cp : (q == 2) ? -sp : -cp;
}

template <int MODE>
__device__ __forceinline__ int colmap(int n) {
    if (MODE == 0) return n;
    if (n >= NIN) return -1;
    if (n >= C_BQ && n < C_BV) { const int hb = n & ~63, j = n & 63; return hb + (j >> 1) + 32 * (j & 1); }
    return n;
}
template <int MODE>
__device__ __forceinline__ void transpose_item(const float* W, int K, int N, int NP, bf16* WT, LAS float* scr, int item, int lane) {
    const int nblk = NP / 32, kb = item / nblk, nb = item % nblk, k0 = 64 * kb, n0 = 32 * nb;
    const int src = colmap<MODE>(n0 + (lane & 31));
#pragma unroll 8
    for (int i = 0; i < 32; ++i) { const int kk = 2 * i + (lane >> 5); scr[kk * 33 + (lane & 31)] = src >= 0 ? W[(size_t)(k0 + kk) * N + src] : 0.f; }
    LDS_WAIT(); asm volatile("" ::: "memory");
    const int c = lane & 7;
#pragma unroll
    for (int j = 0; j < 4; ++j) { const int n = (lane >> 3) + 8 * j; const LAS float* s = scr + (8 * c) * 33 + n;
        v4u o; o.x = pk2(s[0 * 33], s[1 * 33]); o.y = pk2(s[2 * 33], s[3 * 33]); o.z = pk2(s[4 * 33], s[5 * 33]); o.w = pk2(s[6 * 33], s[7 * 33]);
        *(v4u*)(WT + (size_t)(n0 + n) * K + k0 + 8 * c) = o; }
    LDS_WAIT(); asm volatile("" ::: "memory");
}

__device__ __forceinline__ void p0_prologue(Frame& F) {
    LAS float* scr = (LAS float*)(F.lds + F.wave * 16384);
    const int gw = F.vcu * NWAVES + F.wave, NGW = F.G * NWAVES;
    constexpr int I_IN = (DM / 64) * (NINP / 32), I_OUT = (DM / 64) * (DM / 32), I_1 = (DM / 64) * (DFF / 32), I_2 = (DFF / 64) * (DM / 32);
    constexpr int PER_LAYER = I_IN + I_OUT + I_1 + I_2;
    for (int it = gw; it < DEPTH * PER_LAYER; it += NGW) {
        const int l = it / PER_LAYER; int r = it % PER_LAYER;
        if (r < I_IN) { transpose_item<1>(F.in[I_WIN] + (size_t)l * DM * NIN, DM, NIN, NINP, (bf16*)(F.ws + WS_WIN) + (size_t)l * NINP * DM, scr, r, F.lane); continue; } r -= I_IN;
        if (r < I_OUT) { transpose_item<0>(F.in[I_WOUT] + (size_t)l * DM * DM, DM, DM, DM, (bf16*)(F.ws + WS_WOUT) + (size_t)l * DM * DM, scr, r, F.lane); continue; } r -= I_OUT;
        if (r < I_1) { transpose_item<0>(F.in[I_MW1] + (size_t)l * DM * DFF, DM, DFF, DFF, (bf16*)(F.ws + WS_W1) + (size_t)l * DFF * DM, scr, r, F.lane); continue; } r -= I_1;
        transpose_item<0>(F.in[I_MW2] + (size_t)l * DFF * DM, DFF, DM, DM, (bf16*)(F.ws + WS_W2) + (size_t)l * DM * DFF, scr, r, F.lane);
    }
    {
        __syncthreads();
        LAS float* red = (LAS float*)F.lds;
        const int nl = F.tid & 63, kp = F.tid >> 6;
        for (int it = F.vcu; it < DEPTH * 96; it += F.G) {
            const int l = it / 96, n = (it % 96) * 64 + nl;
            const float* w = F.in[I_ADAW] + (size_t)l * DM * 6144 + n;
            const float* c = F.in[I_C];
            float a = 0.f;
#pragma unroll 8
            for (int k = kp * 128; k < kp * 128 + 128; ++k) { const float cv = c[k]; a += (cv / (1.0f + __expf(-cv))) * w[(size_t)k * 6144]; }
            red[kp * 64 + nl] = a;
            __syncthreads();
            if (kp == 0) { float s = F.in[I_ADAB][l * 6144 + n];
#pragma unroll
                for (int j = 0; j < 8; ++j) s += red[j * 64 + nl];
                ((float*)(F.ws + WS_MOD))[l * 6144 + n] = s; }
            __syncthreads();
        }
    }
    {
        const int gt = F.vcu * NTHREADS + F.tid, NGT = F.G * NTHREADS;
        const int* pos = (const int*)F.in[I_POS];
        f32x2* rt = (f32x2*)(F.ws + WS_ROPE);
        for (int e = gt; e < S * 32; e += NGT) {
            const int r = e >> 5, i = e & 31;
            const float ang = (float)pos[r] * ROPE_FREQ[i];
            float cs, sn; sincos_f(ang, cs, sn);
            rt[e] = (f32x2){cs, sn};
        }
        if (gt < 12) { float m = -1e30f; for (int b = 0; b < 32; ++b) m = fmaxf(m, F.in[I_RELB][b * 12 + gt] * LOG2E); ((float*)(F.ws + WS_BMAX))[gt] = m; }
        float* bt = (float*)(F.ws + WS_BIAS);
        for (int e = gt; e < 12 * BIASLEN; e += NGT) {
            const int h = e / BIASLEN, d = e % BIASLEN;
            bt[e] = F.in[I_RELB][t5_bucket(d) * 12 + h] * LOG2E;
        }
    }
}

template <int MODE>
__device__ __forceinline__ void row_pass(Frame& F, const float* xin, float* xout, bf16* H, const float* lng, const float* lnb, const float* sc, const float* sh) {
    const int gw = F.vcu * NWAVES + F.wave, NGW = F.G * NWAVES;
    for (int m = gw; m < S; m += NGW) {
        const f32x4* xr = (const f32x4*)(xin + (size_t)m * DM) + F.lane;
        f32x4 v[4];
#pragma unroll
        for (int j = 0; j < 4; ++j) v[j] = xr[64 * j];
        if (MODE != 0) {
            float s = 0.f;
#pragma unroll
            for (int j = 0; j < 4; ++j) s += (v[j].x + v[j].y) + (v[j].z + v[j].w);
            const float mean = wave_sum(s) * (1.f / DM); float s2 = 0.f;
#pragma unroll
            for (int j = 0; j < 4; ++j) { v[j] = v[j] - mean; s2 += (v[j].x * v[j].x + v[j].y * v[j].y) + (v[j].z * v[j].z + v[j].w * v[j].w); }
            const float rstd = 1.f / sqrtf(wave_sum(s2) * (1.f / DM) + LN_EPS);
            f32x4* xo = (f32x4*)(xout + (size_t)m * DM) + F.lane;
#pragma unroll
            for (int j = 0; j < 4; ++j) { const f32x4 g = ((const f32x4*)lng)[F.lane + 64 * j], b = ((const f32x4*)lnb)[F.lane + 64 * j]; v[j] = v[j] * rstd * g + b; xo[64 * j] = v[j]; }
        }
        if (MODE != 2) {
            v2u* o8 = (v2u*)(H + (size_t)m * DM) + F.lane;
#pragma unroll
            for (int j = 0; j < 4; ++j) { const f32x4 a = ((const f32x4*)sc)[F.lane + 64 * j] + 1.0f, b = ((const f32x4*)sh)[F.lane + 64 * j]; const f32x4 h = v[j] * a + b;
                o8[64 * j] = (v2u){pk2(h.x, h.y), pk2(h.z, h.w)}; }
        }
    }
}

typedef GAS unsigned gu32;
typedef GAS unsigned long long gu64;
#define RLX_AGENT __ATOMIC_RELAXED, __HIP_MEMORY_SCOPE_AGENT
__device__ __forceinline__ unsigned long long rt() { return __builtin_amdgcn_s_memrealtime(); }

#define XB_TMO      128
#define XB_XCNT(j)  (256  + 64 * (j))
#define XB_XSUB(j)  (1280 + 64 * (j))
#define XB_XGEN(j)  (2304 + 64 * (j))
#define XB_TOP      3328
#define XB_TOPGEN   3392
#define XCD_BAR_WORDS 3456
#define XB_SPIN_CAP (1u << 18)

__device__ __forceinline__ unsigned xb_ld(unsigned* p)              { return __hip_atomic_load(p, __ATOMIC_RELAXED, __HIP_MEMORY_SCOPE_AGENT); }
__device__ __forceinline__ unsigned xb_add(unsigned* p, unsigned v) { return __hip_atomic_fetch_add(p, v, __ATOMIC_RELAXED, __HIP_MEMORY_SCOPE_AGENT); }
__device__ __forceinline__ unsigned xb_xcc_id() { return (unsigned)__builtin_amdgcn_s_getreg((3 << 11) | 20) & 0xFu; }
#define XB_SPIN(cond, bar) do { unsigned _sp = 0; while (cond) { __builtin_amdgcn_s_sleep(1); \
    if ((++_sp & 255u) == 0u) { if (xb_ld(&(bar)[XB_TMO])) break; if (_sp > XB_SPIN_CAP) { atomicAdd(&(bar)[XB_TMO], 1u); break; } } } } while (0)

struct XcdBarrier {
    unsigned* bar; unsigned x;
    volatile LAS unsigned* st;
};

__device__ __forceinline__ XcdBarrier xcd_barrier_post(unsigned* bar, volatile LAS unsigned* st) {
    XcdBarrier b; b.bar = bar; b.x = xb_xcc_id(); b.st = st;
    if (threadIdx.x == 0) (void)xb_add(&bar[XB_XCNT(b.x)], 1u);
    return b;
}
__device__ __forceinline__ void xcd_barrier_complete(unsigned* bar, unsigned x, unsigned& nloc, unsigned& nx) {
    const unsigned G = gridDim.x * gridDim.y * gridDim.z;
    unsigned sum, cnt, mine, sp = 0u;
    for (;;) {
        sum = 0u; cnt = 0u; mine = 0u;
#pragma unroll
        for (unsigned j = 0; j < 16; ++j) { const unsigned c = xb_ld(&bar[XB_XCNT(j)]); sum += c; cnt += (c > 0u) ? 1u : 0u; mine = (j == x) ? c : mine; }
        if (sum == G) break;
        __builtin_amdgcn_s_sleep(1);
        if ((++sp & 255u) == 0u) { if (xb_ld(&bar[XB_TMO])) break; if (sp > XB_SPIN_CAP) { atomicAdd(&bar[XB_TMO], 1u); break; } }
    }
    nloc = mine > 0u ? mine : 1u; nx = cnt > 0u ? cnt : 1u;
}

__device__ __forceinline__ void xcd_barrier(const XcdBarrier& b) {
    asm volatile("s_waitcnt vmcnt(0)" ::: "memory");
    __syncthreads();
    if (threadIdx.x == 0) {
        unsigned* bar = b.bar;
        __builtin_amdgcn_s_waitcnt(0);
        unsigned nloc = b.st[0], nx = b.st[1];
        if (nloc == 0u) { xcd_barrier_complete(bar, b.x, nloc, nx); b.st[0] = nloc; b.st[1] = nx; }
        const unsigned old = xb_add(&bar[XB_XSUB(b.x)], 1u);
        const unsigned gen = old / nloc;
        if (old + 1u == (gen + 1u) * nloc) {
            __builtin_amdgcn_fence(__ATOMIC_RELEASE, "agent");
            asm volatile("s_waitcnt vmcnt(0)" ::: "memory");
            const unsigned og = xb_add(&bar[XB_TOP], 1u);
            const unsigned tg = og / nx;
            if (og + 1u == (tg + 1u) * nx) xb_add(&bar[XB_TOPGEN], 1u);
            else XB_SPIN(xb_ld(&bar[XB_TOPGEN]) == tg, bar);
            __builtin_amdgcn_fence(__ATOMIC_ACQUIRE, "agent");
            xb_add(&bar[XB_XGEN(b.x)], 1u);
            asm volatile("s_waitcnt vmcnt(0)" ::: "memory");
        } else {
            XB_SPIN(xb_ld(&bar[XB_XGEN(b.x)]) == gen, bar);
            __builtin_amdgcn_fence(__ATOMIC_ACQUIRE, "agent");
            asm volatile("s_waitcnt vmcnt(0)" ::: "memory");
        }
    }
    __syncthreads();
}


__device__ __forceinline__ float ld_elem(const bf16* p) { return bf2f(*p); }
__device__ __forceinline__ float ld_elem(const float* p) { return *p; }
template <int G>
__device__ __forceinline__ void dot64(const bf16* k, const LAS float* qs, float (&s)[G]) {
    const v4u* kp = (const v4u*)k;
#pragma unroll 2
    for (int c = 0; c < 8; ++c) { const v4u w = kp[c];
        float kv[8] = {bflo(w.x), bfhi(w.x), bflo(w.y), bfhi(w.y), bflo(w.z), bfhi(w.z), bflo(w.w), bfhi(w.w)};
#pragma unroll
        for (int g = 0; g < G; ++g) { const LAS f32x4* q4 = (const LAS f32x4*)(qs + g * 64 + c * 8); const f32x4 a = q4[0], b = q4[1];
            s[g] += kv[0] * a.x + kv[1] * a.y + kv[2] * a.z + kv[3] * a.w + kv[4] * b.x + kv[5] * b.y + kv[6] * b.z + kv[7] * b.w; } }
}
template <int G>
__device__ __forceinline__ void dot64(const float* k, const LAS float* qs, float (&s)[G]) {
    const f32x4* kp = (const f32x4*)k;
#pragma unroll 2
    for (int c = 0; c < 16; ++c) { const f32x4 w = kp[c];
#pragma unroll
        for (int g = 0; g < G; ++g) { const f32x4 a = *(const LAS f32x4*)(qs + g * 64 + c * 4); s[g] += w.x * a.x + w.y * a.y + w.z * a.z + w.w * a.w; } }
}
template <int G, class KT, class KeyFn>
__device__ __forceinline__ void wave_attend(const KT* K, const KT* V, const LAS float* qs, int nk, const KeyFn& kf, float (&m)[G], float (&l)[G], float (&o)[G], int lane) {
    for (int base = 0; base < nk; base += 64) {
        const int i = base + lane;
        long off = 0; float s[G], p[G];
#pragma unroll
        for (int g = 0; g < G; ++g) s[g] = 0.f;
        bool valid = false;
        if (i < nk) valid = kf(i, off, s);
        const LAS float* qo = qs; asm volatile("" : "+v"(qo));
        if (valid) dot64<G>(K + off, qo, s);
        const unsigned long long mask = __ballot(valid);
        if (mask == 0ull) continue;
#pragma unroll
        for (int g = 0; g < G; ++g) {
            const float sv = valid ? s[g] : -1e30f;
            const float mn = fmaxf(m[g], wave_max(sv));
            const float scl = exp2f(m[g] - mn);
            p[g] = valid ? exp2f(sv - mn) : 0.f;
            l[g] = l[g] * scl + wave_sum(p[g]); o[g] *= scl; m[g] = mn;
        }
#pragma unroll 2
        for (int j = 0; j < 64; ++j) {
            if (!((mask >> j) & 1ull)) continue;
            const unsigned olo = __builtin_amdgcn_readlane((unsigned)(unsigned long long)off, j), ohi = __builtin_amdgcn_readlane((unsigned)((unsigned long long)off >> 32), j);
            const long oj = (long)(((unsigned long long)ohi << 32) | olo);
            const float v = ld_elem(V + oj + lane);
#pragma unroll
            for (int g = 0; g < G; ++g) o[g] += __uint_as_float(__builtin_amdgcn_readlane(__float_as_uint(p[g]), j)) * v;
        }
    }
}

struct KeyA { int p, r; const float* bias; __device__ __forceinline__ bool operator()(int i, long& off, float (&b)[1]) const {
    const int row = p - r * i; if (row < 0) return false; off = (long)row * NINP; const int d = r * i; b[0] = bias[d < BIASLEN ? d : BIASLEN - 1]; return true; } };
struct KeyB { int p; __device__ __forceinline__ bool operator()(int i, long& off, float (&b)[2]) const {
    const int row = p - i; if (row < 0) return false; off = (long)row * NINP; return true; } };
struct KeyW { int p; const float* bias; __device__ __forceinline__ bool operator()(int i, long& off, float (&b)[4]) const {
    const int row = p - i; if (row < 0) return false; off = (long)row * NINP;
#pragma unroll
    for (int g = 0; g < 4; ++g) b[g] = bias[g * BIASLEN + i]; return true; } };

__device__ __forceinline__ void load_q(const bf16* q, LAS float* qs, int lane) { qs[lane] = bf2f(q[lane]); }

__device__ __forceinline__ void p2_token_attention(Frame& F, int layer, const bf16* PROJ, bf16* MIXED, bf16* OWIN) {
    LAS float* qs = (LAS float*)(F.lds + F.wave * 2048);
    const int gw = F.vcu * NWAVES + F.wave, NGW = F.G * NWAVES, lane = F.lane;
    const float* bias2 = (const float*)(F.ws + WS_BIAS);
    for (int it = gw; it < S * 4; it += NGW) {
        const int p = it >> 2, h = it & 3;
        load_q(PROJ + (size_t)p * NINP + C_AQ + h * 64, qs, lane); LDS_WAIT(); asm volatile("" ::: "memory");
        float m[1] = {-1e30f}, l[1] = {0.f}, o[1] = {0.f};
        const bf16* K = PROJ + C_AK + h * 64; const bf16* V = PROJ + C_AV + h * 64;
#pragma unroll 1
        for (int c = 0; c < 3; ++c) { const int r = c == 0 ? 1 : (c == 1 ? 4 : 16); KeyA kf{p, r, bias2 + h * BIASLEN}; wave_attend<1>(K, V, qs, 129, kf, m, l, o, lane); }
        MIXED[(size_t)p * DM + h * 64 + lane] = (bf16)f2bf(o[0] / l[0]);
        LDS_WAIT(); asm volatile("" ::: "memory");
    }
    for (int it = gw; it < S * 2; it += NGW) {
        const int p = it >> 1, kvh = it & 1;
        load_q(PROJ + (size_t)p * NINP + C_BQ + (2 * kvh) * 64, qs, lane); load_q(PROJ + (size_t)p * NINP + C_BQ + (2 * kvh + 1) * 64, qs + 64, lane); LDS_WAIT(); asm volatile("" ::: "memory");
        float m[2] = {-1e30f, -1e30f}, l[2] = {0.f, 0.f}, o[2] = {0.f, 0.f};
        KeyB kf{p}; wave_attend<2>(PROJ + C_BK + kvh * 64, PROJ + C_BV + kvh * 64, qs, 128, kf, m, l, o, lane);
#pragma unroll
        for (int g = 0; g < 2; ++g) { const float sk = F.in[I_SINK][layer * 4 + 2 * kvh + g] * LOG2E; const float mn = fmaxf(m[g], sk); const float scl = exp2f(m[g] - mn);
            const float den = l[g] * scl + exp2f(sk - mn); MIXED[(size_t)p * DM + 256 + (2 * kvh + g) * 64 + lane] = (bf16)f2bf(o[g] * scl / den); }
        LDS_WAIT(); asm volatile("" ::: "memory");
    }
    for (int it = gw; it < S * 2; it += NGW) {
        const int p = it >> 1, kvh = it & 1;
#pragma unroll
        for (int g = 0; g < 4; ++g) load_q(PROJ + (size_t)p * NINP + C_CQ + (4 * kvh + g) * 64, qs + g * 64, lane);
        LDS_WAIT(); asm volatile("" ::: "memory");
        float m[4] = {-1e30f, -1e30f, -1e30f, -1e30f}, l[4] = {0.f, 0.f, 0.f, 0.f}, o[4] = {0.f, 0.f, 0.f, 0.f};
        KeyW kf{p, bias2 + (4 + 4 * kvh) * BIASLEN}; wave_attend<4>(PROJ + C_CKW + kvh * 64, PROJ + C_CVW + kvh * 64, qs, 512, kf, m, l, o, lane);
#pragma unroll
        for (int g = 0; g < 4; ++g) OWIN[(size_t)p * 512 + (4 * kvh + g) * 64 + lane] = (bf16)f2bf(o[g] / l[g]);
        LDS_WAIT(); asm volatile("" ::: "memory");
    }
}

__device__ __forceinline__ float gelu_tanh(float x) { const float u = 0.7978845608028654f * (x + 0.044715f * x * x * x); return 0.5f * x * (1.0f + tanhf(u)); }
__device__ __forceinline__ void p2_compress(Frame& F, int layer, const bf16* PROJ) {
    LAS float* flat = (LAS float*)F.lds;
    LAS float* hid = flat + 8 * 2048;
    const int tid = F.tid;
    for (int it = F.vcu; it < 2 * 256; it += F.G) {
        const int kv = it >> 8, rg = it & 255;
        const float* pos = F.in[I_CPOS] + ((size_t)layer * 2 + kv) * 2048;
        const float* w1 = F.in[I_CW1] + ((size_t)layer * 2 + kv) * 2048 * 256;
        const float* w2 = F.in[I_CW2] + ((size_t)layer * 2 + kv) * 256 * 64;
        float* outp = (float*)(F.ws + (kv ? WS_VC : WS_KC));
        __syncthreads();
        for (int e = tid; e < 8 * 2048; e += NTHREADS) {
            const int r = e >> 11, f = e & 2047, R = rg * 8 + r, i = R >> 1, hk = R & 1, t = f >> 6, d = f & 63;
            float v = 0.f;
            if (i < NCMP) v = bf2f(PROJ[(size_t)(16 * i + t) * NINP + (kv ? C_CVC : C_CKC) + hk * 64 + d]) + pos[f];
            flat[e] = v;
        }
        __syncthreads();
        { const int j = tid & 255, half = tid >> 8; float a[4] = {0.f, 0.f, 0.f, 0.f}; const LAS float* fl = flat + half * 4 * 2048;
#pragma unroll 4
            for (int f = 0; f < 2048; ++f) { const float w = w1[(size_t)f * 256 + j];
#pragma unroll
                for (int r = 0; r < 4; ++r) a[r] += fl[r * 2048 + f] * w; }
#pragma unroll
            for (int r = 0; r < 4; ++r) hid[(half * 4 + r) * 256 + j] = gelu_tanh(a[r]); }
        __syncthreads();
        { const int r = tid >> 6, e = tid & 63, R = rg * 8 + r; float a = 0.f;
#pragma unroll 8
            for (int j = 0; j < 256; ++j) a += hid[r * 256 + j] * w2[j * 64 + e];
            if ((R >> 1) < NCMP) { outp[(size_t)R * 64 + e] = a; const unsigned ab = f2bf(a); ((bf16*)(F.ws + (kv ? WS_VCB : WS_KCB)))[(size_t)R * 64 + e] = (bf16)ab;
                const float ar = bf2f((unsigned short)ab); const float n2 = wave_sum(ar * ar);
                if (kv == 0 && e == 0) __hip_atomic_fetch_max((unsigned*)(F.ws + WS_CTL) + CW_MAX + layer * 16 + (R & 1), __float_as_uint(n2), __ATOMIC_RELAXED, __HIP_MEMORY_SCOPE_AGENT); } }
    }
    __syncthreads();
}

struct KeyCmp { int g; __device__ __forceinline__ bool operator()(int i, long& off, float (&b)[4]) const { off = ((long)i * 2 + g) * 64; return true; } };
struct KeySel { int p, blk; const float* bias; __device__ __forceinline__ bool operator()(int i, long& off, float (&b)[4]) const {
    const int kpos = blk * 64 + i; if (kpos > p) return false; off = (long)kpos * NINP; const int d = p - kpos;
#pragma unroll
    for (int g = 0; g < 4; ++g) b[g] = bias[g * BIASLEN + (d < BIASLEN ? d : BIASLEN - 1)]; return true; } };

__device__ __forceinline__ void p3_nsa(Frame& F, int layer, const bf16* PROJ, const bf16* OWIN, bf16* MIXED) {
    LAS float* qs = (LAS float*)(F.lds + F.wave * 8192);
    LAS float* imp = qs + 256;
    const int gw = F.vcu * NWAVES + F.wave, NGW = F.G * NWAVES, lane = F.lane;
    const float* bias2 = (const float*)(F.ws + WS_BIAS);
    const float* KC = (const float*)(F.ws + WS_KC); const float* VC = (const float*)(F.ws + WS_VC);
    for (int it = gw; it < S * 2; it += NGW) {
        const int p = it >> 1, kvh = it & 1;
#pragma unroll
        for (int g = 0; g < 4; ++g) load_q(PROJ + (size_t)p * NINP + C_CQ + (4 * kvh + g) * 64, qs + g * 64, lane);
        for (int e = lane; e < 1040; e += 64) imp[e] = 0.f;
        LDS_WAIT(); asm volatile("" ::: "memory");
        int nv = p >= 31 ? ((p - 31) >> 4) + 1 : 0; if (nv > NCMP) nv = NCMP;
        float m1[4] = {-1e30f, -1e30f, -1e30f, -1e30f}, l1[4] = {0.f, 0.f, 0.f, 0.f}, o1[4] = {0.f, 0.f, 0.f, 0.f};
        { KeyCmp kf{kvh}; wave_attend<4>(KC, VC, qs, nv, kf, m1, l1, o1, lane); }
        for (int base = 0; base < nv; base += 64) { const int i = base + lane;
            const LAS float* qo = qs; asm volatile("" : "+v"(qo));
            if (i < nv) { float s[4] = {0.f, 0.f, 0.f, 0.f}; dot64<4>(KC + ((size_t)i * 2 + kvh) * 64, qo, s); float a = 0.f;
#pragma unroll
                for (int g = 0; g < 4; ++g) a += exp2f(s[g] - m1[g]) / fmaxf(l1[g], 1e-30f);
                imp[1 + i] = a; } }
        LDS_WAIT(); asm volatile("" ::: "memory");
        const int cur = p >> 6;
        float sc[4];
#pragma unroll
        for (int c = 0; c < 4; ++c) { const int j = lane + 64 * c; const LAS float* q = imp + 4 * j;
            const float is = 0.5f * q[0] + q[1] + q[2] + q[3] + 0.5f * q[4];
            const bool forced = (j == 0) || (j == cur) || (j == cur - 1);
            sc[c] = forced ? 1e4f : ((j * 64 <= p) ? is : -1e30f); }
        float m2[4] = {-1e30f, -1e30f, -1e30f, -1e30f}, l2[4] = {0.f, 0.f, 0.f, 0.f}, o2[4] = {0.f, 0.f, 0.f, 0.f};
#pragma unroll 1
        for (int k = 0; k < 16; ++k) {
            float bv = sc[0]; int bi = lane;
#pragma unroll
            for (int c = 1; c < 4; ++c) if (sc[c] > bv) { bv = sc[c]; bi = lane + 64 * c; }
#pragma unroll
            for (int off = 1; off < 64; off <<= 1) { const float ov = __shfl_xor(bv, off); const int oi = __shfl_xor(bi, off); if (ov > bv || (ov == bv && oi < bi)) { bv = ov; bi = oi; } }
#pragma unroll
            for (int c = 0; c < 4; ++c) if (bi == lane + 64 * c) sc[c] = -3e38f;
            if (bi * 64 <= p) { KeySel kf{p, bi, bias2 + (4 + 4 * kvh) * BIASLEN}; wave_attend<4>(PROJ + C_CKS + kvh * 64, PROJ + C_CVS + kvh * 64, qs, 64, kf, m2, l2, o2, lane); }
        }
#pragma unroll
        for (int g = 0; g < 4; ++g) { const int H = 4 * kvh + g;
            const float g0 = bf2f(PROJ[(size_t)p * NINP + C_CG + H * 3 + 0]), g1 = bf2f(PROJ[(size_t)p * NINP + C_CG + H * 3 + 1]), g2 = bf2f(PROJ[(size_t)p * NINP + C_CG + H * 3 + 2]);
            const float ocmp = o1[g] / fmaxf(l1[g], 1e-30f), oslc = o2[g] / l2[g], owin = bf2f(OWIN[(size_t)p * 512 + H * 64 + lane]);
            MIXED[(size_t)p * DM + 512 + H * 64 + lane] = (bf16)f2bf(g0 * ocmp + g1 * oslc + g2 * owin); }
        LDS_WAIT(); asm volatile("" ::: "memory");
    }
}


namespace ba {
typedef short bf16x8 __attribute__((ext_vector_type(8)));
typedef short s16x4 __attribute__((ext_vector_type(4)));
typedef short v4i16_t __attribute__((ext_vector_type(4)));
typedef float f32x16 __attribute__((ext_vector_type(16)));
typedef float f32x2_t __attribute__((ext_vector_type(2))); typedef __bf16 bf16x2_t __attribute__((ext_vector_type(2)));
typedef LAS const char* lds_cptr;
__device__ __forceinline__ unsigned cvtpk(float lo, float hi) { f32x2_t v = {lo, hi}; bf16x2_t b = __builtin_convertvector(v, bf16x2_t); return __builtin_bit_cast(unsigned, b); }
__device__ __forceinline__ s16x4 vtr(lds_cptr p) { return __builtin_bit_cast(s16x4, __builtin_amdgcn_ds_read_tr16_b64_v4i16((LAS v4i16_t*)p)); }
__device__ __forceinline__ float half_sum(float x) { auto rr = __builtin_amdgcn_permlane32_swap(__float_as_uint(x), __float_as_uint(x), false, false); return __uint_as_float(rr[0]) + __uint_as_float(rr[1]); }
constexpr int KIMG = 0, VIMG = 49152, TBL = 98304, WSCR = 108544, KMAX = 110592;

struct Unit {
    const bf16* Q; const bf16* K; const bf16* V;
    bf16* O; int opitch;
    float* lse; int lse_pitch;
    const float* bias;
    const float* bmax;
    const float* sink;
    int rs, rho, u0;
    int W, Wp;
};

template <int NT, int NH>
__device__ __forceinline__ void run_unit(LAS unsigned char* lds, const Unit& U, int wave, int lane, int tid) {
    static_assert(NT * NH == 8, "one wave-task per wave");
    const int r32 = lane & 31, hi = lane >> 5;
    const int NQ = 32 * NT, NKT = U.Wp + NQ, nch = (NKT + 383) / 384, CH = NKT / nch;
    const int tile = wave % NT, hl = wave / NT, uw = U.u0 + 32 * tile;
    const int TW = U.Wp + 64;
    __syncthreads();
    for (int e = tid; e < NH * TW; e += NTHREADS) { const int h = e / TW, dist = e % TW - 32;
        float v = -1e30f; if (dist >= 0 && dist <= U.W) { v = 0.f; if (U.bias) { const int td = dist * U.rs; v = U.bias[h * BIASLEN + (td < BIASLEN ? td : BIASLEN - 1)]; } }
        ((LAS float*)(lds + TBL))[e] = v; }
    if (tid == 0) *(LAS unsigned*)(lds + KMAX) = 0u;
    __syncthreads();
    { float mx = 0.f;
      for (int idx = tid; idx < NKT * 8; idx += NTHREADS) { const int n = idx >> 3, c = idx & 7, u = U.u0 - U.Wp + n; float s = 0.f;
          if (u >= 0) { const v4u w = *(const v4u*)(U.K + (size_t)(U.rho + U.rs * u) * NINP + c * 8);
              const float a0 = bflo(w.x), a1 = bfhi(w.x), a2 = bflo(w.y), a3 = bfhi(w.y), a4 = bflo(w.z), a5 = bfhi(w.z), a6 = bflo(w.w), a7 = bfhi(w.w);
              s = a0 * a0 + a1 * a1 + a2 * a2 + a3 * a3 + a4 * a4 + a5 * a5 + a6 * a6 + a7 * a7; }
          s += __shfl_xor(s, 1); s += __shfl_xor(s, 2); s += __shfl_xor(s, 4); mx = fmaxf(mx, s); }
      mx = wave_max(mx);
      if (lane == 0) __hip_atomic_fetch_max((LAS unsigned*)(lds + KMAX), __float_as_uint(mx), __ATOMIC_RELAXED, __HIP_MEMORY_SCOPE_WORKGROUP); }
    const int qtok = U.rho + U.rs * (uw + r32);
    bf16x8 qr[4]; float qn = 0.f;
    { const bf16* qp = U.Q + (size_t)qtok * NINP + hl * 64 + hi * 8;
#pragma unroll
      for (int d0 = 0; d0 < 4; ++d0) { qr[d0] = *(const bf16x8*)(qp + d0 * 16);
#pragma unroll
          for (int j = 0; j < 8; ++j) { const float x = bf2f((unsigned short)qr[d0][j]); qn += x * x; } }
      qn = half_sum(qn); }
    __syncthreads();
    const float kmax2 = __uint_as_float(*(LAS unsigned*)(lds + KMAX));
    float M = sqrtf(qn * kmax2) * 1.0002f + 1e-6f;
    if (U.bmax) M += fmaxf(U.bmax[hl], 0.f);
    float sink2 = 0.f; if (U.sink) { sink2 = U.sink[hl] * LOG2E; M = fmaxf(M, sink2); }
    f32x16 negm;
#pragma unroll
    for (int r = 0; r < 16; ++r) negm[r] = -M;
    f32x16 o0 = {}, o1 = {}; float lsum = 0.f;
    const LAS float* tbl = (const LAS float*)(lds + TBL) + hl * TW;
    for (int ck = 0; ck < nch; ++ck) {
        const int kc0 = U.u0 - U.Wp + ck * CH;
        if (ck > 0) __syncthreads();
        for (int idx = tid; idx < CH * 16; idx += NTHREADS) { const int n = idx >> 4, isv = (idx >> 3) & 1, c = idx & 7, u = kc0 + n;
            v4u w = {0u, 0u, 0u, 0u};
            if (u >= 0) w = *(const v4u*)((isv ? U.V : U.K) + (size_t)(U.rho + U.rs * u) * NINP + c * 8);
            if (isv) *(LAS v4u*)(lds + VIMG + (c >> 2) * (CH * 64) + n * 64 + (c & 3) * 16) = w;
            else     *(LAS v4u*)(lds + KIMG + c * (CH * 16) + n * 16) = w; }
        __syncthreads();
        const int nbt = U.Wp / 32 + 1;
        for (int t = 0; t < nbt; ++t) {
            const int kt0 = uw - U.Wp + 32 * t, kl = kt0 - kc0;
            if (kt0 < 0 || kl < 0 || kl >= CH) continue;
            f32x16 s;
            { const lds_cptr kb = (lds_cptr)(lds + KIMG) + hi * (CH * 16) + (kl + r32) * 16;
#pragma unroll
              for (int d0 = 0; d0 < 4; ++d0) { const bf16x8 kf = *(const LAS bf16x8*)(kb + d0 * (2 * CH * 16));
                  s = __builtin_amdgcn_mfma_f32_32x32x16_bf16(kf, qr[d0], d0 == 0 ? negm : s, 0, 0, 0); } }
            { const LAS float* tb = tbl + (U.Wp - 32 * t) + r32 - 4 * hi + 32 - 27;
#pragma unroll
              for (int r = 0; r < 16; ++r) s[r] = __builtin_amdgcn_exp2f(s[r] + tb[27 - ((r & 3) + 8 * (r >> 2))]); }
            float ps = 0.f;
#pragma unroll
            for (int r = 0; r < 16; ++r) ps += s[r];
            lsum += ps;
            bf16x8 pa0, pa1;
            { v4u w0 = {cvtpk(s[0], s[1]), cvtpk(s[2], s[3]), cvtpk(s[4], s[5]), cvtpk(s[6], s[7])}, w1 = {cvtpk(s[8], s[9]), cvtpk(s[10], s[11]), cvtpk(s[12], s[13]), cvtpk(s[14], s[15])};
              pa0 = __builtin_bit_cast(bf16x8, w0); pa1 = __builtin_bit_cast(bf16x8, w1); }
            { const lds_cptr vp = (lds_cptr)(lds + VIMG) + ((lane >> 4) & 1) * 32 + (lane & 3) * 8 + (kl + 4 * hi + ((lane & 15) >> 2)) * 64;
#pragma unroll
              for (int dh = 0; dh < 2; ++dh)
#pragma unroll
                  for (int g = 0; g < 2; ++g) { const s16x4 lo = vtr(vp + dh * (CH * 64) + g * 1024), hv = vtr(vp + dh * (CH * 64) + g * 1024 + 512);
                      const bf16x8 vf = {lo[0], lo[1], lo[2], lo[3], hv[0], hv[1], hv[2], hv[3]};
                      if (dh == 0) o0 = __builtin_amdgcn_mfma_f32_32x32x16_bf16(g == 0 ? pa0 : pa1, vf, o0, 0, 0, 0);
                      else         o1 = __builtin_amdgcn_mfma_f32_32x32x16_bf16(g == 0 ? pa0 : pa1, vf, o1, 0, 0, 0); } }
        }
    }
    float l = half_sum(lsum);
    if (U.sink) l += exp2f(sink2 - M);
    LAS float* wsf = (LAS float*)(lds + WSCR) + wave * 64;
    if (hi == 0) wsf[r32] = 1.0f / l;
    if (U.lse && hi == 0) U.lse[(size_t)qtok * U.lse_pitch + hl] = M + log2f(l);
    LDS_WAIT(); asm volatile("" ::: "memory");
#pragma unroll
    for (int r = 0; r < 16; ++r) { const int qo = (r & 3) + 8 * (r >> 2) + 4 * hi; const float rl = wsf[qo];
        bf16* op = U.O + (size_t)(U.rho + U.rs * (uw + qo)) * U.opitch + hl * 64 + r32;
        op[0] = (bf16)f2bf(o0[r] * rl); op[32] = (bf16)f2bf(o1[r] * rl); }
}
}

constexpr int P2_NA = 3 * 4 * 64, P2_NB = 2 * 128, P2_NC = 2 * 256, P2_NUNITS = P2_NA + P2_NB + P2_NC;
__device__ __forceinline__ void p2_banded(Frame& F, int layer, const bf16* PROJ, bf16* MIXED, bf16* OWIN) {
    const float* bias2 = (const float*)(F.ws + WS_BIAS); const float* bmax = (const float*)(F.ws + WS_BMAX);
    bf16* OA3 = (bf16*)(F.ws + WS_OA3); float* LSE = (float*)(F.ws + WS_LSE);
    for (int it = F.vcu; it < P2_NUNITS; it += F.G) {
        ba::Unit U{};
        if (it < P2_NC) { const int kvh = it & 1, blk = it >> 1;
            U.Q = PROJ + C_CQ + kvh * 256; U.K = PROJ + C_CKW + kvh * 64; U.V = PROJ + C_CVW + kvh * 64; U.O = OWIN + kvh * 256; U.opitch = 512;
            U.bias = bias2 + (4 + 4 * kvh) * BIASLEN; U.bmax = bmax + 4 + 4 * kvh; U.rs = 1; U.rho = 0; U.u0 = blk * 64; U.W = 511; U.Wp = 512;
            ba::run_unit<2, 4>(F.lds, U, F.wave, F.lane, F.tid);
        } else if (it < P2_NC + P2_NA) { const int a = it - P2_NC, h = a & 3, c = (a >> 2) % 3, blk = (a >> 2) / 3;
            const int rs = c == 0 ? 1 : (c == 1 ? 4 : 16), per = S / rs / 256;
            const int rho = blk / per, ub = blk % per;
            U.Q = PROJ + C_AQ + h * 64; U.K = PROJ + C_AK + h * 64; U.V = PROJ + C_AV + h * 64; U.O = OA3 + (size_t)c * S * 256 + h * 64; U.opitch = 256;
            U.lse = LSE + (size_t)c * S * 4 + h; U.lse_pitch = 4;
            U.bias = bias2 + h * BIASLEN; U.bmax = bmax + h; U.rs = rs; U.rho = rho; U.u0 = ub * 256; U.W = 128; U.Wp = 128;
            ba::run_unit<8, 1>(F.lds, U, F.wave, F.lane, F.tid);
        } else { const int b = it - P2_NC - P2_NA, kvh = b & 1, blk = b >> 1;
            U.Q = PROJ + C_BQ + kvh * 128; U.K = PROJ + C_BK + kvh * 64; U.V = PROJ + C_BV + kvh * 64; U.O = MIXED + 256 + kvh * 128; U.opitch = DM;
            U.sink = F.in[I_SINK] + layer * 4 + 2 * kvh; U.rs = 1; U.rho = 0; U.u0 = blk * 128; U.W = 127; U.Wp = 128;
            ba::run_unit<4, 2>(F.lds, U, F.wave, F.lane, F.tid);
        }
    }
    __syncthreads();
}
__device__ __forceinline__ void merge_dilated(Frame& F, bf16* MIXED) {
    const bf16* OA3 = (const bf16*)(F.ws + WS_OA3); const float* LSE = (const float*)(F.ws + WS_LSE);
    const int gw = F.vcu * NWAVES + F.wave, NGW = F.G * NWAVES, lane = F.lane, h = lane >> 4;
    for (int p = gw; p < S; p += NGW) {
        const float l0 = LSE[(size_t)p * 4 + h], l1 = LSE[(size_t)(S + p) * 4 + h], l2 = LSE[(size_t)(2 * S + p) * 4 + h];
        const float mx = fmaxf(l0, fmaxf(l1, l2)); const float e0 = exp2f(l0 - mx), e1 = exp2f(l1 - mx), e2 = exp2f(l2 - mx), inv = 1.0f / (e0 + e1 + e2);
        const v2u a = *(const v2u*)(OA3 + (size_t)p * 256 + lane * 4), b = *(const v2u*)(OA3 + (size_t)(S + p) * 256 + lane * 4), c = *(const v2u*)(OA3 + (size_t)(2 * S + p) * 256 + lane * 4);
        const float w0 = e0 * inv, w1 = e1 * inv, w2 = e2 * inv;
        const float r0 = w0 * bflo(a.x) + w1 * bflo(b.x) + w2 * bflo(c.x), r1 = w0 * bfhi(a.x) + w1 * bfhi(b.x) + w2 * bfhi(c.x);
        const float r2 = w0 * bflo(a.y) + w1 * bflo(b.y) + w2 * bflo(c.y), r3 = w0 * bfhi(a.y) + w1 * bfhi(b.y) + w2 * bfhi(c.y);
        *(v2u*)(MIXED + (size_t)p * DM + lane * 4) = (v2u){pk2(r0, r1), pk2(r2, r3)};
    }
}


namespace ca {
using ba::bf16x8; using ba::s16x4; using ba::f32x16; using ba::lds_cptr; using ba::cvtpk; using ba::vtr; using ba::half_sum;
constexpr int CH = 256, KIMG = 0, VIMG = 32768, IMPSEL = 65536, IMPQ = 264  , IMPW = 8 * IMPQ * 4  , WSCR = IMPSEL + 8 * IMPW;
static_assert(WSCR + 8 * 512 <= RING_BYTES, "P3a LDS map");
__device__ __forceinline__ float quad_sum(float x) {
    x += __int_as_float(__builtin_amdgcn_update_dpp(0, __float_as_int(x), 0xB1, 0xF, 0xF, true));
    x += __int_as_float(__builtin_amdgcn_update_dpp(0, __float_as_int(x), 0x4E, 0xF, 0xF, true));
    return x;
}
__device__ __forceinline__ void stage_chunk(LAS unsigned char* lds, const bf16* KCb, const bf16* VCb, int kvh, int kc0, bool with_v, int tid) {
    for (int idx = tid; idx < CH * 16; idx += NTHREADS) { const int n = idx >> 4, isv = (idx >> 3) & 1, c = idx & 7, i = kc0 + n;
        if (isv && !with_v) continue;
        v4u w = {0u, 0u, 0u, 0u};
        if (i < NCMP) w = *(const v4u*)((isv ? VCb : KCb) + ((size_t)i * 2 + kvh) * 64 + c * 8);
        if (isv) *(LAS v4u*)(lds + VIMG + (c >> 2) * (CH * 64) + n * 64 + (c & 3) * 16) = w;
        else     *(LAS v4u*)(lds + KIMG + c * (CH * 16) + n * 16) = w; }
}
__device__ __forceinline__ void run_unit(LAS unsigned char* lds, const bf16* PROJ, const bf16* KCb, const bf16* VCb, float kcmax2, bf16* OCMP, unsigned* SELB, int kvh, int cur, int wave, int lane, int tid) {
    const int r32 = lane & 31, hi = lane >> 5, p0 = cur * 64;
    const int ql = r32 >> 2, hh = r32 & 3, qpos = p0 + wave * 8 + ql, H = 4 * kvh + hh;
    int nvq = qpos >= 31 ? ((qpos - 31) >> 4) + 1 : 0; if (nvq > NCMP) nvq = NCMP;
    int nvw = (p0 + wave * 8 + 7) >= 31 ? ((p0 + wave * 8 + 7 - 31) >> 4) + 1 : 0; if (nvw > NCMP) nvw = NCMP;
    int nvu = (p0 + 63 - 31) >= 0 ? ((p0 + 63 - 31) >> 4) + 1 : 0; if (nvu > NCMP) nvu = NCMP;
    const int nch = (nvu + CH - 1) / CH;
    bf16x8 qr[4]; float qn = 0.f;
    { const bf16* qp = PROJ + (size_t)qpos * NINP + C_CQ + H * 64 + hi * 8;
#pragma unroll
      for (int d0 = 0; d0 < 4; ++d0) { qr[d0] = *(const bf16x8*)(qp + d0 * 16);
#pragma unroll
          for (int j = 0; j < 8; ++j) { const float x = bf2f((unsigned short)qr[d0][j]); qn += x * x; } }
      qn = half_sum(qn); }
    const float M = sqrtf(qn * kcmax2) * 1.0002f + 1e-6f;
    f32x16 negm;
#pragma unroll
    for (int r = 0; r < 16; ++r) negm[r] = -M;
    LAS float* imps = (LAS float*)(lds + IMPSEL + wave * IMPW);
    __syncthreads();
    for (int e = lane; e < 8 * IMPQ; e += 64) imps[e] = 0.f;
    float lsum = 0.f;
    for (int ck = 0; ck < nch; ++ck) {
        if (ck > 0) __syncthreads();
        stage_chunk(lds, KCb, VCb, kvh, ck * CH, false, tid);
        __syncthreads();
        for (int kl = 0; kl < CH; kl += 32) { const int kt0 = ck * CH + kl; if (kt0 >= nvw) break;
            f32x16 s;
            { const lds_cptr kb = (lds_cptr)(lds + KIMG) + hi * (CH * 16) + (kl + r32) * 16;
#pragma unroll
              for (int d0 = 0; d0 < 4; ++d0) { const bf16x8 kf = *(const LAS bf16x8*)(kb + d0 * (2 * CH * 16)); s = __builtin_amdgcn_mfma_f32_32x32x16_bf16(kf, qr[d0], d0 == 0 ? negm : s, 0, 0, 0); } }
            const int lim = nvq - kt0 - 4 * hi;
#pragma unroll
            for (int r = 0; r < 16; ++r) lsum += ((r & 3) + 8 * (r >> 2)) < lim ? __builtin_amdgcn_exp2f(s[r]) : 0.f; }
    }
    const float rinv = 1.0f / fmaxf(half_sum(lsum), 1e-30f);
    f32x16 o0 = {}, o1 = {};
    for (int ck = 0; ck < nch; ++ck) {
        __syncthreads();
        stage_chunk(lds, KCb, VCb, kvh, ck * CH, true, tid);
        __syncthreads();
        for (int kl = 0; kl < CH; kl += 32) { const int kt0 = ck * CH + kl; if (kt0 >= nvw) break;
            f32x16 s;
            { const lds_cptr kb = (lds_cptr)(lds + KIMG) + hi * (CH * 16) + (kl + r32) * 16;
#pragma unroll
              for (int d0 = 0; d0 < 4; ++d0) { const bf16x8 kf = *(const LAS bf16x8*)(kb + d0 * (2 * CH * 16)); s = __builtin_amdgcn_mfma_f32_32x32x16_bf16(kf, qr[d0], d0 == 0 ? negm : s, 0, 0, 0); } }
            const int lim = nvq - kt0 - 4 * hi;
#pragma unroll
            for (int r = 0; r < 16; ++r) s[r] = ((r & 3) + 8 * (r >> 2)) < lim ? __builtin_amdgcn_exp2f(s[r]) * rinv : 0.f;
            { float mains[4], spills[4];
#pragma unroll
              for (int a = 0; a < 4; ++a) { const float x0 = quad_sum(s[4 * a]), x1 = quad_sum(s[4 * a + 1]), x2 = quad_sum(s[4 * a + 2]), x3 = quad_sum(s[4 * a + 3]);
                  spills[a] = 0.5f * x3; mains[a] = ((x0 + x1) + x2) + spills[a]; }
              const float mn = hh == 0 ? mains[0] : (hh == 1 ? mains[1] : (hh == 2 ? mains[2] : mains[3]));
              const float sp = hh == 0 ? spills[0] : (hh == 1 ? spills[1] : (hh == 2 ? spills[2] : spills[3]));
              const int j = (kt0 >> 2) + 2 * hh + hi;
              __hip_atomic_fetch_add(imps + ql * IMPQ + j, mn, __ATOMIC_RELAXED, __HIP_MEMORY_SCOPE_WORKGROUP);
              __hip_atomic_fetch_add(imps + ql * IMPQ + j + 1, sp, __ATOMIC_RELAXED, __HIP_MEMORY_SCOPE_WORKGROUP); }
            bf16x8 pa0, pa1;
            { v4u w0 = {cvtpk(s[0], s[1]), cvtpk(s[2], s[3]), cvtpk(s[4], s[5]), cvtpk(s[6], s[7])}, w1 = {cvtpk(s[8], s[9]), cvtpk(s[10], s[11]), cvtpk(s[12], s[13]), cvtpk(s[14], s[15])};
              pa0 = __builtin_bit_cast(bf16x8, w0); pa1 = __builtin_bit_cast(bf16x8, w1); }
            { const lds_cptr vp = (lds_cptr)(lds + VIMG) + ((lane >> 4) & 1) * 32 + (lane & 3) * 8 + (kl + 4 * hi + ((lane & 15) >> 2)) * 64;
#pragma unroll
              for (int dh = 0; dh < 2; ++dh)
#pragma unroll
                  for (int g = 0; g < 2; ++g) { const s16x4 lo = vtr(vp + dh * (CH * 64) + g * 1024), hv = vtr(vp + dh * (CH * 64) + g * 1024 + 512);
                      const bf16x8 vf = {lo[0], lo[1], lo[2], lo[3], hv[0], hv[1], hv[2], hv[3]};
                      if (dh == 0) o0 = __builtin_amdgcn_mfma_f32_32x32x16_bf16(g == 0 ? pa0 : pa1, vf, o0, 0, 0, 0);
                      else         o1 = __builtin_amdgcn_mfma_f32_32x32x16_bf16(g == 0 ? pa0 : pa1, vf, o1, 0, 0, 0); } }
        }
    }
#pragma unroll
    for (int r = 0; r < 16; ++r) { const int c = (r & 3) + 8 * (r >> 2) + 4 * hi;
        bf16* op = OCMP + (size_t)(p0 + wave * 8 + (c >> 2)) * 512 + (4 * kvh + (c & 3)) * 64 + r32;
        op[0] = (bf16)f2bf(o0[r]); op[32] = (bf16)f2bf(o1[r]); }
    LDS_WAIT(); asm volatile("" ::: "memory");
#pragma unroll 1
    for (int q = 0; q < 8; ++q) { const int qp = p0 + wave * 8 + q; const LAS float* im = imps + q * IMPQ;
        float sc[4];
#pragma unroll
        for (int c = 0; c < 4; ++c) { const int j = lane + 64 * c; const bool forced = (j == 0) || (j == cur) || (j == cur - 1); sc[c] = forced ? 1e4f : ((j * 64 <= qp) ? im[j] : -1e30f); }
        unsigned bits = 0u;
#pragma unroll 1
        for (int k = 0; k < 16; ++k) {
            float bv = sc[0]; int bi = lane;
#pragma unroll
            for (int c = 1; c < 4; ++c) if (sc[c] > bv) { bv = sc[c]; bi = lane + 64 * c; }
#pragma unroll
            for (int off = 1; off < 64; off <<= 1) { const float ov = __shfl_xor(bv, off); const int oi = __shfl_xor(bi, off); if (ov > bv || (ov == bv && oi < bi)) { bv = ov; bi = oi; } }
#pragma unroll
            for (int c = 0; c < 4; ++c) if (bi == lane + 64 * c) sc[c] = -3e38f;
            if (bi * 64 <= qp && lane == (bi >> 5)) bits |= 1u << (bi & 31);
        }
        if (lane < 8) SELB[((size_t)qp * 2 + kvh) * 8 + lane] = bits;
    }
}
}

__device__ __forceinline__ void p3a_cmp_select(Frame& F, int layer, const bf16* PROJ) {
    const bf16* KCb = (const bf16*)(F.ws + WS_KCB); const bf16* VCb = (const bf16*)(F.ws + WS_VCB);
    bf16* OCMP = (bf16*)(F.ws + WS_OCMP); unsigned* SELB = (unsigned*)(F.ws + WS_SELB);
    const unsigned* mx = (const unsigned*)(F.ws + WS_CTL) + CW_MAX + layer * 16;
    for (int k = F.vcu; k < 256; k += F.G) for (int rep = 0; rep < 2; ++rep) { const int x = rep == 0 ? 511 - k : k;
        const int kvh = x & 1, cur = x >> 1;
        const float kcmax2 = __uint_as_float(__hip_atomic_load(mx + kvh, __ATOMIC_RELAXED, __HIP_MEMORY_SCOPE_AGENT));
        ca::run_unit(F.lds, PROJ, KCb, VCb, kcmax2, OCMP, SELB, kvh, cur, F.wave, F.lane, F.tid); }
    __syncthreads();
}

__device__ __forceinline__ void p3b_naive(Frame& F, int layer, const bf16* PROJ, const bf16* OWIN, bf16* MIXED) {
    LAS float* qs = (LAS float*)(F.lds + F.wave * 2048);
    const int gw = F.vcu * NWAVES + F.wave, NGW = F.G * NWAVES, lane = F.lane;
    const float* bias2 = (const float*)(F.ws + WS_BIAS);
    const bf16* OCMP = (const bf16*)(F.ws + WS_OCMP); const unsigned* SELB = (const unsigned*)(F.ws + WS_SELB);
    for (int it = gw; it < S * 2; it += NGW) {
        const int p = it >> 1, kvh = it & 1;
#pragma unroll
        for (int g = 0; g < 4; ++g) load_q(PROJ + (size_t)p * NINP + C_CQ + (4 * kvh + g) * 64, qs + g * 64, lane);
        LDS_WAIT(); asm volatile("" ::: "memory");
        float m2[4] = {-1e30f, -1e30f, -1e30f, -1e30f}, l2[4] = {0.f, 0.f, 0.f, 0.f}, o2[4] = {0.f, 0.f, 0.f, 0.f};
#pragma unroll 1
        for (int w = 0; w < 8; ++w) { unsigned bits = SELB[((size_t)p * 2 + kvh) * 8 + w];
            while (bits) { const int b = __builtin_ctz(bits); bits &= bits - 1; const int bi = w * 32 + b;
                KeySel kf{p, bi, bias2 + (4 + 4 * kvh) * BIASLEN}; wave_attend<4>(PROJ + C_CKS + kvh * 64, PROJ + C_CVS + kvh * 64, qs, 64, kf, m2, l2, o2, lane); } }
#pragma unroll
        for (int g = 0; g < 4; ++g) { const int H = 4 * kvh + g;
            const float g0 = bf2f(PROJ[(size_t)p * NINP + C_CG + H * 3 + 0]), g1 = bf2f(PROJ[(size_t)p * NINP + C_CG + H * 3 + 1]), g2 = bf2f(PROJ[(size_t)p * NINP + C_CG + H * 3 + 2]);
            const float ocmp = bf2f(OCMP[(size_t)p * 512 + H * 64 + lane]), oslc = o2[g] / l2[g], owin = bf2f(OWIN[(size_t)p * 512 + H * 64 + lane]);
            MIXED[(size_t)p * DM + 512 + H * 64 + lane] = (bf16)f2bf(g0 * ocmp + g1 * oslc + g2 * owin); }
        LDS_WAIT(); asm volatile("" ::: "memory");
    }
}


namespace sa {
using ba::bf16x8; using ba::s16x4; using ba::lds_cptr; using ba::cvtpk; using ba::vtr;
typedef float f32x4v __attribute__((ext_vector_type(4)));
constexpr int SLOTB = 16384, BT = 32768, BTH = 1540  , BM = BT + 4 * BTH * 4, LDS_END = BM + 2048;
static_assert(LDS_END <= RING_BYTES, "P3b LDS map");
__device__ __forceinline__ void run_unit(LAS unsigned char* lds, const bf16* PROJ, const float* bias2, const float* bmax, float ksmax2, const bf16* OCMP, const bf16* OWIN,
                                         const unsigned* SELB, bf16* MIXED, int kvh, int cur, int wave, int lane, int tid) {
    const int p0 = cur * 64, col = lane & 15, g = lane >> 4, qq = col >> 2, hh = col & 3, H = 4 * kvh + hh;
    __syncthreads();
    for (int e = tid; e < 4 * BTH; e += NTHREADS) { const int h = e / BTH, i = e % BTH; int d = i - 3; d = d < 0 ? 0 : (d > 1535 ? 1535 : d);
        ((LAS float*)(lds + BT))[e] = bias2[(4 + 4 * kvh + h) * BIASLEN + d]; }
    ((LAS unsigned*)(lds + BM))[tid] = SELB[((size_t)(p0 + (tid >> 3)) * 2 + kvh) * 8 + (tid & 7)];
    const bf16* Kg = PROJ + C_CKS + kvh * 64; const bf16* Vg = PROJ + C_CVS + kvh * 64;
    v4u pre[2];
#define SA_LOAD(j) do { _Pragma("unroll") for (int i_ = 0; i_ < 2; ++i_) { const int idx_ = tid + i_ * NTHREADS, n_ = idx_ >> 4, isv_ = (idx_ >> 3) & 1, c_ = idx_ & 7; \
        pre[i_] = *(const v4u*)((isv_ ? Vg : Kg) + (size_t)((j) * 64 + n_) * NINP + c_ * 8); } } while (0)
#define SA_WRITE(slot) do { _Pragma("unroll") for (int i_ = 0; i_ < 2; ++i_) { const int idx_ = tid + i_ * NTHREADS, n_ = idx_ >> 4, isv_ = (idx_ >> 3) & 1, c_ = idx_ & 7; \
        if (isv_) *(LAS v4u*)(lds + (slot) * SLOTB + 8192 + (c_ >> 1) * 2048 + n_ * 32 + (c_ & 1) * 16) = pre[i_]; \
        else      *(LAS v4u*)(lds + (slot) * SLOTB + c_ * 1024 + n_ * 16) = pre[i_]; } } while (0)
    SA_LOAD(0); SA_WRITE(0);
    __syncthreads();
    bf16x8 qf[2][2]; f32x4v negm[2]; unsigned cgm[2]; int qpos[2];
#pragma unroll
    for (int cg = 0; cg < 2; ++cg) {
        const int ql = wave * 8 + cg * 4 + qq; qpos[cg] = p0 + ql;
        const bf16* qp = PROJ + (size_t)qpos[cg] * NINP + C_CQ + H * 64 + g * 8; float qn = 0.f;
#pragma unroll
        for (int ks = 0; ks < 2; ++ks) { qf[cg][ks] = *(const bf16x8*)(qp + ks * 32);
#pragma unroll
            for (int j = 0; j < 8; ++j) { const float x = bf2f((unsigned short)qf[cg][ks][j]); qn += x * x; } }
        qn += __shfl_xor(qn, 16); qn += __shfl_xor(qn, 32);
        const float M = sqrtf(qn * ksmax2) * 1.0002f + fmaxf(bmax[4 + H], 0.f) + 1e-6f;
        negm[cg] = (f32x4v){-M, -M, -M, -M};
        unsigned m = 0u;
        if (lane < 8) { const LAS unsigned* b = (const LAS unsigned*)(lds + BM) + (wave * 8 + cg * 4) * 8 + lane; m = b[0] | b[8] | b[16] | b[24]; }
        cgm[cg] = m;
    }
    f32x4v oacc[2][4]; float lsum[2] = {0.f, 0.f};
#pragma unroll
    for (int cg = 0; cg < 2; ++cg)
#pragma unroll
        for (int dt = 0; dt < 4; ++dt) oacc[cg][dt] = (f32x4v){0.f, 0.f, 0.f, 0.f};
    const LAS float* bt = (const LAS float*)(lds + BT) + hh * BTH;
    for (int j = 0; j <= cur; ++j) {
        if (j < cur) SA_LOAD(j + 1);
        const LAS unsigned char* slot = lds + (j & 1) * SLOTB;
#pragma unroll
        for (int cg = 0; cg < 2; ++cg) {
            const unsigned word = __builtin_amdgcn_readlane(cgm[cg], j >> 5);
            if (!((word >> (j & 31)) & 1u)) continue;
            const bool mine = (((const LAS unsigned*)(lds + BM))[(wave * 8 + cg * 4 + qq) * 8 + (j >> 5)] >> (j & 31)) & 1u;
            f32x4v s[4];
#pragma unroll
            for (int t = 0; t < 4; ++t) { s[t] = negm[cg];
#pragma unroll
                for (int ks = 0; ks < 2; ++ks) { const bf16x8 kf = *(const LAS bf16x8*)(slot + (4 * ks + g) * 1024 + (16 * t + col) * 16);
                    s[t] = __builtin_amdgcn_mfma_f32_16x16x32_bf16(kf, qf[cg][ks], s[t], 0, 0, 0); } }
            float ps = 0.f;
#pragma unroll
            for (int t = 0; t < 4; ++t) { const int d0 = qpos[cg] - (64 * j + 16 * t + 4 * g); int db = d0 + 3; db = db < 3 ? 3 : (db > 1538 ? 1538 : db);
                const LAS float* tb = bt + db - 3;
#pragma unroll
                for (int e = 0; e < 4; ++e) { const float pv = (mine && d0 - e >= 0) ? __builtin_amdgcn_exp2f(s[t][e] + tb[3 - e]) : 0.f; s[t][e] = pv; ps += pv; } }
            lsum[cg] += ps;
#pragma unroll
            for (int ks2 = 0; ks2 < 2; ++ks2) {
                const v4u pw = {cvtpk(s[2 * ks2][0], s[2 * ks2][1]), cvtpk(s[2 * ks2][2], s[2 * ks2][3]), cvtpk(s[2 * ks2 + 1][0], s[2 * ks2 + 1][1]), cvtpk(s[2 * ks2 + 1][2], s[2 * ks2 + 1][3])};
                const bf16x8 pf = __builtin_bit_cast(bf16x8, pw);
                const lds_cptr vb = (lds_cptr)slot + 8192 + (32 * ks2 + 4 * g + (col >> 2)) * 32 + (col & 3) * 8;
#pragma unroll
                for (int dt = 0; dt < 4; ++dt) { const s16x4 lo = vtr(vb + dt * 2048), hv = vtr(vb + dt * 2048 + 512);
                    const bf16x8 vf = {lo[0], lo[1], lo[2], lo[3], hv[0], hv[1], hv[2], hv[3]};
                    oacc[cg][dt] = __builtin_amdgcn_mfma_f32_16x16x32_bf16(vf, pf, oacc[cg][dt], 0, 0, 0); } }
        }
        if (j < cur) SA_WRITE((j + 1) & 1);
        __syncthreads();
    }
#undef SA_LOAD
#undef SA_WRITE
#pragma unroll
    for (int cg = 0; cg < 2; ++cg) {
        float l = lsum[cg]; l += __shfl_xor(l, 16); l += __shfl_xor(l, 32);
        const float rl = 1.0f / l; const size_t q = (size_t)qpos[cg];
        const float g0 = bf2f(PROJ[q * NINP + C_CG + H * 3 + 0]), g1 = bf2f(PROJ[q * NINP + C_CG + H * 3 + 1]) * rl, g2 = bf2f(PROJ[q * NINP + C_CG + H * 3 + 2]);
#pragma unroll
        for (int dt = 0; dt < 4; ++dt) { const int d = 16 * dt + 4 * g;
            const v2u a = *(const v2u*)(OCMP + q * 512 + H * 64 + d), b = *(const v2u*)(OWIN + q * 512 + H * 64 + d);
            const float r0 = g0 * bflo(a.x) + g1 * oacc[cg][dt][0] + g2 * bflo(b.x), r1 = g0 * bfhi(a.x) + g1 * oacc[cg][dt][1] + g2 * bfhi(b.x);
            const float r2 = g0 * bflo(a.y) + g1 * oacc[cg][dt][2] + g2 * bflo(b.y), r3 = g0 * bfhi(a.y) + g1 * oacc[cg][dt][3] + g2 * bfhi(b.y);
            *(v2u*)(MIXED + q * DM + 512 + H * 64 + d) = (v2u){pk2(r0, r1), pk2(r2, r3)}; }
    }
}
}

__device__ __forceinline__ void p3b_select(Frame& F, int layer, const bf16* PROJ, const bf16* OWIN, bf16* MIXED) {
    const float* bias2 = (const float*)(F.ws + WS_BIAS); const float* bmax = (const float*)(F.ws + WS_BMAX);
    const bf16* OCMP = (const bf16*)(F.ws + WS_OCMP); const unsigned* SELB = (const unsigned*)(F.ws + WS_SELB);
    const unsigned* mx = (const unsigned*)(F.ws + WS_CTL) + CW_MAX + layer * 16;
    for (int k = F.vcu; k < 256; k += F.G) for (int rep = 0; rep < 2; ++rep) { const int x = rep == 0 ? 511 - k : k;
        const int kvh = x & 1, cur = x >> 1;
        const float ksmax2 = __uint_as_float(__hip_atomic_load(mx + 2 + kvh, __ATOMIC_RELAXED, __HIP_MEMORY_SCOPE_AGENT));
        sa::run_unit(F.lds, PROJ, bias2, bmax, ksmax2, OCMP, OWIN, SELB, MIXED, kvh, cur, F.wave, F.lane, F.tid); }
    __syncthreads();
}
__device__ __forceinline__ void p2_kslc_norm(Frame& F, int layer, const bf16* PROJ) {
    const int gt = F.vcu * NTHREADS + F.tid, NGT = F.G * NTHREADS; float m0 = 0.f, m1 = 0.f;
    for (int idx = gt; idx < S * 16; idx += NGT) { const int n = idx >> 3, c = idx & 7, p = n >> 1, kvh = n & 1;
        const v4u w = *(const v4u*)(PROJ + (size_t)p * NINP + C_CKS + kvh * 64 + c * 8);
        const float a0 = bflo(w.x), a1 = bfhi(w.x), a2 = bflo(w.y), a3 = bfhi(w.y), a4 = bflo(w.z), a5 = bfhi(w.z), a6 = bflo(w.w), a7 = bfhi(w.w);
        float s = a0 * a0 + a1 * a1 + a2 * a2 + a3 * a3 + a4 * a4 + a5 * a5 + a6 * a6 + a7 * a7;
        s += __shfl_xor(s, 1); s += __shfl_xor(s, 2); s += __shfl_xor(s, 4);
        if (kvh) m1 = fmaxf(m1, s); else m0 = fmaxf(m0, s); }
    m0 = wave_max(m0); m1 = wave_max(m1);
    if (F.lane == 0) { unsigned* mx = (unsigned*)(F.ws + WS_CTL) + CW_MAX + layer * 16;
        __hip_atomic_fetch_max(mx + 2, __float_as_uint(m0), __ATOMIC_RELAXED, __HIP_MEMORY_SCOPE_AGENT); __hip_atomic_fetch_max(mx + 3, __float_as_uint(m1), __ATOMIC_RELAXED, __HIP_MEMORY_SCOPE_AGENT); }
}

constexpr int NSUB = 9;
constexpr int N_PHASES = 2 + NSUB * DEPTH;
__device__ __forceinline__ void run_phase(Frame& F, int ph) {
    unsigned char* ws = F.ws;
    const float* mod = (const float*)(ws + WS_MOD);
    if (ph == 0) { p0_prologue(F); return; }
    if (ph == 1) { row_pass<0>(F, F.in[I_X], nullptr, (bf16*)(ws + WS_RA), nullptr, nullptr, mod + 1024, mod + 0); return; }
    const int l = (ph - 2) / NSUB, si = (ph - 2) % NSUB;
    const int sub = si <= 2 ? si : (si == 3 ? 8 : si - 1);
    const float* modl = mod + l * 6144;
    bf16* bufX = (bf16*)(ws + ((l & 1) ? WS_RB : WS_RA));
    bf16* bufY = (bf16*)(ws + ((l & 1) ? WS_RA : WS_RB));
    bf16* PROJ = (bf16*)(ws + WS_BIG); bf16* HID = (bf16*)(ws + WS_BIG); bf16* OWIN = (bf16*)(ws + WS_OWIN);
    const float* xres = (l == 0) ? F.in[I_X] : F.out;
    switch (sub) {
    case 0: {
        pg8::Gemm g{bufX, (const bf16*)(ws + WS_WIN) + (size_t)l * NINP * DM, S, NINP, DM}; pg8::StaticOrder So; So.init(S, NINP, F.G, (int)blockIdx.x);
        pg8::EpiInProj E{PROJ, NINP, (const float*)(ws + WS_ROPE), QSCALE};
        pg8::gemm_phase<pg8::EpiInProj, pg8::StaticOrder, PG8_ALIGN, PG8_SP2>(F.lds, g, So, E, F.wave);
    } break;
    case 1: p2_kslc_norm(F, l, PROJ); p2_compress(F, l, PROJ); p2_banded(F, l, PROJ, bufY, OWIN); break;
    case 2: merge_dilated(F, bufY); p3a_cmp_select(F, l, PROJ); break;
    case 8: p3b_select(F, l, PROJ, OWIN, bufY); break;
    case 3: {
        pg8::Gemm g{bufY, (const bf16*)(ws + WS_WOUT) + (size_t)l * DM * DM, S, DM, DM}; pg8::StaticOrder So; So.init(S, DM, F.G, (int)blockIdx.x);
        pg8::EpiResid E{xres, F.out, DM, modl + 2048, DN_ALPHA};
        pg8::gemm_phase<pg8::EpiResid, pg8::StaticOrder, PG8_ALIGN, PG8_SP2>(F.lds, g, So, E, F.wave);
    } break;
    case 4: row_pass<1>(F, F.out, F.out, bufX, F.in[I_LNG] + (l * 2 + 0) * DM, F.in[I_LNB] + (l * 2 + 0) * DM, modl + 4096, modl + 3072); break;
    case 5: {
        pg8::Gemm g{bufX, (const bf16*)(ws + WS_W1) + (size_t)l * DFF * DM, S, DFF, DM}; pg8::StaticOrder So; So.init(S, DFF, F.G, (int)blockIdx.x);
        pg8::EpiRelu2 E{HID, DFF};
        pg8::gemm_phase<pg8::EpiRelu2, pg8::StaticOrder, PG8_ALIGN, PG8_SP2>(F.lds, g, So, E, F.wave);
    } break;
    case 6: {
        pg8::Gemm g{HID, (const bf16*)(ws + WS_W2) + (size_t)l * DM * DFF, S, DM, DFF}; pg8::StaticOrder So; So.init(S, DM, F.G, (int)blockIdx.x);
        pg8::EpiResid E{F.out, F.out, DM, modl + 5120, DN_ALPHA};
        pg8::gemm_phase<pg8::EpiResid, pg8::StaticOrder, PG8_ALIGN, PG8_SP2>(F.lds, g, So, E, F.wave);
    } break;
    default: {
        if (l + 1 < DEPTH) row_pass<1>(F, F.out, F.out, bufY, F.in[I_LNG] + (l * 2 + 1) * DM, F.in[I_LNB] + (l * 2 + 1) * DM, modl + 6144 + 1024, modl + 6144 + 0);
        else row_pass<2>(F, F.out, F.out, nullptr, F.in[I_LNG] + (l * 2 + 1) * DM, F.in[I_LNB] + (l * 2 + 1) * DM, nullptr, nullptr);
    } break;
    }
}

__global__ void __launch_bounds__(NTHREADS, 2) fwd_kernel(Args args) {
    extern __shared__ __attribute__((aligned(16))) unsigned char lds[];
    Frame F;
    F.lds = (LAS unsigned char*)lds;
    F.tid = threadIdx.x; F.lane = F.tid & 63; F.wave = __builtin_amdgcn_readfirstlane(F.tid >> 6);
    F.G = gridDim.x; { const int bx = blockIdx.x; F.vcu = (F.G % 8 == 0) ? (bx % 8) * (F.G / 8) + bx / 8 : bx; }
    F.ws = args.ws; F.out = args.out;
#pragma unroll
    for (int i = 0; i < 16; ++i) F.in[i] = args.in[i];
    for (int u = F.tid; u < (LDS_BYTES - LDSCTL_OFF) / 4; u += NTHREADS) ((LAS unsigned*)(F.lds + LDSCTL_OFF))[u] = 0u;
    __syncthreads();
    const int wave0 = __builtin_amdgcn_readfirstlane(threadIdx.x >> 6);
    const bool multi = (args.ph_hi - args.ph_lo) > 1;
    XcdBarrier bar; bar.bar = (unsigned*)(F.ws + WS_CTL) + 4096; bar.x = 0; bar.st = nullptr;
    if (multi) bar = xcd_barrier_post((unsigned*)(F.ws + WS_CTL) + 4096, (volatile LAS unsigned*)(F.lds + MISC_OFF) + 8);
    for (int ph = args.ph_lo; ph < args.ph_hi; ++ph) {
        { int ln = __builtin_amdgcn_mbcnt_hi(~0u, __builtin_amdgcn_mbcnt_lo(~0u, 0u)); asm volatile("" : "+v"(ln)); F.lane = ln; F.wave = wave0; F.tid = wave0 * 64 + ln; }
        run_phase(F, ph);
        if (ph + 1 < args.ph_hi) xcd_barrier(bar);
    }
}

#ifndef N_LAUNCH_MODE
#define N_LAUNCH_MODE 1
#endif
extern "C" void kernel_launch(void* const* d_in, const int* in_sizes, int n_in, void* d_out, int out_size, void* d_ws, size_t ws_size, hipStream_t stream) {
    static int grid = 0;
    if (grid == 0) {
        if (n_in != 16 || out_size != S * DM || ws_size < WS_END) { fprintf(stderr, "kernel_launch: unexpected shapes (n_in %d out %d ws %zu)\n", n_in, out_size, ws_size); grid = -1; return; }
        int dev = 0, cus = 0;
        if (hipGetDevice(&dev) != hipSuccess || hipDeviceGetAttribute(&cus, hipDeviceAttributeMultiprocessorCount, dev) != hipSuccess) { grid = -1; return; }
        if (hipFuncSetAttribute((const void*)fwd_kernel, hipFuncAttributeMaxDynamicSharedMemorySize, LDS_BYTES) != hipSuccess) { fprintf(stderr, "kernel_launch: hipFuncSetAttribute failed\n"); grid = -1; return; }
        int per_cu = 0;
        if (hipOccupancyMaxActiveBlocksPerMultiprocessor(&per_cu, (const void*)fwd_kernel, NTHREADS, LDS_BYTES) != hipSuccess || per_cu < 1) fprintf(stderr, "kernel_launch: occupancy query says %d\n", per_cu);
        (void)hipGetLastError();
        grid = cus;
    }
    if (grid < 0) return;
    (void)hipMemsetAsync((char*)d_ws + WS_CTL, 0, CTL_ZERO_BYTES, stream);
    Args a{};
    for (int i = 0; i < 16; ++i) a.in[i] = (const float*)d_in[i];
    a.out = (float*)d_out; a.ws = (unsigned char*)d_ws;
#if N_LAUNCH_MODE == 1
    a.ph_lo = 0; a.ph_hi = N_PHASES;
    hipLaunchKernelGGL(fwd_kernel, dim3(grid), dim3(NTHREADS), LDS_BYTES, stream, a);
#else
    for (int ph = 0; ph < N_PHASES; ++ph) { a.ph_lo = ph; a.ph_hi = ph + 1; hipLaunchKernelGGL(fwd_kernel, dim3(grid), dim3(NTHREADS), LDS_BYTES, stream, a); }
#endif
}
```

```cpp
#include <hip/hip_runtime.h>
#include <cstdio>
#include <cstdint>
#include <cmath>
namespace pg8 {
#define PG8_LAS __attribute__((address_space(3)))
typedef unsigned short bf16_t;
typedef short bf16x8 __attribute__((ext_vector_type(8)));
typedef float f32x4 __attribute__((ext_vector_type(4)));
typedef unsigned u32x4 __attribute__((ext_vector_type(4)));
constexpr int BM = 256, BK = 64, HALF = 128, HTB = HALF * BK * 2  , STAGE_BYTES = 8 * HTB, NXCD = 8, WGM = 8;

__host__ __device__ __forceinline__ int lds_byte(int r, int c) { const int st = (r >> 4) * 2 + (c >> 5), rr = r & 15, cc = c & 31, ob = rr * 64 + cc * 2; return st * 1024 + (ob ^ (((ob >> 9) & 1) << 5)); }
__host__ __device__ __forceinline__ void stage_rc(int b, int& R, int& C) { const int st = b / 1024, sb = b % 1024, swz = sb ^ (((sb >> 9) & 1) << 5); R = (st >> 1) * 16 + swz / 64; C = (st & 1) * 32 + (swz % 64) / 2; }
__host__ __device__ __forceinline__ int perm32(int rho) { const int n = rho >> 4, i = rho & 15; return 8 * (i >> 2) + 4 * n + (i & 3); }

struct Unit { int pm, pn; };
struct Gemm { const bf16_t* A; const bf16_t* Bt; int M, N, K; };

struct StaticOrder {
    int nM, nN, nwg, G, c;
    __host__ __device__ void init(int M, int N, int G_, int c_) { nM = M / BM; nN = N / BM; nwg = nM * nN; G = G_; c = c_; }
    __host__ __device__ bool next(int i, Unit& u) const {
        const long L = (long)i * G + c; if (L >= nwg) return false;
        int wgid = (int)L; { const int q = nwg / NXCD, r = nwg % NXCD, xcd = wgid % NXCD, off = wgid / NXCD; wgid = (xcd < r ? xcd * (q + 1) : r * (q + 1) + (xcd - r) * q) + off; }
        const int nig = WGM * nN, gid = wgid / nig, fm = gid * WGM, gsz = (nM - fm) < WGM ? (nM - fm) : WGM;
        u.pm = fm + ((wgid % nig) % gsz); u.pn = (wgid % nig) / gsz; return true;
    }
    __device__ __forceinline__ void a_ready(const Unit&) const {}
    __device__ __forceinline__ void done(const Unit&) const {}
};


__device__ __forceinline__ unsigned cvt_pk_bf16(float lo, float hi) { unsigned r; asm volatile("v_cvt_pk_bf16_f32 %0, %1, %2" : "=v"(r) : "v"(lo), "v"(hi)); return r; }
typedef float f32x2 __attribute__((ext_vector_type(2)));

struct EpiInProj {
    static constexpr bool PERM = true, AFTER_DRAIN = false;
    bf16_t* O; int ldc; const float* rope; float qscale;
    __device__ __forceinline__ void operator()(const f32x4 (&acc)[2][2][4][2], const Unit& u, int wr, int wc, int fr, int fq) const {
        const int row0 = u.pm * BM + wr * 64 + fr; const int col0 = u.pn * BM + wc * 32 + 8 * fq;
        const int i0 = 16 * (wc & 1) + 4 * fq;
#pragma unroll
        for (int bj = 0; bj < 2; ++bj) {
            const int pn = u.pn;
            const bool do_rope = (pn == 3) || (pn == 4 && bj == 0);
            const bool do_sig = (pn == 10);
            const float sc = (pn == 0 || pn == 3 || pn == 5 || pn == 6) ? qscale : 1.0f;
#pragma unroll
            for (int ai = 0; ai < 2; ++ai)
#pragma unroll
                for (int m = 0; m < 4; ++m) {
                    const int row = row0 + ai * HALF + m * 16;
                    f32x4 v0 = acc[ai][bj][m][0], v1 = acc[ai][bj][m][1];
                    if (do_rope) {
                        const f32x4* rp = (const f32x4*)(rope + ((size_t)row * 32 + i0) * 2);
                        const f32x4 c01 = rp[0], c23 = rp[1];
                        f32x4 w0, w1;
                        w0[0] = v0[0] * c01[0] - v0[1] * c01[1]; w0[1] = v0[1] * c01[0] + v0[0] * c01[1];
                        w0[2] = v0[2] * c01[2] - v0[3] * c01[3]; w0[3] = v0[3] * c01[2] + v0[2] * c01[3];
                        w1[0] = v1[0] * c23[0] - v1[1] * c23[1]; w1[1] = v1[1] * c23[0] + v1[0] * c23[1];
                        w1[2] = v1[2] * c23[2] - v1[3] * c23[3]; w1[3] = v1[3] * c23[2] + v1[2] * c23[3];
                        v0 = w0; v1 = w1;
                    }
                    if (do_sig) {
#pragma unroll
                        for (int e = 0; e < 4; ++e) { v0[e] = 1.0f / (1.0f + __expf(-v0[e])); v1[e] = 1.0f / (1.0f + __expf(-v1[e])); }
                    }
                    v0 = v0 * sc; v1 = v1 * sc;
                    u32x4 w; w.x = cvt_pk_bf16(v0[0], v0[1]); w.y = cvt_pk_bf16(v0[2], v0[3]); w.z = cvt_pk_bf16(v1[0], v1[1]); w.w = cvt_pk_bf16(v1[2], v1[3]);
                    *(u32x4*)(O + (size_t)row * ldc + col0 + bj * HALF) = w;
                }
        }
    }
};
struct EpiRelu2 {
    static constexpr bool PERM = true, AFTER_DRAIN = false;
    bf16_t* O; int ldc;
    __device__ __forceinline__ void operator()(const f32x4 (&acc)[2][2][4][2], const Unit& u, int wr, int wc, int fr, int fq) const {
        const int row0 = u.pm * BM + wr * 64 + fr; const int col0 = u.pn * BM + wc * 32 + 8 * fq;
#pragma unroll
        for (int ai = 0; ai < 2; ++ai)
#pragma unroll
            for (int m = 0; m < 4; ++m) { bf16_t* rowp = O + (size_t)(row0 + ai * HALF + m * 16) * ldc + col0;
#pragma unroll
                for (int bj = 0; bj < 2; ++bj) { f32x4 v0 = acc[ai][bj][m][0], v1 = acc[ai][bj][m][1];
#pragma unroll
                    for (int e = 0; e < 4; ++e) { const float a = fmaxf(v0[e], 0.f), b = fmaxf(v1[e], 0.f); v0[e] = a * a; v1[e] = b * b; }
                    u32x4 w; w.x = cvt_pk_bf16(v0[0], v0[1]); w.y = cvt_pk_bf16(v0[2], v0[3]); w.z = cvt_pk_bf16(v1[0], v1[1]); w.w = cvt_pk_bf16(v1[2], v1[3]);
                    *(u32x4*)(rowp + bj * HALF) = w; } }
    }
};
struct EpiResid {
    static constexpr bool PERM = false, AFTER_DRAIN = false;
    const float* base; float* out; int ldc; const float* gate; float alpha;
    __device__ __forceinline__ void operator()(const f32x4 (&acc)[2][2][4][2], const Unit& u, int wr, int wc, int fr, int fq) const {
        const int col0 = u.pn * BM + wc * 32 + 4 * fq;
#pragma unroll
        for (int bj = 0; bj < 2; ++bj)
#pragma unroll
            for (int n = 0; n < 2; ++n) { const f32x4 gv = *(const f32x4*)(gate + col0 + bj * HALF + n * 16) + 1.0f;
#pragma unroll
                for (int ai = 0; ai < 2; ++ai)
#pragma unroll
                    for (int m = 0; m < 4; ++m) { const size_t off = (size_t)(u.pm * BM + ai * HALF + wr * 64 + m * 16 + fr) * ldc + col0 + bj * HALF + n * 16;
                        const f32x4 bs = *(const f32x4*)(base + off); *(f32x4*)(out + off) = bs * alpha + gv * acc[ai][bj][m][n]; } }
    }
};
template <class Epi, class Sched, bool ALIGN_EPI = false, bool SP2 = false>
__device__ __forceinline__ void gemm_phase(PG8_LAS unsigned char* lds, const Gemm g, const Sched& S, const Epi& E, const int wid  ) {
    int lane_ = __builtin_amdgcn_mbcnt_hi(~0u, __builtin_amdgcn_mbcnt_lo(~0u, 0u)); asm volatile("" : "+v"(lane_));
    const int lane = lane_, tid = wid * 64 + lane, wr = wid >> 2, wc = wid & 3, fr = lane & 15, fq = lane >> 4;
    const int K = g.K, nt = K / BK;
    unsigned voffA[2], voffB[2];
#pragma unroll
    for (int i = 0; i < 2; ++i) { int R, C; stage_rc(tid * 16 + i * 8192, R, C); const int Rb = Epi::PERM ? ((R & ~31) + perm32(R & 31)) : R;
        voffA[i] = (unsigned)(R * K + C) * 2u; voffB[i] = (unsigned)(Rb * K + C) * 2u; }
    const size_t kstep = (size_t)(BK * 2);
    const size_t hstep = (size_t)HALF * K * 2;
    const size_t tstep = 2 * hstep;
    const unsigned ldsw = (unsigned)wid * 1024u;
    const int aoff = lds_byte(wr * 64 + fr, fq * 8), boff = lds_byte(wc * 32 + fr, fq * 8);
#define PG8_SA(b, h) (((b) * 2 + (h)) * HTB)
#define PG8_SB(b, h) ((4 + (b) * 2 + (h)) * HTB)
#define PG8_STAGE(bufoff, gbase, voff) do { _Pragma("unroll") for (int _i = 0; _i < 2; ++_i) \
        __builtin_amdgcn_global_load_lds((const unsigned*)((const char*)(gbase) + (voff)[_i]), (PG8_LAS unsigned*)(lds + (bufoff) + ldsw + _i * 8192), 16, 0, 0); } while (0)
#define PG8_LDA(dst, b, h) do { _Pragma("unroll") for (int m = 0; m < 4; ++m) _Pragma("unroll") for (int k = 0; k < 2; ++k) dst[m][k] = *(const PG8_LAS bf16x8*)(lds + PG8_SA(b, h) + aoff + m * 2048 + k * 1024); } while (0)
#define PG8_LDB(dst, b, h) do { _Pragma("unroll") for (int n = 0; n < 2; ++n) _Pragma("unroll") for (int k = 0; k < 2; ++k) dst[n][k] = *(const PG8_LAS bf16x8*)(lds + PG8_SB(b, h) + boff + n * 2048 + k * 1024); } while (0)
#define PG8_MMA(ai, bj, At, Bt) do { __builtin_amdgcn_s_setprio(1); _Pragma("unroll") for (int m = 0; m < 4; ++m) _Pragma("unroll") for (int n = 0; n < 2; ++n) _Pragma("unroll") for (int k = 0; k < 2; ++k) \
        acc[ai][bj][m][n] = __builtin_amdgcn_mfma_f32_16x16x32_bf16(Bt[n][k], At[m][k], acc[ai][bj][m][n], 0, 0, 0); __builtin_amdgcn_s_setprio(0); } while (0)
#define PG8_WAIT_V(n) asm volatile("s_waitcnt vmcnt(" #n ")" ::: "memory")
#define PG8_WAIT_L(n) asm volatile("s_waitcnt lgkmcnt(" #n ")" ::: "memory")
#define PG8_BAR __builtin_amdgcn_s_barrier()
#define PG8_SCHED __builtin_amdgcn_sched_barrier(0)
    Unit cur, nxt; int ui = 0;
    if (!S.next(0, cur)) return;
    f32x4 acc[2][2][4][2];
#pragma unroll
    for (int a = 0; a < 2; ++a)
#pragma unroll
        for (int b = 0; b < 2; ++b)
#pragma unroll
            for (int m = 0; m < 4; ++m)
#pragma unroll
                for (int n = 0; n < 2; ++n) acc[a][b][m][n] = (f32x4){0.f, 0.f, 0.f, 0.f};
    bf16x8 At[4][2], B0[2][2], B1[2][2];
    const char* cA = (const char*)g.A + (size_t)cur.pm * tstep; const char* cB = (const char*)g.Bt + (size_t)cur.pn * tstep;
    S.a_ready(cur);
    if constexpr (SP2) {
        PG8_STAGE(PG8_SB(0, 0), cB, voffB); PG8_STAGE(PG8_SB(0, 1), cB + hstep, voffB); PG8_STAGE(PG8_SA(0, 0), cA, voffA); PG8_STAGE(PG8_SA(0, 1), cA + hstep, voffA);
        if (wr == 1) PG8_BAR;
        PG8_WAIT_V(2); PG8_BAR;
        PG8_STAGE(PG8_SB(1, 0), cB + kstep, voffB); PG8_STAGE(PG8_SA(1, 0), cA + kstep, voffA); PG8_STAGE(PG8_SB(1, 1), cB + hstep + kstep, voffB);
        PG8_WAIT_V(6); PG8_BAR;
    } else {
        PG8_STAGE(PG8_SB(0, 0), cB, voffB); PG8_STAGE(PG8_SA(0, 0), cA, voffA); PG8_STAGE(PG8_SB(0, 1), cB + hstep, voffB); PG8_STAGE(PG8_SA(0, 1), cA + hstep, voffA);
        if (wr == 1) PG8_BAR;
        PG8_WAIT_V(4); PG8_BAR;
        PG8_STAGE(PG8_SB(1, 0), cB + kstep, voffB); PG8_STAGE(PG8_SA(1, 0), cA + kstep, voffA); PG8_STAGE(PG8_SB(1, 1), cB + hstep + kstep, voffB);
        PG8_WAIT_V(6); PG8_BAR;
    }
    for (;;) {
        const bool has_next = S.next(ui + 1, nxt);
        const char* nA = has_next ? (const char*)g.A + (size_t)nxt.pm * tstep : cA; const char* nB = has_next ? (const char*)g.Bt + (size_t)nxt.pn * tstep : cB;
        for (int t = 0; t < nt; t += 2) {
            const bool last = (t == nt - 2);
            const char* a1 = cA + (size_t)(t + 1) * kstep;
            const char* a2 = last ? nA : cA + (size_t)(t + 2) * kstep; const char* b2 = last ? nB : cB + (size_t)(t + 2) * kstep;
            const char* a3 = a2 + kstep; const char* b3 = b2 + kstep;
            if (last && has_next) S.a_ready(nxt);
            if constexpr (SP2) {
            PG8_LDB(B0, 0, 0); PG8_LDB(B1, 0, 1); PG8_SCHED; PG8_LDA(At, 0, 0); PG8_STAGE(PG8_SA(1, 1), a1 + hstep, voffA);
            PG8_WAIT_V(8); PG8_WAIT_L(0); PG8_BAR; PG8_MMA(0, 0, At, B0); PG8_MMA(0, 1, At, B1); PG8_BAR; PG8_SCHED;
            PG8_LDA(At, 0, 1); PG8_STAGE(PG8_SB(0, 0), b2, voffB); PG8_STAGE(PG8_SB(0, 1), b2 + hstep, voffB); PG8_STAGE(PG8_SA(0, 0), a2, voffA);
            PG8_WAIT_V(8); PG8_WAIT_L(0); PG8_BAR; PG8_MMA(1, 0, At, B0); PG8_MMA(1, 1, At, B1); PG8_BAR; PG8_SCHED;
            PG8_LDB(B0, 1, 0); PG8_LDB(B1, 1, 1); PG8_SCHED; PG8_LDA(At, 1, 0); PG8_STAGE(PG8_SA(0, 1), a2 + hstep, voffA);
            PG8_WAIT_V(8); PG8_WAIT_L(0); PG8_BAR; PG8_MMA(0, 0, At, B0); PG8_MMA(0, 1, At, B1); PG8_BAR; PG8_SCHED;
            PG8_LDA(At, 1, 1); PG8_STAGE(PG8_SB(1, 0), b3, voffB); PG8_STAGE(PG8_SB(1, 1), b3 + hstep, voffB); PG8_STAGE(PG8_SA(1, 0), a3, voffA);
            PG8_WAIT_V(8); PG8_WAIT_L(0); PG8_BAR; PG8_MMA(1, 0, At, B0); PG8_MMA(1, 1, At, B1); PG8_BAR; PG8_SCHED;
            } else {
            PG8_LDB(B0, 0, 0); PG8_SCHED; PG8_LDA(At, 0, 0); PG8_STAGE(PG8_SA(1, 1), a1 + hstep, voffA);
            PG8_WAIT_L(8); PG8_BAR; PG8_WAIT_L(0); PG8_MMA(0, 0, At, B0); PG8_BAR; PG8_SCHED;
            PG8_LDB(B1, 0, 1); PG8_STAGE(PG8_SB(0, 0), b2, voffB);
            PG8_BAR; PG8_WAIT_L(0); PG8_MMA(0, 1, At, B1); PG8_BAR;
            PG8_LDA(At, 0, 1); PG8_STAGE(PG8_SA(0, 0), a2, voffA);
            PG8_BAR; PG8_WAIT_L(0); PG8_MMA(1, 0, At, B0); PG8_BAR; PG8_SCHED;
            PG8_STAGE(PG8_SB(0, 1), b2 + hstep, voffB);
            PG8_WAIT_V(6); PG8_BAR; PG8_MMA(1, 1, At, B1); PG8_BAR;
            PG8_LDB(B0, 1, 0); PG8_SCHED; PG8_LDA(At, 1, 0); PG8_STAGE(PG8_SA(0, 1), a2 + hstep, voffA);
            PG8_WAIT_L(8); PG8_BAR; PG8_WAIT_L(0); PG8_MMA(0, 0, At, B0); PG8_BAR; PG8_SCHED;
            PG8_LDB(B1, 1, 1); PG8_STAGE(PG8_SB(1, 0), b3, voffB);
            PG8_BAR; PG8_WAIT_L(0); PG8_MMA(0, 1, At, B1); PG8_BAR;
            PG8_LDA(At, 1, 1); PG8_STAGE(PG8_SA(1, 0), a3, voffA);
            PG8_BAR; PG8_WAIT_L(0); PG8_MMA(1, 0, At, B0); PG8_BAR; PG8_SCHED;
            PG8_STAGE(PG8_SB(1, 1), b3 + hstep, voffB);
            PG8_WAIT_V(6); PG8_BAR; PG8_MMA(1, 1, At, B1); PG8_BAR;
            }
        }
        if constexpr (ALIGN_EPI) { if (wr == 0) PG8_BAR; }
        if constexpr (!Epi::AFTER_DRAIN) { E(acc, cur, wr, wc, fr, fq); S.done(cur); }
        if (!has_next) break;
#pragma unroll
        for (int a = 0; a < 2; ++a)
#pragma unroll
            for (int b = 0; b < 2; ++b)
#pragma unroll
                for (int m = 0; m < 4; ++m)
#pragma unroll
                    for (int n = 0; n < 2; ++n) acc[a][b][m][n] = (f32x4){0.f, 0.f, 0.f, 0.f};
        cur = nxt; cA = nA; cB = nB; ++ui;
        if constexpr (ALIGN_EPI) { if (wr == 1) PG8_BAR; }
    }
    PG8_WAIT_V(0);
    if constexpr (!ALIGN_EPI) { if (wr == 0) PG8_BAR; }
    PG8_BAR;
    if constexpr (Epi::AFTER_DRAIN) { E.fused(acc, cur, wr, wc, fr, fq, lds, wid, lane); S.done(cur); }
#undef PG8_SA
#undef PG8_SB
#undef PG8_STAGE
#undef PG8_LDA
#undef PG8_LDB
#undef PG8_MMA
#undef PG8_WAIT_V
#undef PG8_WAIT_L
#undef PG8_BAR
#undef PG8_SCHED
}
}

#ifndef PG8_SP2
#define PG8_SP2 true
#endif
#ifndef PG8_ALIGN
#define PG8_ALIGN true
#endif

constexpr int S = 16384, DM = 1024, NIN = 2584, NINP = 2816, DFF = 4096, DEPTH = 4;
constexpr int NWAVES = 8, NTHREADS = 512;
constexpr float LN_EPS = 1e-5f;
constexpr float LOG2E = 1.4426950408889634f;
constexpr float QSCALE = 0.125f * LOG2E;
constexpr float DN_ALPHA = 1.681792830507429f;
constexpr int C_AQ = 0, C_AK = 256, C_AV = 512, C_BQ = 768, C_BK = 1024, C_BV = 1152, C_CQ = 1280, C_CKC = 1792, C_CVC = 1920,
              C_CKS = 2048, C_CVS = 2176, C_CKW = 2304, C_CVW = 2432, C_CG = 2560;
constexpr int NCMP = 1023, NSEL = 256;
constexpr int BIASLEN = 2048;

constexpr size_t MiB = 1u << 20;
constexpr size_t WS_CTL = 0, CTL_ZERO_BYTES = 1 * MiB;
constexpr size_t WS_MOD = 1 * MiB;
constexpr size_t WS_BIAS = 1 * MiB + 128 * 1024;
constexpr size_t WS_BMAX = 1 * MiB + 256 * 1024;
constexpr size_t WS_ROPE = 2 * MiB;
constexpr size_t WS_KC = 6 * MiB, WS_VC = 6 * MiB + 512 * 1024;
constexpr size_t WS_CW2T = 6 * MiB;
constexpr size_t WS_POSW1 = 6 * MiB + 512 * 1024;
constexpr size_t WS_WIN = 8 * MiB;
constexpr size_t WS_WOUT = 30 * MiB;
constexpr size_t WS_W1 = 38 * MiB;
constexpr size_t WS_W2 = 70 * MiB;
constexpr size_t WS_CW1 = 102 * MiB;
constexpr size_t WS_RA = 110 * MiB, WS_RB = 142 * MiB;
constexpr size_t WS_BIG = 174 * MiB;
constexpr size_t WS_OWIN = WS_BIG + 88 * MiB;
constexpr size_t WS_OA3 = WS_BIG + 104 * MiB;
constexpr size_t WS_OCMP = 302 * MiB;
constexpr size_t WS_SELB = 318 * MiB;
constexpr size_t WS_LSE = 319 * MiB;
constexpr size_t WS_END = 320 * MiB;
constexpr size_t WS_KCB = 7 * MiB, WS_VCB = 7 * MiB + 512 * 1024;
constexpr int CW_MAX = 16384;

#define GAS __attribute__((address_space(1)))
#define LAS __attribute__((address_space(3)))
typedef unsigned short bf16;
typedef unsigned v4u __attribute__((ext_vector_type(4)));
typedef unsigned v2u __attribute__((ext_vector_type(2)));
typedef float f32x4 __attribute__((ext_vector_type(4)));
typedef float f32x2 __attribute__((ext_vector_type(2)));
#define LDS_WAIT() asm volatile("s_waitcnt lgkmcnt(0)" ::: "memory")
#define VM_WAIT() asm volatile("s_waitcnt vmcnt(0)" ::: "memory")
__device__ __forceinline__ unsigned f2bf(float f) { unsigned u = __builtin_bit_cast(unsigned, f); return (u + 0x7fffu + ((u >> 16) & 1u)) >> 16; }
__device__ __forceinline__ unsigned pk2(float lo, float hi) { return f2bf(lo) | (f2bf(hi) << 16); }
__device__ __forceinline__ float bf2f(unsigned short b) { return __uint_as_float((unsigned)b << 16); }
__device__ __forceinline__ float bflo(unsigned w) { return __uint_as_float(w << 16); }
__device__ __forceinline__ float bfhi(unsigned w) { return __uint_as_float(w & 0xffff0000u); }
__device__ __forceinline__ float wave_sum(float v) {
#pragma unroll
    for (int o = 1; o < 64; o <<= 1) v += __shfl_xor(v, o);
    return v;
}
__device__ __forceinline__ float wave_max(float v) {
#pragma unroll
    for (int o = 1; o < 64; o <<= 1) v = fmaxf(v, __shfl_xor(v, o));
    return v;
}

constexpr int RING_BYTES = 153600;
constexpr int LDSCTL_OFF = RING_BYTES, MISC_OFF = LDSCTL_OFF + 320;
constexpr int LDS_BYTES = 155648;

struct Args { const float* in[16]; float* out; unsigned char* ws; int ph_lo, ph_hi; };

struct Frame {
    LAS unsigned char* lds;
    int tid, lane, wave, G, vcu;
    unsigned char* ws;
    const float* in[16];
    float* out;
};
enum { I_X = 0, I_C, I_POS, I_WIN, I_WOUT, I_RELB, I_SINK, I_CPOS, I_CW1, I_CW2, I_MW1, I_MW2, I_ADAW, I_ADAB, I_LNG, I_LNB };

__device__ __forceinline__ int t5_bucket(int d) {
    if (d < 16) return d;
    int b = 16;
    b += d >= 22; b += d >= 30; b += d >= 40; b += d >= 54; b += d >= 73; b += d >= 99; b += d >= 134; b += d >= 182;
    b += d >= 246; b += d >= 332; b += d >= 450; b += d >= 609; b += d >= 825; b += d >= 1117; b += d >= 1513;
    return b;
}
__device__ const float ROPE_FREQ[32] = {1.000000000e+00f, 6.890442967e-01f, 4.747820497e-01f, 3.271458745e-01f, 2.254180014e-01f, 1.553229839e-01f, 1.070244238e-01f, 7.374456525e-02f,
    5.081327632e-02f, 3.501259908e-02f, 2.412523143e-02f, 1.662335359e-02f, 1.145422645e-02f, 7.892469876e-03f, 5.438261200e-03f, 3.747202922e-03f,
    2.581988927e-03f, 1.779104699e-03f, 1.225881977e-03f, 8.446869906e-04f, 5.820267834e-04f, 4.010422272e-04f, 2.763358643e-04f, 1.904076635e-04f,
    1.311993110e-04f, 9.040213627e-05f, 6.229108112e-05f, 4.292131416e-05f, 2.957468678e-05f, 2.037826926e-05f, 1.404153045e-05f, 9.675236470e-06f};
__device__ __forceinline__ void sincos_f(float a, float& c, float& s) {
    const float n = rintf(a * 0.636619772367581343f);
    float r = fmaf(-n, 1.5703125f, a); r = fmaf(-n, 0.0004838267923332751f, r); r = fmaf(-n, 2.5632829192545614e-12f, r);
    const float r2 = r * r;
    const float sp = fmaf(r * r2, fmaf(r2, fmaf(r2, fmaf(r2, 2.755731922e-6f, -1.984126984e-4f), 8.333333333e-3f), -1.666666667e-1f), r);
    const float cp = fmaf(r2, fmaf(r2, fmaf(r2, fmaf(r2, fmaf(r2, -2.755731922e-7f, 2.480158730e-5f), -1.388888889e-3f), 4.166666667e-2f), -0.5f), 1.0f);
    const int q = ((int)n) & 3;
    c = (q == 0) ? cp : (q == 1) ? -sp : (q == 2) ? -cp : sp;
    s = (q == 0) ? sp : (q == 1) ? cp : (q == 2) ? -sp : -cp;
}

template <int MODE>
__device__ __forceinline__ int colmap(int n) {
    if (MODE == 0) return n;
    if (n >= NIN) return -1;
    if (n >= C_BQ && n < C_BV) { const int hb = n & ~63, j = n & 63; return hb + (j >> 1) + 32 * (j & 1); }
    return n;
}
template <int MODE>
__device__ __forceinline__ void transpose_item(const float* W, int K, int N, int NP, bf16* WT, LAS float* scr, int item, int lane) {
    const int nblk = NP / 32, kb = item / nblk, nb = item % nblk, k0 = 64 * kb, n0 = 32 * nb;
    const int src = colmap<MODE>(n0 + (lane & 31));
#pragma unroll 8
    for (int i = 0; i < 32; ++i) { const int kk = 2 * i + (lane >> 5); scr[kk * 33 + (lane & 31)] = src >= 0 ? W[(size_t)(k0 + kk) * N + src] : 0.f; }
    LDS_WAIT(); asm volatile("" ::: "memory");
    const int c = lane & 7;
#pragma unroll
    for (int j = 0; j < 4; ++j) { const int n = (lane >> 3) + 8 * j; const LAS float* s = scr + (8 * c) * 33 + n;
        v4u o; o.x = pk2(s[0 * 33], s[1 * 33]); o.y = pk2(s[2 * 33], s[3 * 33]); o.z = pk2(s[4 * 33], s[5 * 33]); o.w = pk2(s[6 * 33], s[7 * 33]);
        *(v4u*)(WT + (size_t)(n0 + n) * K + k0 + 8 * c) = o; }
    LDS_WAIT(); asm volatile("" ::: "memory");
}

__device__ __forceinline__ void p0_prologue(Frame& F) {
    LAS float* scr = (LAS float*)(F.lds + F.wave * 16384);
    const int gw = F.vcu * NWAVES + F.wave, NGW = F.G * NWAVES;
    constexpr int I_IN = (DM / 64) * (NINP / 32), I_OUT = (DM / 64) * (DM / 32), I_1 = (DM / 64) * (DFF / 32), I_2 = (DFF / 64) * (DM / 32);
    constexpr int PER_LAYER = I_IN + I_OUT + I_1 + I_2;
    for (int it = gw; it < DEPTH * PER_LAYER; it += NGW) {
        const int l = it / PER_LAYER; int r = it % PER_LAYER;
        if (r < I_IN) { transpose_item<1>(F.in[I_WIN] + (size_t)l * DM * NIN, DM, NIN, NINP, (bf16*)(F.ws + WS_WIN) + (size_t)l * NINP * DM, scr, r, F.lane); continue; } r -= I_IN;
        if (r < I_OUT) { transpose_item<0>(F.in[I_WOUT] + (size_t)l * DM * DM, DM, DM, DM, (bf16*)(F.ws + WS_WOUT) + (size_t)l * DM * DM, scr, r, F.lane); continue; } r -= I_OUT;
        if (r < I_1) { transpose_item<0>(F.in[I_MW1] + (size_t)l * DM * DFF, DM, DFF, DFF, (bf16*)(F.ws + WS_W1) + (size_t)l * DFF * DM, scr, r, F.lane); continue; } r -= I_1;
        transpose_item<0>(F.in[I_MW2] + (size_t)l * DFF * DM, DFF, DM, DM, (bf16*)(F.ws + WS_W2) + (size_t)l * DM * DFF, scr, r, F.lane);
    }
    {
        __syncthreads();
        LAS float* red = (LAS float*)F.lds;
        const int nl = F.tid & 63, kp = F.tid >> 6;
        for (int it = F.vcu; it < DEPTH * 96; it += F.G) {
            const int l = it / 96, n = (it % 96) * 64 + nl;
            const float* w = F.in[I_ADAW] + (size_t)l * DM * 6144 + n;
            const float* c = F.in[I_C];
            float a = 0.f;
#pragma unroll 8
            for (int k = kp * 128; k < kp * 128 + 128; ++k) { const float cv = c[k]; a += (cv / (1.0f + __expf(-cv))) * w[(size_t)k * 6144]; }
            red[kp * 64 + nl] = a;
            __syncthreads();
            if (kp == 0) { float s = F.in[I_ADAB][l * 6144 + n];
#pragma unroll
                for (int j = 0; j < 8; ++j) s += red[j * 64 + nl];
                ((float*)(F.ws + WS_MOD))[l * 6144 + n] = s; }
            __syncthreads();
        }
    }
    {
        const int gt = F.vcu * NTHREADS + F.tid, NGT = F.G * NTHREADS;
        const int* pos = (const int*)F.in[I_POS];
        f32x2* rt = (f32x2*)(F.ws + WS_ROPE);
        for (int e = gt; e < S * 32; e += NGT) {
            const int r = e >> 5, i = e & 31;
            const float ang = (float)pos[r] * ROPE_FREQ[i];
            float cs, sn; sincos_f(ang, cs, sn);
            rt[e] = (f32x2){cs, sn};
        }
        if (gt < 12) { float m = -1e30f; for (int b = 0; b < 32; ++b) m = fmaxf(m, F.in[I_RELB][b * 12 + gt] * LOG2E); ((float*)(F.ws + WS_BMAX))[gt] = m; }
        for (int e = gt; e < 8 * 256 * 256; e += NGT) { const int mtx = e >> 16, c = (e >> 8) & 255, n = e & 255; const float* w = F.in[I_CW1] + (size_t)mtx * 2048 * 256 + (size_t)(8 * c) * 256 + n;
            v4u o; o.x = pk2(w[0], w[256]); o.y = pk2(w[512], w[768]); o.z = pk2(w[1024], w[1280]); o.w = pk2(w[1536], w[1792]);
            *(v4u*)((bf16*)(F.ws + WS_CW1) + (size_t)e * 8) = o; }
        for (int e = gt; e < 8 * 64 * 32; e += NGT) { const int mtx = e >> 11, ee = (e >> 5) & 63, jc = e & 31; const float* w = F.in[I_CW2] + (size_t)mtx * 256 * 64 + (size_t)(8 * jc) * 64 + ee;
            v4u o; o.x = pk2(w[0], w[64]); o.y = pk2(w[128], w[192]); o.z = pk2(w[256], w[320]); o.w = pk2(w[384], w[448]);
            *(v4u*)((bf16*)(F.ws + WS_CW2T) + (size_t)e * 8) = o; }
        for (int e = gt; e < 8 * 256; e += NGT) { const int mtx = e >> 8, n = e & 255; const float* w = F.in[I_CW1] + (size_t)mtx * 2048 * 256 + n; const float* ps = F.in[I_CPOS] + (size_t)mtx * 2048;
            float a = 0.f;
#pragma unroll 8
            for (int f = 0; f < 2048; ++f) a += ps[f] * w[(size_t)f * 256];
            ((float*)(F.ws + WS_POSW1))[e] = a; }
        float* bt = (float*)(F.ws + WS_BIAS);
        for (int e = gt; e < 12 * BIASLEN; e += NGT) {
            const int h = e / BIASLEN, d = e % BIASLEN;
            bt[e] = F.in[I_RELB][t5_bucket(d) * 12 + h] * LOG2E;
        }
    }
}

template <int MODE>
__device__ __forceinline__ void row_pass(Frame& F, const float* xin, float* xout, bf16* H, const float* lng, const float* lnb, const float* sc, const float* sh) {
    const int gw = F.vcu * NWAVES + F.wave, NGW = F.G * NWAVES;
    for (int m = gw; m < S; m += NGW) {
        const f32x4* xr = (const f32x4*)(xin + (size_t)m * DM) + F.lane;
        f32x4 v[4];
#pragma unroll
        for (int j = 0; j < 4; ++j) v[j] = xr[64 * j];
        if (MODE != 0) {
            float s = 0.f;
#pragma unroll
            for (int j = 0; j < 4; ++j) s += (v[j].x + v[j].y) + (v[j].z + v[j].w);
            const float mean = wave_sum(s) * (1.f / DM); float s2 = 0.f;
#pragma unroll
            for (int j = 0; j < 4; ++j) { v[j] = v[j] - mean; s2 += (v[j].x * v[j].x + v[j].y * v[j].y) + (v[j].z * v[j].z + v[j].w * v[j].w); }
            const float rstd = 1.f / sqrtf(wave_sum(s2) * (1.f / DM) + LN_EPS);
            f32x4* xo = (f32x4*)(xout + (size_t)m * DM) + F.lane;
#pragma unroll
            for (int j = 0; j < 4; ++j) { const f32x4 g = ((const f32x4*)lng)[F.lane + 64 * j], b = ((const f32x4*)lnb)[F.lane + 64 * j]; v[j] = v[j] * rstd * g + b; xo[64 * j] = v[j]; }
        }
        if (MODE != 2) {
            v2u* o8 = (v2u*)(H + (size_t)m * DM) + F.lane;
#pragma unroll
            for (int j = 0; j < 4; ++j) { const f32x4 a = ((const f32x4*)sc)[F.lane + 64 * j] + 1.0f, b = ((const f32x4*)sh)[F.lane + 64 * j]; const f32x4 h = v[j] * a + b;
                o8[64 * j] = (v2u){pk2(h.x, h.y), pk2(h.z, h.w)}; }
        }
    }
}

typedef GAS unsigned gu32;
typedef GAS unsigned long long gu64;
#define RLX_AGENT __ATOMIC_RELAXED, __HIP_MEMORY_SCOPE_AGENT
__device__ __forceinline__ unsigned long long rt() { return __builtin_amdgcn_s_memrealtime(); }

#define XB_TMO      128
#define XB_XCNT(j)  (256  + 64 * (j))
#define XB_XSUB(j)  (1280 + 64 * (j))
#define XB_XGEN(j)  (2304 + 64 * (j))
#define XB_TOP      3328
#define XB_TOPGEN   3392
#define XCD_BAR_WORDS 3456
#define XB_SPIN_CAP (1u << 18)

__device__ __forceinline__ unsigned xb_ld(unsigned* p)              { return __hip_atomic_load(p, __ATOMIC_RELAXED, __HIP_MEMORY_SCOPE_AGENT); }
__device__ __forceinline__ unsigned xb_add(unsigned* p, unsigned v) { return __hip_atomic_fetch_add(p, v, __ATOMIC_RELAXED, __HIP_MEMORY_SCOPE_AGENT); }
__device__ __forceinline__ unsigned xb_xcc_id() { return (unsigned)__builtin_amdgcn_s_getreg((3 << 11) | 20) & 0xFu; }
#define XB_SPIN(cond, bar) do { unsigned _sp = 0; while (cond) { __builtin_amdgcn_s_sleep(1); \
    if ((++_sp & 255u) == 0u) { if (xb_ld(&(bar)[XB_TMO])) break; if (_sp > XB_SPIN_CAP) { atomicAdd(&(bar)[XB_TMO], 1u); break; } } } } while (0)

struct XcdBarrier {
    unsigned* bar; unsigned x;
    volatile LAS unsigned* st;
};

__device__ __forceinline__ XcdBarrier xcd_barrier_post(unsigned* bar, volatile LAS unsigned* st) {
    XcdBarrier b; b.bar = bar; b.x = xb_xcc_id(); b.st = st;
    if (threadIdx.x == 0) (void)xb_add(&bar[XB_XCNT(b.x)], 1u);
    return b;
}
__device__ __forceinline__ void xcd_barrier_complete(unsigned* bar, unsigned x, unsigned& nloc, unsigned& nx) {
    const unsigned G = gridDim.x * gridDim.y * gridDim.z;
    unsigned sum, cnt, mine, sp = 0u;
    for (;;) {
        sum = 0u; cnt = 0u; mine = 0u;
#pragma unroll
        for (unsigned j = 0; j < 16; ++j) { const unsigned c = xb_ld(&bar[XB_XCNT(j)]); sum += c; cnt += (c > 0u) ? 1u : 0u; mine = (j == x) ? c : mine; }
        if (sum == G) break;
        __builtin_amdgcn_s_sleep(1);
        if ((++sp & 255u) == 0u) { if (xb_ld(&bar[XB_TMO])) break; if (sp > XB_SPIN_CAP) { atomicAdd(&bar[XB_TMO], 1u); break; } }
    }
    nloc = mine > 0u ? mine : 1u; nx = cnt > 0u ? cnt : 1u;
}

__device__ __forceinline__ void xcd_barrier(const XcdBarrier& b) {
    asm volatile("s_waitcnt vmcnt(0)" ::: "memory");
    __syncthreads();
    if (threadIdx.x == 0) {
        unsigned* bar = b.bar;
        __builtin_amdgcn_s_waitcnt(0);
        unsigned nloc = b.st[0], nx = b.st[1];
        if (nloc == 0u) { xcd_barrier_complete(bar, b.x, nloc, nx); b.st[0] = nloc; b.st[1] = nx; }
        const unsigned old = xb_add(&bar[XB_XSUB(b.x)], 1u);
        const unsigned gen = old / nloc;
        if (old + 1u == (gen + 1u) * nloc) {
            __builtin_amdgcn_fence(__ATOMIC_RELEASE, "agent");
            asm volatile("s_waitcnt vmcnt(0)" ::: "memory");
            const unsigned og = xb_add(&bar[XB_TOP], 1u);
            const unsigned tg = og / nx;
            if (og + 1u == (tg + 1u) * nx) xb_add(&bar[XB_TOPGEN], 1u);
            else XB_SPIN(xb_ld(&bar[XB_TOPGEN]) == tg, bar);
            __builtin_amdgcn_fence(__ATOMIC_ACQUIRE, "agent");
            xb_add(&bar[XB_XGEN(b.x)], 1u);
            asm volatile("s_waitcnt vmcnt(0)" ::: "memory");
        } else {
            XB_SPIN(xb_ld(&bar[XB_XGEN(b.x)]) == gen, bar);
            __builtin_amdgcn_fence(__ATOMIC_ACQUIRE, "agent");
            asm volatile("s_waitcnt vmcnt(0)" ::: "memory");
        }
    }
    __syncthreads();
}


__device__ __forceinline__ float ld_elem(const bf16* p) { return bf2f(*p); }
__device__ __forceinline__ float ld_elem(const float* p) { return *p; }
template <int G>
__device__ __forceinline__ void dot64(const bf16* k, const LAS float* qs, float (&s)[G]) {
    const v4u* kp = (const v4u*)k;
#pragma unroll 2
    for (int c = 0; c < 8; ++c) { const v4u w = kp[c];
        float kv[8] = {bflo(w.x), bfhi(w.x), bflo(w.y), bfhi(w.y), bflo(w.z), bfhi(w.z), bflo(w.w), bfhi(w.w)};
#pragma unroll
        for (int g = 0; g < G; ++g) { const LAS f32x4* q4 = (const LAS f32x4*)(qs + g * 64 + c * 8); const f32x4 a = q4[0], b = q4[1];
            s[g] += kv[0] * a.x + kv[1] * a.y + kv[2] * a.z + kv[3] * a.w + kv[4] * b.x + kv[5] * b.y + kv[6] * b.z + kv[7] * b.w; } }
}
template <int G>
__device__ __forceinline__ void dot64(const float* k, const LAS float* qs, float (&s)[G]) {
    const f32x4* kp = (const f32x4*)k;
#pragma unroll 2
    for (int c = 0; c < 16; ++c) { const f32x4 w = kp[c];
#pragma unroll
        for (int g = 0; g < G; ++g) { const f32x4 a = *(const LAS f32x4*)(qs + g * 64 + c * 4); s[g] += w.x * a.x + w.y * a.y + w.z * a.z + w.w * a.w; } }
}
template <int G, class KT, class KeyFn>
__device__ __forceinline__ void wave_attend(const KT* K, const KT* V, const LAS float* qs, int nk, const KeyFn& kf, float (&m)[G], float (&l)[G], float (&o)[G], int lane) {
    for (int base = 0; base < nk; base += 64) {
        const int i = base + lane;
        long off = 0; float s[G], p[G];
#pragma unroll
        for (int g = 0; g < G; ++g) s[g] = 0.f;
        bool valid = false;
        if (i < nk) valid = kf(i, off, s);
        const LAS float* qo = qs; asm volatile("" : "+v"(qo));
        if (valid) dot64<G>(K + off, qo, s);
        const unsigned long long mask = __ballot(valid);
        if (mask == 0ull) continue;
#pragma unroll
        for (int g = 0; g < G; ++g) {
            const float sv = valid ? s[g] : -1e30f;
            const float mn = fmaxf(m[g], wave_max(sv));
            const float scl = exp2f(m[g] - mn);
            p[g] = valid ? exp2f(sv - mn) : 0.f;
            l[g] = l[g] * scl + wave_sum(p[g]); o[g] *= scl; m[g] = mn;
        }
#pragma unroll 2
        for (int j = 0; j < 64; ++j) {
            if (!((mask >> j) & 1ull)) continue;
            const unsigned olo = __builtin_amdgcn_readlane((unsigned)(unsigned long long)off, j), ohi = __builtin_amdgcn_readlane((unsigned)((unsigned long long)off >> 32), j);
            const long oj = (long)(((unsigned long long)ohi << 32) | olo);
            const float v = ld_elem(V + oj + lane);
#pragma unroll
            for (int g = 0; g < G; ++g) o[g] += __uint_as_float(__builtin_amdgcn_readlane(__float_as_uint(p[g]), j)) * v;
        }
    }
}

struct KeyA { int p, r; const float* bias; __device__ __forceinline__ bool operator()(int i, long& off, float (&b)[1]) const {
    const int row = p - r * i; if (row < 0) return false; off = (long)row * NINP; const int d = r * i; b[0] = bias[d < BIASLEN ? d : BIASLEN - 1]; return true; } };
struct KeyB { int p; __device__ __forceinline__ bool operator()(int i, long& off, float (&b)[2]) const {
    const int row = p - i; if (row < 0) return false; off = (long)row * NINP; return true; } };
struct KeyW { int p; const float* bias; __device__ __forceinline__ bool operator()(int i, long& off, float (&b)[4]) const {
    const int row = p - i; if (row < 0) return false; off = (long)row * NINP;
#pragma unroll
    for (int g = 0; g < 4; ++g) b[g] = bias[g * BIASLEN + i]; return true; } };

__device__ __forceinline__ void load_q(const bf16* q, LAS float* qs, int lane) { qs[lane] = bf2f(q[lane]); }

__device__ __forceinline__ void p2_token_attention(Frame& F, int layer, const bf16* PROJ, bf16* MIXED, bf16* OWIN) {
    LAS float* qs = (LAS float*)(F.lds + F.wave * 2048);
    const int gw = F.vcu * NWAVES + F.wave, NGW = F.G * NWAVES, lane = F.lane;
    const float* bias2 = (const float*)(F.ws + WS_BIAS);
    for (int it = gw; it < S * 4; it += NGW) {
        const int p = it >> 2, h = it & 3;
        load_q(PROJ + (size_t)p * NINP + C_AQ + h * 64, qs, lane); LDS_WAIT(); asm volatile("" ::: "memory");
        float m[1] = {-1e30f}, l[1] = {0.f}, o[1] = {0.f};
        const bf16* K = PROJ + C_AK + h * 64; const bf16* V = PROJ + C_AV + h * 64;
#pragma unroll 1
        for (int c = 0; c < 3; ++c) { const int r = c == 0 ? 1 : (c == 1 ? 4 : 16); KeyA kf{p, r, bias2 + h * BIASLEN}; wave_attend<1>(K, V, qs, 129, kf, m, l, o, lane); }
        MIXED[(size_t)p * DM + h * 64 + lane] = (bf16)f2bf(o[0] / l[0]);
        LDS_WAIT(); asm volatile("" ::: "memory");
    }
    for (int it = gw; it < S * 2; it += NGW) {
        const int p = it >> 1, kvh = it & 1;
        load_q(PROJ + (size_t)p * NINP + C_BQ + (2 * kvh) * 64, qs, lane); load_q(PROJ + (size_t)p * NINP + C_BQ + (2 * kvh + 1) * 64, qs + 64, lane); LDS_WAIT(); asm volatile("" ::: "memory");
        float m[2] = {-1e30f, -1e30f}, l[2] = {0.f, 0.f}, o[2] = {0.f, 0.f};
        KeyB kf{p}; wave_attend<2>(PROJ + C_BK + kvh * 64, PROJ + C_BV + kvh * 64, qs, 128, kf, m, l, o, lane);
#pragma unroll
        for (int g = 0; g < 2; ++g) { const float sk = F.in[I_SINK][layer * 4 + 2 * kvh + g] * LOG2E; const float mn = fmaxf(m[g], sk); const float scl = exp2f(m[g] - mn);
            const float den = l[g] * scl + exp2f(sk - mn); MIXED[(size_t)p * DM + 256 + (2 * kvh + g) * 64 + lane] = (bf16)f2bf(o[g] * scl / den); }
        LDS_WAIT(); asm volatile("" ::: "memory");
    }
    for (int it = gw; it < S * 2; it += NGW) {
        const int p = it >> 1, kvh = it & 1;
#pragma unroll
        for (int g = 0; g < 4; ++g) load_q(PROJ + (size_t)p * NINP + C_CQ + (4 * kvh + g) * 64, qs + g * 64, lane);
        LDS_WAIT(); asm volatile("" ::: "memory");
        float m[4] = {-1e30f, -1e30f, -1e30f, -1e30f}, l[4] = {0.f, 0.f, 0.f, 0.f}, o[4] = {0.f, 0.f, 0.f, 0.f};
        KeyW kf{p, bias2 + (4 + 4 * kvh) * BIASLEN}; wave_attend<4>(PROJ + C_CKW + kvh * 64, PROJ + C_CVW + kvh * 64, qs, 512, kf, m, l, o, lane);
#pragma unroll
        for (int g = 0; g < 4; ++g) OWIN[(size_t)p * 512 + (4 * kvh + g) * 64 + lane] = (bf16)f2bf(o[g] / l[g]);
        LDS_WAIT(); asm volatile("" ::: "memory");
    }
}

__device__ __forceinline__ float gelu_tanh(float x) { const float u = 0.7978845608028654f * (x + 0.044715f * x * x * x); return 0.5f * x * (1.0f + tanhf(u)); }
__device__ __forceinline__ void p2_compress(Frame& F, int layer, const bf16* PROJ) {
    LAS float* flat = (LAS float*)F.lds;
    LAS float* hid = flat + 8 * 2048;
    const int tid = F.tid;
    for (int it = F.vcu; it < 2 * 256; it += F.G) {
        const int kv = it >> 8, rg = it & 255;
        const float* pos = F.in[I_CPOS] + ((size_t)layer * 2 + kv) * 2048;
        const float* w1 = F.in[I_CW1] + ((size_t)layer * 2 + kv) * 2048 * 256;
        const float* w2 = F.in[I_CW2] + ((size_t)layer * 2 + kv) * 256 * 64;
        float* outp = (float*)(F.ws + (kv ? WS_VC : WS_KC));
        __syncthreads();
        for (int e = tid; e < 8 * 2048; e += NTHREADS) {
            const int r = e >> 11, f = e & 2047, R = rg * 8 + r, i = R >> 1, hk = R & 1, t = f >> 6, d = f & 63;
            float v = 0.f;
            if (i < NCMP) v = bf2f(PROJ[(size_t)(16 * i + t) * NINP + (kv ? C_CVC : C_CKC) + hk * 64 + d]) + pos[f];
            flat[e] = v;
        }
        __syncthreads();
        { const int j = tid & 255, half = tid >> 8; float a[4] = {0.f, 0.f, 0.f, 0.f}; const LAS float* fl = flat + half * 4 * 2048;
#pragma unroll 4
            for (int f = 0; f < 2048; ++f) { const float w = w1[(size_t)f * 256 + j];
#pragma unroll
                for (int r = 0; r < 4; ++r) a[r] += fl[r * 2048 + f] * w; }
#pragma unroll
            for (int r = 0; r < 4; ++r) hid[(half * 4 + r) * 256 + j] = gelu_tanh(a[r]); }
        __syncthreads();
        { const int r = tid >> 6, e = tid & 63, R = rg * 8 + r; float a = 0.f;
#pragma unroll 8
            for (int j = 0; j < 256; ++j) a += hid[r * 256 + j] * w2[j * 64 + e];
            if ((R >> 1) < NCMP) { outp[(size_t)R * 64 + e] = a; const unsigned ab = f2bf(a); ((bf16*)(F.ws + (kv ? WS_VCB : WS_KCB)))[(size_t)R * 64 + e] = (bf16)ab;
                const float ar = bf2f((unsigned short)ab); const float n2 = wave_sum(ar * ar);
                if (kv == 0 && e == 0) __hip_atomic_fetch_max((unsigned*)(F.ws + WS_CTL) + CW_MAX + layer * 16 + (R & 1), __float_as_uint(n2), __ATOMIC_RELAXED, __HIP_MEMORY_SCOPE_AGENT); } }
    }
    __syncthreads();
}

struct KeyCmp { int g; __device__ __forceinline__ bool operator()(int i, long& off, float (&b)[4]) const { off = ((long)i * 2 + g) * 64; return true; } };
struct KeySel { int p, blk; const float* bias; __device__ __forceinline__ bool operator()(int i, long& off, float (&b)[4]) const {
    const int kpos = blk * 64 + i; if (kpos > p) return false; off = (long)kpos * NINP; const int d = p - kpos;
#pragma unroll
    for (int g = 0; g < 4; ++g) b[g] = bias[g * BIASLEN + (d < BIASLEN ? d : BIASLEN - 1)]; return true; } };

__device__ __forceinline__ void p3_nsa(Frame& F, int layer, const bf16* PROJ, const bf16* OWIN, bf16* MIXED) {
    LAS float* qs = (LAS float*)(F.lds + F.wave * 8192);
    LAS float* imp = qs + 256;
    const int gw = F.vcu * NWAVES + F.wave, NGW = F.G * NWAVES, lane = F.lane;
    const float* bias2 = (const float*)(F.ws + WS_BIAS);
    const float* KC = (const float*)(F.ws + WS_KC); const float* VC = (const float*)(F.ws + WS_VC);
    for (int it = gw; it < S * 2; it += NGW) {
        const int p = it >> 1, kvh = it & 1;
#pragma unroll
        for (int g = 0; g < 4; ++g) load_q(PROJ + (size_t)p * NINP + C_CQ + (4 * kvh + g) * 64, qs + g * 64, lane);
        for (int e = lane; e < 1040; e += 64) imp[e] = 0.f;
        LDS_WAIT(); asm volatile("" ::: "memory");
        int nv = p >= 31 ? ((p - 31) >> 4) + 1 : 0; if (nv > NCMP) nv = NCMP;
        float m1[4] = {-1e30f, -1e30f, -1e30f, -1e30f}, l1[4] = {0.f, 0.f, 0.f, 0.f}, o1[4] = {0.f, 0.f, 0.f, 0.f};
        { KeyCmp kf{kvh}; wave_attend<4>(KC, VC, qs, nv, kf, m1, l1, o1, lane); }
        for (int base = 0; base < nv; base += 64) { const int i = base + lane;
            const LAS float* qo = qs; asm volatile("" : "+v"(qo));
            if (i < nv) { float s[4] = {0.f, 0.f, 0.f, 0.f}; dot64<4>(KC + ((size_t)i * 2 + kvh) * 64, qo, s); float a = 0.f;
#pragma unroll
                for (int g = 0; g < 4; ++g) a += exp2f(s[g] - m1[g]) / fmaxf(l1[g], 1e-30f);
                imp[1 + i] = a; } }
        LDS_WAIT(); asm volatile("" ::: "memory");
        const int cur = p >> 6;
        float sc[4];
#pragma unroll
        for (int c = 0; c < 4; ++c) { const int j = lane + 64 * c; const LAS float* q = imp + 4 * j;
            const float is = 0.5f * q[0] + q[1] + q[2] + q[3] + 0.5f * q[4];
            const bool forced = (j == 0) || (j == cur) || (j == cur - 1);
            sc[c] = forced ? 1e4f : ((j * 64 <= p) ? is : -1e30f); }
        float m2[4] = {-1e30f, -1e30f, -1e30f, -1e30f}, l2[4] = {0.f, 0.f, 0.f, 0.f}, o2[4] = {0.f, 0.f, 0.f, 0.f};
#pragma unroll 1
        for (int k = 0; k < 16; ++k) {
            float bv = sc[0]; int bi = lane;
#pragma unroll
            for (int c = 1; c < 4; ++c) if (sc[c] > bv) { bv = sc[c]; bi = lane + 64 * c; }
#pragma unroll
            for (int off = 1; off < 64; off <<= 1) { const float ov = __shfl_xor(bv, off); const int oi = __shfl_xor(bi, off); if (ov > bv || (ov == bv && oi < bi)) { bv = ov; bi = oi; } }
#pragma unroll
            for (int c = 0; c < 4; ++c) if (bi == lane + 64 * c) sc[c] = -3e38f;
            if (bi * 64 <= p) { KeySel kf{p, bi, bias2 + (4 + 4 * kvh) * BIASLEN}; wave_attend<4>(PROJ + C_CKS + kvh * 64, PROJ + C_CVS + kvh * 64, qs, 64, kf, m2, l2, o2, lane); }
        }
#pragma unroll
        for (int g = 0; g < 4; ++g) { const int H = 4 * kvh + g;
            const float g0 = bf2f(PROJ[(size_t)p * NINP + C_CG + H * 3 + 0]), g1 = bf2f(PROJ[(size_t)p * NINP + C_CG + H * 3 + 1]), g2 = bf2f(PROJ[(size_t)p * NINP + C_CG + H * 3 + 2]);
            const float ocmp = o1[g] / fmaxf(l1[g], 1e-30f), oslc = o2[g] / l2[g], owin = bf2f(OWIN[(size_t)p * 512 + H * 64 + lane]);
            MIXED[(size_t)p * DM + 512 + H * 64 + lane] = (bf16)f2bf(g0 * ocmp + g1 * oslc + g2 * owin); }
        LDS_WAIT(); asm volatile("" ::: "memory");
    }
}


namespace ba {
typedef short bf16x8 __attribute__((ext_vector_type(8)));
typedef short s16x4 __attribute__((ext_vector_type(4)));
typedef short v4i16_t __attribute__((ext_vector_type(4)));
typedef float f32x16 __attribute__((ext_vector_type(16)));
typedef float f32x2_t __attribute__((ext_vector_type(2))); typedef __bf16 bf16x2_t __attribute__((ext_vector_type(2)));
typedef LAS const char* lds_cptr;
__device__ __forceinline__ unsigned cvtpk(float lo, float hi) { f32x2_t v = {lo, hi}; bf16x2_t b = __builtin_convertvector(v, bf16x2_t); return __builtin_bit_cast(unsigned, b); }
__device__ __forceinline__ s16x4 vtr(lds_cptr p) { return __builtin_bit_cast(s16x4, __builtin_amdgcn_ds_read_tr16_b64_v4i16((LAS v4i16_t*)p)); }
__device__ __forceinline__ float half_sum(float x) { auto rr = __builtin_amdgcn_permlane32_swap(__float_as_uint(x), __float_as_uint(x), false, false); return __uint_as_float(rr[0]) + __uint_as_float(rr[1]); }
constexpr int KIMG = 0, VIMG = 49152, TBL = 98304, WSCR = 108544, KMAX = 110592;

struct Unit {
    const bf16* Q; const bf16* K; const bf16* V;
    bf16* O; int opitch;
    float* lse; int lse_pitch;
    const float* bias;
    const float* bmax;
    const float* sink;
    int rs, rho, u0;
    int W, Wp;
};

template <int NT, int NH>
__device__ __forceinline__ void run_unit(LAS unsigned char* lds, const Unit& U, int wave, int lane, int tid) {
    static_assert(NT * NH == 8, "one wave-task per wave");
    const int r32 = lane & 31, hi = lane >> 5;
    const int NQ = 32 * NT, NKT = U.Wp + NQ, nch = (NKT + 383) / 384, CH = NKT / nch;
    const int tile = wave % NT, hl = wave / NT, uw = U.u0 + 32 * tile;
    const int TW = U.Wp + 64;
    __syncthreads();
    for (int e = tid; e < NH * TW; e += NTHREADS) { const int h = e / TW, dist = e % TW - 32;
        float v = -1e30f; if (dist >= 0 && dist <= U.W) { v = 0.f; if (U.bias) { const int td = dist * U.rs; v = U.bias[h * BIASLEN + (td < BIASLEN ? td : BIASLEN - 1)]; } }
        ((LAS float*)(lds + TBL))[e] = v; }
    if (tid == 0) *(LAS unsigned*)(lds + KMAX) = 0u;
    __syncthreads();
    { float mx = 0.f;
      for (int idx = tid; idx < NKT * 8; idx += NTHREADS) { const int n = idx >> 3, c = idx & 7, u = U.u0 - U.Wp + n; float s = 0.f;
          if (u >= 0) { const v4u w = *(const v4u*)(U.K + (size_t)(U.rho + U.rs * u) * NINP + c * 8);
              const float a0 = bflo(w.x), a1 = bfhi(w.x), a2 = bflo(w.y), a3 = bfhi(w.y), a4 = bflo(w.z), a5 = bfhi(w.z), a6 = bflo(w.w), a7 = bfhi(w.w);
              s = a0 * a0 + a1 * a1 + a2 * a2 + a3 * a3 + a4 * a4 + a5 * a5 + a6 * a6 + a7 * a7; }
          s += __shfl_xor(s, 1); s += __shfl_xor(s, 2); s += __shfl_xor(s, 4); mx = fmaxf(mx, s); }
      mx = wave_max(mx);
      if (lane == 0) __hip_atomic_fetch_max((LAS unsigned*)(lds + KMAX), __float_as_uint(mx), __ATOMIC_RELAXED, __HIP_MEMORY_SCOPE_WORKGROUP); }
    const int qtok = U.rho + U.rs * (uw + r32);
    bf16x8 qr[4]; float qn = 0.f;
    { const bf16* qp = U.Q + (size_t)qtok * NINP + hl * 64 + hi * 8;
#pragma unroll
      for (int d0 = 0; d0 < 4; ++d0) { qr[d0] = *(const bf16x8*)(qp + d0 * 16);
#pragma unroll
          for (int j = 0; j < 8; ++j) { const float x = bf2f((unsigned short)qr[d0][j]); qn += x * x; } }
      qn = half_sum(qn); }
    __syncthreads();
    const float kmax2 = __uint_as_float(*(LAS unsigned*)(lds + KMAX));
    float M = sqrtf(qn * kmax2) * 1.0002f + 1e-6f;
    if (U.bmax) M += fmaxf(U.bmax[hl], 0.f);
    float sink2 = 0.f; if (U.sink) { sink2 = U.sink[hl] * LOG2E; M = fmaxf(M, sink2); }
    f32x16 negm;
#pragma unroll
    for (int r = 0; r < 16; ++r) negm[r] = -M;
    f32x16 o0 = {}, o1 = {}; float lsum = 0.f;
    const LAS float* tbl = (const LAS float*)(lds + TBL) + hl * TW;
    for (int ck = 0; ck < nch; ++ck) {
        const int kc0 = U.u0 - U.Wp + ck * CH;
        if (ck > 0) __syncthreads();
        for (int idx = tid; idx < CH * 16; idx += NTHREADS) { const int n = idx >> 4, isv = (idx >> 3) & 1, c = idx & 7, u = kc0 + n;
            v4u w = {0u, 0u, 0u, 0u};
            if (u >= 0) w = *(const v4u*)((isv ? U.V : U.K) + (size_t)(U.rho + U.rs * u) * NINP + c * 8);
            if (isv) *(LAS v4u*)(lds + VIMG + (c >> 2) * (CH * 64) + n * 64 + (c & 3) * 16) = w;
            else     *(LAS v4u*)(lds + KIMG + c * (CH * 16) + n * 16) = w; }
        __syncthreads();
        const int nbt = U.Wp / 32 + 1;
        for (int t = 0; t < nbt; ++t) {
            const int kt0 = uw - U.Wp + 32 * t, kl = kt0 - kc0;
            if (kt0 < 0 || kl < 0 || kl >= CH) continue;
            f32x16 s;
            { const lds_cptr kb = (lds_cptr)(lds + KIMG) + hi * (CH * 16) + (kl + r32) * 16;
#pragma unroll
              for (int d0 = 0; d0 < 4; ++d0) { const bf16x8 kf = *(const LAS bf16x8*)(kb + d0 * (2 * CH * 16));
                  s = __builtin_amdgcn_mfma_f32_32x32x16_bf16(kf, qr[d0], d0 == 0 ? negm : s, 0, 0, 0); } }
            { const LAS float* tb = tbl + (U.Wp - 32 * t) + r32 - 4 * hi + 32 - 27;
#pragma unroll
              for (int r = 0; r < 16; ++r) s[r] = __builtin_amdgcn_exp2f(s[r] + tb[27 - ((r & 3) + 8 * (r >> 2))]); }
            float ps = 0.f;
#pragma unroll
            for (int r = 0; r < 16; ++r) ps += s[r];
            lsum += ps;
            bf16x8 pa0, pa1;
            { v4u w0 = {cvtpk(s[0], s[1]), cvtpk(s[2], s[3]), cvtpk(s[4], s[5]), cvtpk(s[6], s[7])}, w1 = {cvtpk(s[8], s[9]), cvtpk(s[10], s[11]), cvtpk(s[12], s[13]), cvtpk(s[14], s[15])};
              pa0 = __builtin_bit_cast(bf16x8, w0); pa1 = __builtin_bit_cast(bf16x8, w1); }
            { const lds_cptr vp = (lds_cptr)(lds + VIMG) + ((lane >> 4) & 1) * 32 + (lane & 3) * 8 + (kl + 4 * hi + ((lane & 15) >> 2)) * 64;
#pragma unroll
              for (int dh = 0; dh < 2; ++dh)
#pragma unroll
                  for (int g = 0; g < 2; ++g) { const s16x4 lo = vtr(vp + dh * (CH * 64) + g * 1024), hv = vtr(vp + dh * (CH * 64) + g * 1024 + 512);
                      const bf16x8 vf = {lo[0], lo[1], lo[2], lo[3], hv[0], hv[1], hv[2], hv[3]};
                      if (dh == 0) o0 = __builtin_amdgcn_mfma_f32_32x32x16_bf16(g == 0 ? pa0 : pa1, vf, o0, 0, 0, 0);
                      else         o1 = __builtin_amdgcn_mfma_f32_32x32x16_bf16(g == 0 ? pa0 : pa1, vf, o1, 0, 0, 0); } }
        }
    }
    float l = half_sum(lsum);
    if (U.sink) l += exp2f(sink2 - M);
    LAS float* wsf = (LAS float*)(lds + WSCR) + wave * 64;
    if (hi == 0) wsf[r32] = 1.0f / l;
    if (U.lse && hi == 0) U.lse[(size_t)qtok * U.lse_pitch + hl] = M + log2f(l);
    LDS_WAIT(); asm volatile("" ::: "memory");
#pragma unroll
    for (int r = 0; r < 16; ++r) { const int qo = (r & 3) + 8 * (r >> 2) + 4 * hi; const float rl = wsf[qo];
        bf16* op = U.O + (size_t)(U.rho + U.rs * (uw + qo)) * U.opitch + hl * 64 + r32;
        op[0] = (bf16)f2bf(o0[r] * rl); op[32] = (bf16)f2bf(o1[r] * rl); }
}
}

constexpr int P2_NA = 3 * 4 * 64, P2_NB = 2 * 128, P2_NC = 2 * 256, P2_NUNITS = P2_NA + P2_NB + P2_NC;
__device__ __forceinline__ void p2_banded(Frame& F, int layer, const bf16* PROJ, bf16* MIXED, bf16* OWIN) {
    const float* bias2 = (const float*)(F.ws + WS_BIAS); const float* bmax = (const float*)(F.ws + WS_BMAX);
    bf16* OA3 = (bf16*)(F.ws + WS_OA3); float* LSE = (float*)(F.ws + WS_LSE);
    for (int it = F.vcu; it < P2_NUNITS; it += F.G) {
        ba::Unit U{};
        if (it < P2_NC) { const int kvh = it & 1, blk = it >> 1;
            U.Q = PROJ + C_CQ + kvh * 256; U.K = PROJ + C_CKW + kvh * 64; U.V = PROJ + C_CVW + kvh * 64; U.O = OWIN + kvh * 256; U.opitch = 512;
            U.bias = bias2 + (4 + 4 * kvh) * BIASLEN; U.bmax = bmax + 4 + 4 * kvh; U.rs = 1; U.rho = 0; U.u0 = blk * 64; U.W = 511; U.Wp = 512;
            ba::run_unit<2, 4>(F.lds, U, F.wave, F.lane, F.tid);
        } else if (it < P2_NC + P2_NA) { const int a = it - P2_NC, h = a & 3, c = (a >> 2) % 3, blk = (a >> 2) / 3;
            const int rs = c == 0 ? 1 : (c == 1 ? 4 : 16), per = S / rs / 256;
            const int rho = blk / per, ub = blk % per;
            U.Q = PROJ + C_AQ + h * 64; U.K = PROJ + C_AK + h * 64; U.V = PROJ + C_AV + h * 64; U.O = OA3 + (size_t)c * S * 256 + h * 64; U.opitch = 256;
            U.lse = LSE + (size_t)c * S * 4 + h; U.lse_pitch = 4;
            U.bias = bias2 + h * BIASLEN; U.bmax = bmax + h; U.rs = rs; U.rho = rho; U.u0 = ub * 256; U.W = 128; U.Wp = 128;
            ba::run_unit<8, 1>(F.lds, U, F.wave, F.lane, F.tid);
        } else { const int b = it - P2_NC - P2_NA, kvh = b & 1, blk = b >> 1;
            U.Q = PROJ + C_BQ + kvh * 128; U.K = PROJ + C_BK + kvh * 64; U.V = PROJ + C_BV + kvh * 64; U.O = MIXED + 256 + kvh * 128; U.opitch = DM;
            U.sink = F.in[I_SINK] + layer * 4 + 2 * kvh; U.rs = 1; U.rho = 0; U.u0 = blk * 128; U.W = 127; U.Wp = 128;
            ba::run_unit<4, 2>(F.lds, U, F.wave, F.lane, F.tid);
        }
    }
    __syncthreads();
}
__device__ __forceinline__ void merge_dilated(Frame& F, bf16* MIXED) {
    const bf16* OA3 = (const bf16*)(F.ws + WS_OA3); const float* LSE = (const float*)(F.ws + WS_LSE);
    const int gw = F.vcu * NWAVES + F.wave, NGW = F.G * NWAVES, lane = F.lane, h = lane >> 4;
    for (int p = gw; p < S; p += NGW) {
        const float l0 = LSE[(size_t)p * 4 + h], l1 = LSE[(size_t)(S + p) * 4 + h], l2 = LSE[(size_t)(2 * S + p) * 4 + h];
        const float mx = fmaxf(l0, fmaxf(l1, l2)); const float e0 = exp2f(l0 - mx), e1 = exp2f(l1 - mx), e2 = exp2f(l2 - mx), inv = 1.0f / (e0 + e1 + e2);
        const v2u a = *(const v2u*)(OA3 + (size_t)p * 256 + lane * 4), b = *(const v2u*)(OA3 + (size_t)(S + p) * 256 + lane * 4), c = *(const v2u*)(OA3 + (size_t)(2 * S + p) * 256 + lane * 4);
        const float w0 = e0 * inv, w1 = e1 * inv, w2 = e2 * inv;
        const float r0 = w0 * bflo(a.x) + w1 * bflo(b.x) + w2 * bflo(c.x), r1 = w0 * bfhi(a.x) + w1 * bfhi(b.x) + w2 * bfhi(c.x);
        const float r2 = w0 * bflo(a.y) + w1 * bflo(b.y) + w2 * bflo(c.y), r3 = w0 * bfhi(a.y) + w1 * bfhi(b.y) + w2 * bfhi(c.y);
        *(v2u*)(MIXED + (size_t)p * DM + lane * 4) = (v2u){pk2(r0, r1), pk2(r2, r3)};
    }
}


namespace ca {
using ba::bf16x8; using ba::s16x4; using ba::f32x16; using ba::lds_cptr; using ba::cvtpk; using ba::vtr; using ba::half_sum;
constexpr int CH = 256, KIMG = 0, VIMG = 32768, IMPSEL = 65536, IMPQ = 264  , IMPW = 8 * IMPQ * 4  , WSCR = IMPSEL + 8 * IMPW;
static_assert(WSCR + 8 * 512 <= RING_BYTES, "P3a LDS map");
__device__ __forceinline__ float quad_sum(float x) {
    x += __int_as_float(__builtin_amdgcn_update_dpp(0, __float_as_int(x), 0xB1, 0xF, 0xF, true));
    x += __int_as_float(__builtin_amdgcn_update_dpp(0, __float_as_int(x), 0x4E, 0xF, 0xF, true));
    return x;
}
__device__ __forceinline__ void stage_chunk(LAS unsigned char* lds, const bf16* KCb, const bf16* VCb, int kvh, int kc0, bool with_v, int tid) {
    for (int idx = tid; idx < CH * 16; idx += NTHREADS) { const int n = idx >> 4, isv = (idx >> 3) & 1, c = idx & 7, i = kc0 + n;
        if (isv && !with_v) continue;
        v4u w = {0u, 0u, 0u, 0u};
        if (i < NCMP) w = *(const v4u*)((isv ? VCb : KCb) + ((size_t)i * 2 + kvh) * 64 + c * 8);
        if (isv) *(LAS v4u*)(lds + VIMG + (c >> 2) * (CH * 64) + n * 64 + (c & 3) * 16) = w;
        else     *(LAS v4u*)(lds + KIMG + c * (CH * 16) + n * 16) = w; }
}
__device__ __forceinline__ void run_unit(LAS unsigned char* lds, const bf16* PROJ, const bf16* KCb, const bf16* VCb, float kcmax2, bf16* OCMP, unsigned* SELB, int kvh, int cur, int wave, int lane, int tid) {
    const int r32 = lane & 31, hi = lane >> 5, p0 = cur * 64;
    const int ql = r32 >> 2, hh = r32 & 3, qpos = p0 + wave * 8 + ql, H = 4 * kvh + hh;
    int nvq = qpos >= 31 ? ((qpos - 31) >> 4) + 1 : 0; if (nvq > NCMP) nvq = NCMP;
    int nvw = (p0 + wave * 8 + 7) >= 31 ? ((p0 + wave * 8 + 7 - 31) >> 4) + 1 : 0; if (nvw > NCMP) nvw = NCMP;
    int nvu = (p0 + 63 - 31) >= 0 ? ((p0 + 63 - 31) >> 4) + 1 : 0; if (nvu > NCMP) nvu = NCMP;
    const int nch = (nvu + CH - 1) / CH;
    bf16x8 qr[4]; float qn = 0.f;
    { const bf16* qp = PROJ + (size_t)qpos * NINP + C_CQ + H * 64 + hi * 8;
#pragma unroll
      for (int d0 = 0; d0 < 4; ++d0) { qr[d0] = *(const bf16x8*)(qp + d0 * 16);
#pragma unroll
          for (int j = 0; j < 8; ++j) { const float x = bf2f((unsigned short)qr[d0][j]); qn += x * x; } }
      qn = half_sum(qn); }
    const float M = sqrtf(qn * kcmax2) * 1.0002f + 1e-6f;
    f32x16 negm;
#pragma unroll
    for (int r = 0; r < 16; ++r) negm[r] = -M;
    LAS float* imps = (LAS float*)(lds + IMPSEL + wave * IMPW);
    __syncthreads();
    for (int e = lane; e < 8 * IMPQ; e += 64) imps[e] = 0.f;
    float lsum = 0.f;
    for (int ck = 0; ck < nch; ++ck) {
        if (ck > 0) __syncthreads();
        stage_chunk(lds, KCb, VCb, kvh, ck * CH, false, tid);
        __syncthreads();
        for (int kl = 0; kl < CH; kl += 32) { const int kt0 = ck * CH + kl; if (kt0 >= nvw) break;
            f32x16 s;
            { const lds_cptr kb = (lds_cptr)(lds + KIMG) + hi * (CH * 16) + (kl + r32) * 16;
#pragma unroll
              for (int d0 = 0; d0 < 4; ++d0) { const bf16x8 kf = *(const LAS bf16x8*)(kb + d0 * (2 * CH * 16)); s = __builtin_amdgcn_mfma_f32_32x32x16_bf16(kf, qr[d0], d0 == 0 ? negm : s, 0, 0, 0); } }
            const int lim = nvq - kt0 - 4 * hi;
#pragma unroll
            for (int r = 0; r < 16; ++r) lsum += ((r & 3) + 8 * (r >> 2)) < lim ? __builtin_amdgcn_exp2f(s[r]) : 0.f; }
    }
    const float rinv = 1.0f / fmaxf(half_sum(lsum), 1e-30f);
    f32x16 o0 = {}, o1 = {};
    for (int ck = 0; ck < nch; ++ck) {
        __syncthreads();
        stage_chunk(lds, KCb, VCb, kvh, ck * CH, true, tid);
        __syncthreads();
        for (int kl = 0; kl < CH; kl += 32) { const int kt0 = ck * CH + kl; if (kt0 >= nvw) break;
            f32x16 s;
            { const lds_cptr kb = (lds_cptr)(lds + KIMG) + hi * (CH * 16) + (kl + r32) * 16;
#pragma unroll
              for (int d0 = 0; d0 < 4; ++d0) { const bf16x8 kf = *(const LAS bf16x8*)(kb + d0 * (2 * CH * 16)); s = __builtin_amdgcn_mfma_f32_32x32x16_bf16(kf, qr[d0], d0 == 0 ? negm : s, 0, 0, 0); } }
            const int lim = nvq - kt0 - 4 * hi;
#pragma unroll
            for (int r = 0; r < 16; ++r) s[r] = ((r & 3) + 8 * (r >> 2)) < lim ? __builtin_amdgcn_exp2f(s[r]) * rinv : 0.f;
            { float mains[4], spills[4];
#pragma unroll
              for (int a = 0; a < 4; ++a) { const float x0 = quad_sum(s[4 * a]), x1 = quad_sum(s[4 * a + 1]), x2 = quad_sum(s[4 * a + 2]), x3 = quad_sum(s[4 * a + 3]);
                  spills[a] = 0.5f * x3; mains[a] = ((x0 + x1) + x2) + spills[a]; }
              const float mn = hh == 0 ? mains[0] : (hh == 1 ? mains[1] : (hh == 2 ? mains[2] : mains[3]));
              const float sp = hh == 0 ? spills[0] : (hh == 1 ? spills[1] : (hh == 2 ? spills[2] : spills[3]));
              const int j = (kt0 >> 2) + 2 * hh + hi;
              __hip_atomic_fetch_add(imps + ql * IMPQ + j, mn, __ATOMIC_RELAXED, __HIP_MEMORY_SCOPE_WORKGROUP);
              __hip_atomic_fetch_add(imps + ql * IMPQ + j + 1, sp, __ATOMIC_RELAXED, __HIP_MEMORY_SCOPE_WORKGROUP); }
            bf16x8 pa0, pa1;
            { v4u w0 = {cvtpk(s[0], s[1]), cvtpk(s[2], s[3]), cvtpk(s[4], s[5]), cvtpk(s[6], s[7])}, w1 = {cvtpk(s[8], s[9]), cvtpk(s[10], s[11]), cvtpk(s[12], s[13]), cvtpk(s[14], s[15])};
              pa0 = __builtin_bit_cast(bf16x8, w0); pa1 = __builtin_bit_cast(bf16x8, w1); }
            { const lds_cptr vp = (lds_cptr)(lds + VIMG) + ((lane >> 4) & 1) * 32 + (lane & 3) * 8 + (kl + 4 * hi + ((lane & 15) >> 2)) * 64;
#pragma unroll
              for (int dh = 0; dh < 2; ++dh)
#pragma unroll
                  for (int g = 0; g < 2; ++g) { const s16x4 lo = vtr(vp + dh * (CH * 64) + g * 1024), hv = vtr(vp + dh * (CH * 64) + g * 1024 + 512);
                      const bf16x8 vf = {lo[0], lo[1], lo[2], lo[3], hv[0], hv[1], hv[2], hv[3]};
                      if (dh == 0) o0 = __builtin_amdgcn_mfma_f32_32x32x16_bf16(g == 0 ? pa0 : pa1, vf, o0, 0, 0, 0);
                      else         o1 = __builtin_amdgcn_mfma_f32_32x32x16_bf16(g == 0 ? pa0 : pa1, vf, o1, 0, 0, 0); } }
        }
    }
#pragma unroll
    for (int r = 0; r < 16; ++r) { const int c = (r & 3) + 8 * (r >> 2) + 4 * hi;
        bf16* op = OCMP + (size_t)(p0 + wave * 8 + (c >> 2)) * 512 + (4 * kvh + (c & 3)) * 64 + r32;
        op[0] = (bf16)f2bf(o0[r]); op[32] = (bf16)f2bf(o1[r]); }
    LDS_WAIT(); asm volatile("" ::: "memory");
#pragma unroll 1
    for (int q = 0; q < 8; ++q) { const int qp = p0 + wave * 8 + q; const LAS float* im = imps + q * IMPQ;
        float sc[4];
#pragma unroll
        for (int c = 0; c < 4; ++c) { const int j = lane + 64 * c; const bool forced = (j == 0) || (j == cur) || (j == cur - 1); sc[c] = forced ? 1e4f : ((j * 64 <= qp) ? im[j] : -1e30f); }
        unsigned bits = 0u;
#pragma unroll 1
        for (int k = 0; k < 16; ++k) {
            float bv = sc[0]; int bi = lane;
#pragma unroll
            for (int c = 1; c < 4; ++c) if (sc[c] > bv) { bv = sc[c]; bi = lane + 64 * c; }
#pragma unroll
            for (int off = 1; off < 64; off <<= 1) { const float ov = __shfl_xor(bv, off); const int oi = __shfl_xor(bi, off); if (ov > bv || (ov == bv && oi < bi)) { bv = ov; bi = oi; } }
#pragma unroll
            for (int c = 0; c < 4; ++c) if (bi == lane + 64 * c) sc[c] = -3e38f;
            if (bi * 64 <= qp && lane == (bi >> 5)) bits |= 1u << (bi & 31);
        }
        if (lane < 8) SELB[((size_t)qp * 2 + kvh) * 8 + lane] = bits;
    }
}
}

__device__ __forceinline__ void p3a_cmp_select(Frame& F, int layer, const bf16* PROJ) {
    const bf16* KCb = (const bf16*)(F.ws + WS_KCB); const bf16* VCb = (const bf16*)(F.ws + WS_VCB);
    bf16* OCMP = (bf16*)(F.ws + WS_OCMP); unsigned* SELB = (unsigned*)(F.ws + WS_SELB);
    const unsigned* mx = (const unsigned*)(F.ws + WS_CTL) + CW_MAX + layer * 16;
    for (int k = F.vcu; k < 256; k += F.G) for (int rep = 0; rep < 2; ++rep) { const int x = rep == 0 ? 511 - k : k;
        const int kvh = x & 1, cur = x >> 1;
        const float kcmax2 = __uint_as_float(__hip_atomic_load(mx + kvh, __ATOMIC_RELAXED, __HIP_MEMORY_SCOPE_AGENT));
        ca::run_unit(F.lds, PROJ, KCb, VCb, kcmax2, OCMP, SELB, kvh, cur, F.wave, F.lane, F.tid); }
    __syncthreads();
}

__device__ __forceinline__ void p3b_naive(Frame& F, int layer, const bf16* PROJ, const bf16* OWIN, bf16* MIXED) {
    LAS float* qs = (LAS float*)(F.lds + F.wave * 2048);
    const int gw = F.vcu * NWAVES + F.wave, NGW = F.G * NWAVES, lane = F.lane;
    const float* bias2 = (const float*)(F.ws + WS_BIAS);
    const bf16* OCMP = (const bf16*)(F.ws + WS_OCMP); const unsigned* SELB = (const unsigned*)(F.ws + WS_SELB);
    for (int it = gw; it < S * 2; it += NGW) {
        const int p = it >> 1, kvh = it & 1;
#pragma unroll
        for (int g = 0; g < 4; ++g) load_q(PROJ + (size_t)p * NINP + C_CQ + (4 * kvh + g) * 64, qs + g * 64, lane);
        LDS_WAIT(); asm volatile("" ::: "memory");
        float m2[4] = {-1e30f, -1e30f, -1e30f, -1e30f}, l2[4] = {0.f, 0.f, 0.f, 0.f}, o2[4] = {0.f, 0.f, 0.f, 0.f};
#pragma unroll 1
        for (int w = 0; w < 8; ++w) { unsigned bits = SELB[((size_t)p * 2 + kvh) * 8 + w];
            while (bits) { const int b = __builtin_ctz(bits); bits &= bits - 1; const int bi = w * 32 + b;
                KeySel kf{p, bi, bias2 + (4 + 4 * kvh) * BIASLEN}; wave_attend<4>(PROJ + C_CKS + kvh * 64, PROJ + C_CVS + kvh * 64, qs, 64, kf, m2, l2, o2, lane); } }
#pragma unroll
        for (int g = 0; g < 4; ++g) { const int H = 4 * kvh + g;
            const float g0 = bf2f(PROJ[(size_t)p * NINP + C_CG + H * 3 + 0]), g1 = bf2f(PROJ[(size_t)p * NINP + C_CG + H * 3 + 1]), g2 = bf2f(PROJ[(size_t)p * NINP + C_CG + H * 3 + 2]);
            const float ocmp = bf2f(OCMP[(size_t)p * 512 + H * 64 + lane]), oslc = o2[g] / l2[g], owin = bf2f(OWIN[(size_t)p * 512 + H * 64 + lane]);
            MIXED[(size_t)p * DM + 512 + H * 64 + lane] = (bf16)f2bf(g0 * ocmp + g1 * oslc + g2 * owin); }
        LDS_WAIT(); asm volatile("" ::: "memory");
    }
}


namespace sa {
using ba::bf16x8; using ba::s16x4; using ba::lds_cptr; using ba::cvtpk; using ba::vtr;
typedef float f32x4v __attribute__((ext_vector_type(4)));
constexpr int SLOTB = 16384, BT = 32768, BTH = 1540  , BM = BT + 4 * BTH * 4, LDS_END = BM + 2048;
static_assert(LDS_END <= RING_BYTES, "P3b LDS map");
__device__ __forceinline__ void run_unit(LAS unsigned char* lds, const bf16* PROJ, const float* bias2, const float* bmax, float ksmax2, const bf16* OCMP, const bf16* OWIN,
                                         const unsigned* SELB, bf16* MIXED, int kvh, int cur, int wave, int lane, int tid) {
    const int p0 = cur * 64, col = lane & 15, g = lane >> 4, qq = col >> 2, hh = col & 3, H = 4 * kvh + hh;
    __syncthreads();
    for (int e = tid; e < 4 * BTH; e += NTHREADS) { const int h = e / BTH, i = e % BTH; int d = i - 3; d = d < 0 ? 0 : (d > 1535 ? 1535 : d);
        ((LAS float*)(lds + BT))[e] = bias2[(4 + 4 * kvh + h) * BIASLEN + d]; }
    ((LAS unsigned*)(lds + BM))[tid] = SELB[((size_t)(p0 + (tid >> 3)) * 2 + kvh) * 8 + (tid & 7)];
    const bf16* Kg = PROJ + C_CKS + kvh * 64; const bf16* Vg = PROJ + C_CVS + kvh * 64;
    v4u pre[2];
#define SA_LOAD(j) do { _Pragma("unroll") for (int i_ = 0; i_ < 2; ++i_) { const int idx_ = tid + i_ * NTHREADS, n_ = idx_ >> 4, isv_ = (idx_ >> 3) & 1, c_ = idx_ & 7; \
        pre[i_] = *(const v4u*)((isv_ ? Vg : Kg) + (size_t)((j) * 64 + n_) * NINP + c_ * 8); } } while (0)
#define SA_WRITE(slot) do { _Pragma("unroll") for (int i_ = 0; i_ < 2; ++i_) { const int idx_ = tid + i_ * NTHREADS, n_ = idx_ >> 4, isv_ = (idx_ >> 3) & 1, c_ = idx_ & 7; \
        if (isv_) *(LAS v4u*)(lds + (slot) * SLOTB + 8192 + (c_ >> 1) * 2048 + n_ * 32 + (c_ & 1) * 16) = pre[i_]; \
        else      *(LAS v4u*)(lds + (slot) * SLOTB + c_ * 1024 + n_ * 16) = pre[i_]; } } while (0)
    SA_LOAD(0); SA_WRITE(0);
    __syncthreads();
    bf16x8 qf[2][2]; f32x4v negm[2]; unsigned cgm[2]; int qpos[2];
#pragma unroll
    for (int cg = 0; cg < 2; ++cg) {
        const int ql = wave * 8 + cg * 4 + qq; qpos[cg] = p0 + ql;
        const bf16* qp = PROJ + (size_t)qpos[cg] * NINP + C_CQ + H * 64 + g * 8; float qn = 0.f;
#pragma unroll
        for (int ks = 0; ks < 2; ++ks) { qf[cg][ks] = *(const bf16x8*)(qp + ks * 32);
#pragma unroll
            for (int j = 0; j < 8; ++j) { const float x = bf2f((unsigned short)qf[cg][ks][j]); qn += x * x; } }
        qn += __shfl_xor(qn, 16); qn += __shfl_xor(qn, 32);
        const float M = sqrtf(qn * ksmax2) * 1.0002f + fmaxf(bmax[4 + H], 0.f) + 1e-6f;
        negm[cg] = (f32x4v){-M, -M, -M, -M};
        unsigned m = 0u;
        if (lane < 8) { const LAS unsigned* b = (const LAS unsigned*)(lds + BM) + (wave * 8 + cg * 4) * 8 + lane; m = b[0] | b[8] | b[16] | b[24]; }
        cgm[cg] = m;
    }
    f32x4v oacc[2][4]; float lsum[2] = {0.f, 0.f};
#pragma unroll
    for (int cg = 0; cg < 2; ++cg)
#pragma unroll
        for (int dt = 0; dt < 4; ++dt) oacc[cg][dt] = (f32x4v){0.f, 0.f, 0.f, 0.f};
    const LAS float* bt = (const LAS float*)(lds + BT) + hh * BTH;
    for (int j = 0; j <= cur; ++j) {
        if (j < cur) SA_LOAD(j + 1);
        const LAS unsigned char* slot = lds + (j & 1) * SLOTB;
#pragma unroll
        for (int cg = 0; cg < 2; ++cg) {
            const unsigned word = __builtin_amdgcn_readlane(cgm[cg], j >> 5);
            if (!((word >> (j & 31)) & 1u)) continue;
            const bool mine = (((const LAS unsigned*)(lds + BM))[(wave * 8 + cg * 4 + qq) * 8 + (j >> 5)] >> (j & 31)) & 1u;
            f32x4v s[4];
#pragma unroll
            for (int t = 0; t < 4; ++t) { s[t] = negm[cg];
#pragma unroll
                for (int ks = 0; ks < 2; ++ks) { const bf16x8 kf = *(const LAS bf16x8*)(slot + (4 * ks + g) * 1024 + (16 * t + col) * 16);
                    s[t] = __builtin_amdgcn_mfma_f32_16x16x32_bf16(kf, qf[cg][ks], s[t], 0, 0, 0); } }
            float ps = 0.f;
#pragma unroll
            for (int t = 0; t < 4; ++t) { const int d0 = qpos[cg] - (64 * j + 16 * t + 4 * g); int db = d0 + 3; db = db < 3 ? 3 : (db > 1538 ? 1538 : db);
                const LAS float* tb = bt + db - 3;
#pragma unroll
                for (int e = 0; e < 4; ++e) { const float pv = (mine && d0 - e >= 0) ? __builtin_amdgcn_exp2f(s[t][e] + tb[3 - e]) : 0.f; s[t][e] = pv; ps += pv; } }
            lsum[cg] += ps;
#pragma unroll
            for (int ks2 = 0; ks2 < 2; ++ks2) {
                const v4u pw = {cvtpk(s[2 * ks2][0], s[2 * ks2][1]), cvtpk(s[2 * ks2][2], s[2 * ks2][3]), cvtpk(s[2 * ks2 + 1][0], s[2 * ks2 + 1][1]), cvtpk(s[2 * ks2 + 1][2], s[2 * ks2 + 1][3])};
                const bf16x8 pf = __builtin_bit_cast(bf16x8, pw);
                const lds_cptr vb = (lds_cptr)slot + 8192 + (32 * ks2 + 4 * g + (col >> 2)) * 32 + (col & 3) * 8;
#pragma unroll
                for (int dt = 0; dt < 4; ++dt) { const s16x4 lo = vtr(vb + dt * 2048), hv = vtr(vb + dt * 2048 + 512);
                    const bf16x8 vf = {lo[0], lo[1], lo[2], lo[3], hv[0], hv[1], hv[2], hv[3]};
                    oacc[cg][dt] = __builtin_amdgcn_mfma_f32_16x16x32_bf16(vf, pf, oacc[cg][dt], 0, 0, 0); } }
        }
        if (j < cur) SA_WRITE((j + 1) & 1);
        __syncthreads();
    }
#undef SA_LOAD
#undef SA_WRITE
#pragma unroll
    for (int cg = 0; cg < 2; ++cg) {
        float l = lsum[cg]; l += __shfl_xor(l, 16); l += __shfl_xor(l, 32);
        const float rl = 1.0f / l; const size_t q = (size_t)qpos[cg];
        const float g0 = bf2f(PROJ[q * NINP + C_CG + H * 3 + 0]), g1 = bf2f(PROJ[q * NINP + C_CG + H * 3 + 1]) * rl, g2 = bf2f(PROJ[q * NINP + C_CG + H * 3 + 2]);
#pragma unroll
        for (int dt = 0; dt < 4; ++dt) { const int d = 16 * dt + 4 * g;
            const v2u a = *(const v2u*)(OCMP + q * 512 + H * 64 + d), b = *(const v2u*)(OWIN + q * 512 + H * 64 + d);
            const float r0 = g0 * bflo(a.x) + g1 * oacc[cg][dt][0] + g2 * bflo(b.x), r1 = g0 * bfhi(a.x) + g1 * oacc[cg][dt][1] + g2 * bfhi(b.x);
            const float r2 = g0 * bflo(a.y) + g1 * oacc[cg][dt][2] + g2 * bflo(b.y), r3 = g0 * bfhi(a.y) + g1 * oacc[cg][dt][3] + g2 * bfhi(b.y);
            *(v2u*)(MIXED + q * DM + 512 + H * 64 + d) = (v2u){pk2(r0, r1), pk2(r2, r3)}; }
    }
}
}

__device__ __forceinline__ void p3b_select(Frame& F, int layer, const bf16* PROJ, const bf16* OWIN, bf16* MIXED) {
    const float* bias2 = (const float*)(F.ws + WS_BIAS); const float* bmax = (const float*)(F.ws + WS_BMAX);
    const bf16* OCMP = (const bf16*)(F.ws + WS_OCMP); const unsigned* SELB = (const unsigned*)(F.ws + WS_SELB);
    const unsigned* mx = (const unsigned*)(F.ws + WS_CTL) + CW_MAX + layer * 16;
    for (int k = F.vcu; k < 256; k += F.G) for (int rep = 0; rep < 2; ++rep) { const int x = rep == 0 ? 511 - k : k;
        const int kvh = x & 1, cur = x >> 1;
        const float ksmax2 = __uint_as_float(__hip_atomic_load(mx + 2 + kvh, __ATOMIC_RELAXED, __HIP_MEMORY_SCOPE_AGENT));
        sa::run_unit(F.lds, PROJ, bias2, bmax, ksmax2, OCMP, OWIN, SELB, MIXED, kvh, cur, F.wave, F.lane, F.tid); }
    __syncthreads();
}
__device__ __forceinline__ void p2_kslc_norm(Frame& F, int layer, const bf16* PROJ) {
    const int gt = F.vcu * NTHREADS + F.tid, NGT = F.G * NTHREADS; float m0 = 0.f, m1 = 0.f;
    for (int idx = gt; idx < S * 16; idx += NGT) { const int n = idx >> 3, c = idx & 7, p = n >> 1, kvh = n & 1;
        const v4u w = *(const v4u*)(PROJ + (size_t)p * NINP + C_CKS + kvh * 64 + c * 8);
        const float a0 = bflo(w.x), a1 = bfhi(w.x), a2 = bflo(w.y), a3 = bfhi(w.y), a4 = bflo(w.z), a5 = bfhi(w.z), a6 = bflo(w.w), a7 = bfhi(w.w);
        float s = a0 * a0 + a1 * a1 + a2 * a2 + a3 * a3 + a4 * a4 + a5 * a5 + a6 * a6 + a7 * a7;
        s += __shfl_xor(s, 1); s += __shfl_xor(s, 2); s += __shfl_xor(s, 4);
        if (kvh) m1 = fmaxf(m1, s); else m0 = fmaxf(m0, s); }
    m0 = wave_max(m0); m1 = wave_max(m1);
    if (F.lane == 0) { unsigned* mx = (unsigned*)(F.ws + WS_CTL) + CW_MAX + layer * 16;
        __hip_atomic_fetch_max(mx + 2, __float_as_uint(m0), __ATOMIC_RELAXED, __HIP_MEMORY_SCOPE_AGENT); __hip_atomic_fetch_max(mx + 3, __float_as_uint(m1), __ATOMIC_RELAXED, __HIP_MEMORY_SCOPE_AGENT); }
}


namespace cm {
using ba::bf16x8; using ba::f32x16;
constexpr int AIMG = 0, HIMG = 32768, LDS_END = HIMG + 16384;
__device__ __forceinline__ void run_unit(LAS unsigned char* lds, const bf16* PROJ, const bf16* W1C, const float* posw1, const bf16* W2T, bf16* OUTB, unsigned* maxw,
                                         int kv, int ru, int wave, int lane, int tid) {
    const int r32 = lane & 31, hi = lane >> 5, R0 = ru * 32, ccol = kv ? C_CVC : C_CKC;
    f32x16 acc = {};
    for (int kc = 0; kc < 4; ++kc) {
        __syncthreads();
#pragma unroll
        for (int i_ = 0; i_ < 4; ++i_) { const int idx = tid + i_ * NTHREADS, row = idx >> 6, c = idx & 63; int R = R0 + row; if (R > 2045) R = 2045;
            const v4u w = *(const v4u*)(PROJ + (size_t)(16 * (R >> 1) + 8 * kc + (c >> 3)) * NINP + ccol + (R & 1) * 64 + (c & 7) * 8);
            *(LAS v4u*)(lds + AIMG + c * 512 + row * 16) = w; }
        __syncthreads();
        const bf16* wb = W1C + ((size_t)(kc * 64 + hi) * 256 + wave * 32 + r32) * 8;
#pragma unroll 4
        for (int ks = 0; ks < 32; ++ks) {
            const bf16x8 af = *(const LAS bf16x8*)(lds + AIMG + (2 * ks + hi) * 512 + r32 * 16);
            const bf16x8 bfr = *(const bf16x8*)(wb + (size_t)ks * 2 * 256 * 8);
            acc = __builtin_amdgcn_mfma_f32_32x32x16_bf16(af, bfr, acc, 0, 0, 0); }
    }
    { const int n = wave * 32 + r32; const float pb = posw1[n];
#pragma unroll
      for (int r = 0; r < 16; ++r) { const int row = (r & 3) + 8 * (r >> 2) + 4 * hi; const float x = acc[r] + pb;
          const float u2 = 1.5957691216057308f * (x + 0.044715f * x * x * x); const float gl = x / (1.0f + __expf(-u2));
          *(LAS bf16*)(lds + HIMG + (n >> 3) * 512 + row * 16 + (n & 7) * 2) = (bf16)f2bf(gl); } }
    __syncthreads();
    if (wave == 0) {
        f32x16 o0 = {}, o1 = {};
#pragma unroll 4
        for (int ks = 0; ks < 16; ++ks) { const bf16x8 af = *(const LAS bf16x8*)(lds + HIMG + (2 * ks + hi) * 512 + r32 * 16);
            const bf16x8 b0 = *(const bf16x8*)(W2T + (size_t)r32 * 256 + ks * 16 + hi * 8), b1 = *(const bf16x8*)(W2T + (size_t)(32 + r32) * 256 + ks * 16 + hi * 8);
            o0 = __builtin_amdgcn_mfma_f32_32x32x16_bf16(af, b0, o0, 0, 0, 0); o1 = __builtin_amdgcn_mfma_f32_32x32x16_bf16(af, b1, o1, 0, 0, 0); }
#pragma unroll
        for (int r = 0; r < 16; ++r) { const int R = R0 + (r & 3) + 8 * (r >> 2) + 4 * hi;
            if (R < 2046) { OUTB[(size_t)R * 64 + r32] = (bf16)f2bf(o0[r]); OUTB[(size_t)R * 64 + 32 + r32] = (bf16)f2bf(o1[r]); } }
        if (maxw) { float m0 = 0.f, m1 = 0.f;
#pragma unroll
            for (int r = 0; r < 16; ++r) { const int R = R0 + (r & 3) + 8 * (r >> 2) + 4 * hi; const float fa = bf2f((unsigned short)f2bf(o0[r])), fb = bf2f((unsigned short)f2bf(o1[r])); float n2 = fa * fa + fb * fb;
                n2 += __shfl_xor(n2, 1); n2 += __shfl_xor(n2, 2); n2 += __shfl_xor(n2, 4); n2 += __shfl_xor(n2, 8); n2 += __shfl_xor(n2, 16);
                if (R < 2046) { if (r & 1) m1 = fmaxf(m1, n2); else m0 = fmaxf(m0, n2); } }
            m0 = fmaxf(m0, __shfl_xor(m0, 32)); m1 = fmaxf(m1, __shfl_xor(m1, 32));
            if (lane == 0) { __hip_atomic_fetch_max(maxw, __float_as_uint(m0), __ATOMIC_RELAXED, __HIP_MEMORY_SCOPE_AGENT); __hip_atomic_fetch_max(maxw + 1, __float_as_uint(m1), __ATOMIC_RELAXED, __HIP_MEMORY_SCOPE_AGENT); } }
    }
}
}
__device__ __forceinline__ void p2_compress_mfma(Frame& F, int layer, const bf16* PROJ) {
    for (int it = F.vcu; it < 128; it += F.G) { const int kv = it & 1, ru = it >> 1;
        cm::run_unit(F.lds, PROJ, (const bf16*)(F.ws + WS_CW1) + (size_t)(layer * 2 + kv) * 2048 * 256, (const float*)(F.ws + WS_POSW1) + (layer * 2 + kv) * 256,
                     (const bf16*)(F.ws + WS_CW2T) + (size_t)(layer * 2 + kv) * 64 * 256, (bf16*)(F.ws + (kv ? WS_VCB : WS_KCB)),
                     kv == 0 ? (unsigned*)(F.ws + WS_CTL) + CW_MAX + layer * 16 : nullptr, kv, ru, F.wave, F.lane, F.tid); }
    __syncthreads();
}

constexpr int NSUB = 9;
constexpr int N_PHASES = 2 + NSUB * DEPTH;
__device__ __forceinline__ void run_phase(Frame& F, int ph) {
    unsigned char* ws = F.ws;
    const float* mod = (const float*)(ws + WS_MOD);
    if (ph == 0) { p0_prologue(F); return; }
    if (ph == 1) { row_pass<0>(F, F.in[I_X], nullptr, (bf16*)(ws + WS_RA), nullptr, nullptr, mod + 1024, mod + 0); return; }
    const int l = (ph - 2) / NSUB, si = (ph - 2) % NSUB;
    const int sub = si <= 2 ? si : (si == 3 ? 8 : si - 1);
    const float* modl = mod + l * 6144;
    bf16* bufX = (bf16*)(ws + ((l & 1) ? WS_RB : WS_RA));
    bf16* bufY = (bf16*)(ws + ((l & 1) ? WS_RA : WS_RB));
    bf16* PROJ = (bf16*)(ws + WS_BIG); bf16* HID = (bf16*)(ws + WS_BIG); bf16* OWIN = (bf16*)(ws + WS_OWIN);
    const float* xres = (l == 0) ? F.in[I_X] : F.out;
    switch (sub) {
    case 0: {
        pg8::Gemm g{bufX, (const bf16*)(ws + WS_WIN) + (size_t)l * NINP * DM, S, NINP, DM}; pg8::StaticOrder So; So.init(S, NINP, F.G, (int)blockIdx.x);
        pg8::EpiInProj E{PROJ, NINP, (const float*)(ws + WS_ROPE), QSCALE};
        pg8::gemm_phase<pg8::EpiInProj, pg8::StaticOrder, PG8_ALIGN, PG8_SP2>(F.lds, g, So, E, F.wave);
    } break;
    case 1: p2_kslc_norm(F, l, PROJ); p2_compress_mfma(F, l, PROJ); p2_banded(F, l, PROJ, bufY, OWIN); break;
    case 2: merge_dilated(F, bufY); p3a_cmp_select(F, l, PROJ); break;
    case 8: p3b_select(F, l, PROJ, OWIN, bufY); break;
    case 3: {
        pg8::Gemm g{bufY, (const bf16*)(ws + WS_WOUT) + (size_t)l * DM * DM, S, DM, DM}; pg8::StaticOrder So; So.init(S, DM, F.G, (int)blockIdx.x);
        pg8::EpiResid E{xres, F.out, DM, modl + 2048, DN_ALPHA};
        pg8::gemm_phase<pg8::EpiResid, pg8::StaticOrder, PG8_ALIGN, PG8_SP2>(F.lds, g, So, E, F.wave);
    } break;
    case 4: row_pass<1>(F, F.out, F.out, bufX, F.in[I_LNG] + (l * 2 + 0) * DM, F.in[I_LNB] + (l * 2 + 0) * DM, modl + 4096, modl + 3072); break;
    case 5: {
        pg8::Gemm g{bufX, (const bf16*)(ws + WS_W1) + (size_t)l * DFF * DM, S, DFF, DM}; pg8::StaticOrder So; So.init(S, DFF, F.G, (int)blockIdx.x);
        pg8::EpiRelu2 E{HID, DFF};
        pg8::gemm_phase<pg8::EpiRelu2, pg8::StaticOrder, PG8_ALIGN, PG8_SP2>(F.lds, g, So, E, F.wave);
    } break;
    case 6: {
        pg8::Gemm g{HID, (const bf16*)(ws + WS_W2) + (size_t)l * DM * DFF, S, DM, DFF}; pg8::StaticOrder So; So.init(S, DM, F.G, (int)blockIdx.x);
        pg8::EpiResid E{F.out, F.out, DM, modl + 5120, DN_ALPHA};
        pg8::gemm_phase<pg8::EpiResid, pg8::StaticOrder, PG8_ALIGN, PG8_SP2>(F.lds, g, So, E, F.wave);
    } break;
    default: {
        if (l + 1 < DEPTH) row_pass<1>(F, F.out, F.out, bufY, F.in[I_LNG] + (l * 2 + 1) * DM, F.in[I_LNB] + (l * 2 + 1) * DM, modl + 6144 + 1024, modl + 6144 + 0);
        else row_pass<2>(F, F.out, F.out, nullptr, F.in[I_LNG] + (l * 2 + 1) * DM, F.in[I_LNB] + (l * 2 + 1) * DM, nullptr, nullptr);
    } break;
    }
}

__global__ void __launch_bounds__(NTHREADS, 2) fwd_kernel(Args args) {
    extern __shared__ __attribute__((aligned(16))) unsigned char lds[];
    Frame F;
    F.lds = (LAS unsigned char*)lds;
    F.tid = threadIdx.x; F.lane = F.tid & 63; F.wave = __builtin_amdgcn_readfirstlane(F.tid >> 6);
    F.G = gridDim.x; { const int bx = blockIdx.x; F.vcu = (F.G % 8 == 0) ? (bx % 8) * (F.G / 8) + bx / 8 : bx; }
    F.ws = args.ws; F.out = args.out;
#pragma unroll
    for (int i = 0; i < 16; ++i) F.in[i] = args.in[i];
    for (int u = F.tid; u < (LDS_BYTES - LDSCTL_OFF) / 4; u += NTHREADS) ((LAS unsigned*)(F.lds + LDSCTL_OFF))[u] = 0u;
    __syncthreads();
    const int wave0 = __builtin_amdgcn_readfirstlane(threadIdx.x >> 6);
    const bool multi = (args.ph_hi - args.ph_lo) > 1;
    XcdBarrier bar; bar.bar = (unsigned*)(F.ws + WS_CTL) + 4096; bar.x = 0; bar.st = nullptr;
    if (multi) bar = xcd_barrier_post((unsigned*)(F.ws + WS_CTL) + 4096, (volatile LAS unsigned*)(F.lds + MISC_OFF) + 8);
    for (int ph = args.ph_lo; ph < args.ph_hi; ++ph) {
        { int ln = __builtin_amdgcn_mbcnt_hi(~0u, __builtin_amdgcn_mbcnt_lo(~0u, 0u)); asm volatile("" : "+v"(ln)); F.lane = ln; F.wave = wave0; F.tid = wave0 * 64 + ln; }
        run_phase(F, ph);
        if (ph + 1 < args.ph_hi) xcd_barrier(bar);
    }
}

#ifndef N_LAUNCH_MODE
#define N_LAUNCH_MODE 1
#endif
extern "C" void kernel_launch(void* const* d_in, const int* in_sizes, int n_in, void* d_out, int out_size, void* d_ws, size_t ws_size, hipStream_t stream) {
    static int grid = 0;
    if (grid == 0) {
        if (n_in != 16 || out_size != S * DM || ws_size < WS_END) { fprintf(stderr, "kernel_launch: unexpected shapes (n_in %d out %d ws %zu)\n", n_in, out_size, ws_size); grid = -1; return; }
        int dev = 0, cus = 0;
        if (hipGetDevice(&dev) != hipSuccess || hipDeviceGetAttribute(&cus, hipDeviceAttributeMultiprocessorCount, dev) != hipSuccess) { grid = -1; return; }
        if (hipFuncSetAttribute((const void*)fwd_kernel, hipFuncAttributeMaxDynamicSharedMemorySize, LDS_BYTES) != hipSuccess) { fprintf(stderr, "kernel_launch: hipFuncSetAttribute failed\n"); grid = -1; return; }
        int per_cu = 0;
        if (hipOccupancyMaxActiveBlocksPerMultiprocessor(&per_cu, (const void*)fwd_kernel, NTHREADS, LDS_BYTES) != hipSuccess || per_cu < 1) fprintf(stderr, "kernel_launch: occupancy query says %d\n", per_cu);
        (void)hipGetLastError();
        grid = cus;
    }
    if (grid < 0) return;
    (void)hipMemsetAsync((char*)d_ws + WS_CTL, 0, CTL_ZERO_BYTES, stream);
    Args a{};
    for (int i = 0; i < 16; ++i) a.in[i] = (const float*)d_in[i];
    a.out = (float*)d_out; a.ws = (unsigned char*)d_ws;
#if N_LAUNCH_MODE == 1
    a.ph_lo = 0; a.ph_hi = N_PHASES;
    hipLaunchKernelGGL(fwd_kernel, dim3(grid), dim3(NTHREADS), LDS_BYTES, stream, a);
#else
    for (int ph = 0; ph < N_PHASES; ++ph) { a.ph_lo = ph; a.ph_hi = ph + 1; hipLaunchKernelGGL(fwd_kernel, dim3(grid), dim3(NTHREADS), LDS_BYTES, stream, a); }
#endif
}
```

```cpp
#include <hip/hip_runtime.h>
#include <cstdio>
#include <cstdint>
#include <cmath>
#ifndef DUP_ACT
#define DUP_ACT 0
#endif
namespace pg8 {
#define PG8_LAS __attribute__((address_space(3)))
typedef unsigned short bf16_t;
typedef short bf16x8 __attribute__((ext_vector_type(8)));
typedef float f32x4 __attribute__((ext_vector_type(4)));
typedef unsigned u32x4 __attribute__((ext_vector_type(4)));
constexpr int BM = 256, BK = 64, HALF = 128, HTB = HALF * BK * 2  , STAGE_BYTES = 8 * HTB, NXCD = 8, WGM = 8;

__host__ __device__ __forceinline__ int lds_byte(int r, int c) { const int st = (r >> 4) * 2 + (c >> 5), rr = r & 15, cc = c & 31, ob = rr * 64 + cc * 2; return st * 1024 + (ob ^ (((ob >> 9) & 1) << 5)); }
__host__ __device__ __forceinline__ void stage_rc(int b, int& R, int& C) { const int st = b / 1024, sb = b % 1024, swz = sb ^ (((sb >> 9) & 1) << 5); R = (st >> 1) * 16 + swz / 64; C = (st & 1) * 32 + (swz % 64) / 2; }
__host__ __device__ __forceinline__ int perm32(int rho) { const int n = rho >> 4, i = rho & 15; return 8 * (i >> 2) + 4 * n + (i & 3); }

struct Unit { int pm, pn; };
struct Gemm { const bf16_t* A; const bf16_t* Bt; int M, N, K; };

struct StaticOrder {
    int nM, nN, nwg, G, c;
    __host__ __device__ void init(int M, int N, int G_, int c_) { nM = M / BM; nN = N / BM; nwg = nM * nN; G = G_; c = c_; }
    __host__ __device__ bool next(int i, Unit& u) const {
        const long L = (long)i * G + c; if (L >= nwg) return false;
        int wgid = (int)L; { const int q = nwg / NXCD, r = nwg % NXCD, xcd = wgid % NXCD, off = wgid / NXCD; wgid = (xcd < r ? xcd * (q + 1) : r * (q + 1) + (xcd - r) * q) + off; }
        const int nig = WGM * nN, gid = wgid / nig, fm = gid * WGM, gsz = (nM - fm) < WGM ? (nM - fm) : WGM;
        u.pm = fm + ((wgid % nig) % gsz); u.pn = (wgid % nig) / gsz; return true;
    }
    __device__ __forceinline__ void a_ready(const Unit&) const {}
    __device__ __forceinline__ void done(const Unit&) const {}
};


__device__ __forceinline__ unsigned cvt_pk_bf16(float lo, float hi) { unsigned r; asm volatile("v_cvt_pk_bf16_f32 %0, %1, %2" : "=v"(r) : "v"(lo), "v"(hi)); return r; }
typedef float f32x2 __attribute__((ext_vector_type(2)));

struct EpiInProj {
    static constexpr bool PERM = true, AFTER_DRAIN = false;
    bf16_t* O; int ldc; const float* rope; float qscale; unsigned char* simg;
    __device__ __forceinline__ void operator()(const f32x4 (&acc)[2][2][4][2], const Unit& u, int wr, int wc, int fr, int fq) const {
        const int row0 = u.pm * BM + wr * 64 + fr; const int col0 = u.pn * BM + wc * 32 + 8 * fq;
        const int i0 = 16 * (wc & 1) + 4 * fq;
#pragma unroll
        for (int bj = 0; bj < 2; ++bj) {
            const int pn = u.pn;
            const bool do_rope = (pn == 3) || (pn == 4 && bj == 0);
            const bool do_sig = (pn == 10);
            const float sc = (pn == 0 || pn == 3 || pn == 5 || pn == 6) ? qscale : 1.0f;
#pragma unroll
            for (int ai = 0; ai < 2; ++ai)
#pragma unroll
                for (int m = 0; m < 4; ++m) {
                    const int row = row0 + ai * HALF + m * 16;
                    f32x4 v0 = acc[ai][bj][m][0], v1 = acc[ai][bj][m][1];
                    if (do_rope) {
                        const f32x4* rp = (const f32x4*)(rope + ((size_t)row * 32 + i0) * 2);
                        const f32x4 c01 = rp[0], c23 = rp[1];
                        f32x4 w0, w1;
                        w0[0] = v0[0] * c01[0] - v0[1] * c01[1]; w0[1] = v0[1] * c01[0] + v0[0] * c01[1];
                        w0[2] = v0[2] * c01[2] - v0[3] * c01[3]; w0[3] = v0[3] * c01[2] + v0[2] * c01[3];
                        w1[0] = v1[0] * c23[0] - v1[1] * c23[1]; w1[1] = v1[1] * c23[0] + v1[0] * c23[1];
                        w1[2] = v1[2] * c23[2] - v1[3] * c23[3]; w1[3] = v1[3] * c23[2] + v1[2] * c23[3];
                        v0 = w0; v1 = w1;
                    }
                    if (do_sig) {
#pragma unroll
                        for (int e = 0; e < 4; ++e) { v0[e] = 1.0f / (1.0f + __expf(-v0[e])); v1[e] = 1.0f / (1.0f + __expf(-v1[e])); }
                    }
                    v0 = v0 * sc; v1 = v1 * sc;
                    u32x4 w; w.x = cvt_pk_bf16(v0[0], v0[1]); w.y = cvt_pk_bf16(v0[2], v0[3]); w.z = cvt_pk_bf16(v1[0], v1[1]); w.w = cvt_pk_bf16(v1[2], v1[3]);
                    *(u32x4*)(O + (size_t)row * ldc + col0 + bj * HALF) = w;
                    if (pn == 8) {
                        const unsigned kvh = wc >> 1, blk = (unsigned)row >> 6, key = row & 63;
                        const unsigned off = ((kvh * 256u + blk) << 14) + (bj == 0 ? (4u * (wc & 1) + fq) * 1024u + key * 16u : 8192u + (2u * (wc & 1) + (fq >> 1)) * 2048u + key * 32u + (fq & 1) * 16u);
                        *(u32x4*)(simg + off) = w;
                    }
                }
        }
    }
};
struct EpiRelu2 {
    static constexpr bool PERM = true, AFTER_DRAIN = false;
    bf16_t* O; int ldc;
    __device__ __forceinline__ void operator()(const f32x4 (&acc)[2][2][4][2], const Unit& u, int wr, int wc, int fr, int fq) const {
        const int row0 = u.pm * BM + wr * 64 + fr; const int col0 = u.pn * BM + wc * 32 + 8 * fq;
#pragma unroll
        for (int ai = 0; ai < 2; ++ai)
#pragma unroll
            for (int m = 0; m < 4; ++m) { bf16_t* rowp = O + (size_t)(row0 + ai * HALF + m * 16) * ldc + col0;
#pragma unroll
                for (int bj = 0; bj < 2; ++bj) { f32x4 v0 = acc[ai][bj][m][0], v1 = acc[ai][bj][m][1];
#pragma unroll
                    for (int e = 0; e < 4; ++e) { const float a = fmaxf(v0[e], 0.f), b = fmaxf(v1[e], 0.f); v0[e] = a * a; v1[e] = b * b; }
                    u32x4 w; w.x = cvt_pk_bf16(v0[0], v0[1]); w.y = cvt_pk_bf16(v0[2], v0[3]); w.z = cvt_pk_bf16(v1[0], v1[1]); w.w = cvt_pk_bf16(v1[2], v1[3]);
                    *(u32x4*)(rowp + bj * HALF) = w; } }
    }
};
struct EpiResid {
    static constexpr bool PERM = false, AFTER_DRAIN = false;
    const float* base; float* out; int ldc; const float* gate; float alpha;
    __device__ __forceinline__ void operator()(const f32x4 (&acc)[2][2][4][2], const Unit& u, int wr, int wc, int fr, int fq) const {
        const int col0 = u.pn * BM + wc * 32 + 4 * fq;
#pragma unroll
        for (int bj = 0; bj < 2; ++bj)
#pragma unroll
            for (int n = 0; n < 2; ++n) { const f32x4 gv = *(const f32x4*)(gate + col0 + bj * HALF + n * 16) + 1.0f;
#pragma unroll
                for (int ai = 0; ai < 2; ++ai)
#pragma unroll
                    for (int m = 0; m < 4; ++m) { const size_t off = (size_t)(u.pm * BM + ai * HALF + wr * 64 + m * 16 + fr) * ldc + col0 + bj * HALF + n * 16;
                        const f32x4 bs = *(const f32x4*)(base + off); *(f32x4*)(out + off) = bs * alpha + gv * acc[ai][bj][m][n]; } }
    }
};
template <class Epi, class Sched, bool ALIGN_EPI = false, bool SP2 = false>
__device__ __forceinline__ void gemm_phase(PG8_LAS unsigned char* lds, const Gemm g, const Sched& S, const Epi& E, const int wid  ) {
    int lane_ = __builtin_amdgcn_mbcnt_hi(~0u, __builtin_amdgcn_mbcnt_lo(~0u, 0u)); asm volatile("" : "+v"(lane_));
    const int lane = lane_, tid = wid * 64 + lane, wr = wid >> 2, wc = wid & 3, fr = lane & 15, fq = lane >> 4;
    const int K = g.K, nt = K / BK;
    unsigned voffA[2], voffB[2];
#pragma unroll
    for (int i = 0; i < 2; ++i) { int R, C; stage_rc(tid * 16 + i * 8192, R, C); const int Rb = Epi::PERM ? ((R & ~31) + perm32(R & 31)) : R;
        voffA[i] = (unsigned)(R * K + C) * 2u; voffB[i] = (unsigned)(Rb * K + C) * 2u; }
    const size_t kstep = (size_t)(BK * 2);
    const size_t hstep = (size_t)HALF * K * 2;
    const size_t tstep = 2 * hstep;
    const unsigned ldsw = (unsigned)wid * 1024u;
    const int aoff = lds_byte(wr * 64 + fr, fq * 8), boff = lds_byte(wc * 32 + fr, fq * 8);
#define PG8_SA(b, h) (((b) * 2 + (h)) * HTB)
#define PG8_SB(b, h) ((4 + (b) * 2 + (h)) * HTB)
#define PG8_STAGE(bufoff, gbase, voff) do { _Pragma("unroll") for (int _i = 0; _i < 2; ++_i) \
        __builtin_amdgcn_global_load_lds((const unsigned*)((const char*)(gbase) + (voff)[_i]), (PG8_LAS unsigned*)(lds + (bufoff) + ldsw + _i * 8192), 16, 0, 0); } while (0)
#define PG8_LDA(dst, b, h) do { _Pragma("unroll") for (int m = 0; m < 4; ++m) _Pragma("unroll") for (int k = 0; k < 2; ++k) dst[m][k] = *(const PG8_LAS bf16x8*)(lds + PG8_SA(b, h) + aoff + m * 2048 + k * 1024); } while (0)
#define PG8_LDB(dst, b, h) do { _Pragma("unroll") for (int n = 0; n < 2; ++n) _Pragma("unroll") for (int k = 0; k < 2; ++k) dst[n][k] = *(const PG8_LAS bf16x8*)(lds + PG8_SB(b, h) + boff + n * 2048 + k * 1024); } while (0)
#define PG8_MMA(ai, bj, At, Bt) do { __builtin_amdgcn_s_setprio(1); _Pragma("unroll") for (int m = 0; m < 4; ++m) _Pragma("unroll") for (int n = 0; n < 2; ++n) _Pragma("unroll") for (int k = 0; k < 2; ++k) \
        acc[ai][bj][m][n] = __builtin_amdgcn_mfma_f32_16x16x32_bf16(Bt[n][k], At[m][k], acc[ai][bj][m][n], 0, 0, 0); __builtin_amdgcn_s_setprio(0); } while (0)
#define PG8_WAIT_V(n) asm volatile("s_waitcnt vmcnt(" #n ")" ::: "memory")
#define PG8_WAIT_L(n) asm volatile("s_waitcnt lgkmcnt(" #n ")" ::: "memory")
#define PG8_BAR __builtin_amdgcn_s_barrier()
#define PG8_SCHED __builtin_amdgcn_sched_barrier(0)
    Unit cur, nxt; int ui = 0;
    if (!S.next(0, cur)) return;
    f32x4 acc[2][2][4][2];
#pragma unroll
    for (int a = 0; a < 2; ++a)
#pragma unroll
        for (int b = 0; b < 2; ++b)
#pragma unroll
            for (int m = 0; m < 4; ++m)
#pragma unroll
                for (int n = 0; n < 2; ++n) acc[a][b][m][n] = (f32x4){0.f, 0.f, 0.f, 0.f};
    bf16x8 At[4][2], B0[2][2], B1[2][2];
    const char* cA = (const char*)g.A + (size_t)cur.pm * tstep; const char* cB = (const char*)g.Bt + (size_t)cur.pn * tstep;
    S.a_ready(cur);
    if constexpr (SP2) {
        PG8_STAGE(PG8_SB(0, 0), cB, voffB); PG8_STAGE(PG8_SB(0, 1), cB + hstep, voffB); PG8_STAGE(PG8_SA(0, 0), cA, voffA); PG8_STAGE(PG8_SA(0, 1), cA + hstep, voffA);
        if (wr == 1) PG8_BAR;
        PG8_WAIT_V(2); PG8_BAR;
        PG8_STAGE(PG8_SB(1, 0), cB + kstep, voffB); PG8_STAGE(PG8_SA(1, 0), cA + kstep, voffA); PG8_STAGE(PG8_SB(1, 1), cB + hstep + kstep, voffB);
        PG8_WAIT_V(6); PG8_BAR;
    } else {
        PG8_STAGE(PG8_SB(0, 0), cB, voffB); PG8_STAGE(PG8_SA(0, 0), cA, voffA); PG8_STAGE(PG8_SB(0, 1), cB + hstep, voffB); PG8_STAGE(PG8_SA(0, 1), cA + hstep, voffA);
        if (wr == 1) PG8_BAR;
        PG8_WAIT_V(4); PG8_BAR;
        PG8_STAGE(PG8_SB(1, 0), cB + kstep, voffB); PG8_STAGE(PG8_SA(1, 0), cA + kstep, voffA); PG8_STAGE(PG8_SB(1, 1), cB + hstep + kstep, voffB);
        PG8_WAIT_V(6); PG8_BAR;
    }
    for (;;) {
        const bool has_next = S.next(ui + 1, nxt);
        const char* nA = has_next ? (const char*)g.A + (size_t)nxt.pm * tstep : cA; const char* nB = has_next ? (const char*)g.Bt + (size_t)nxt.pn * tstep : cB;
        for (int t = 0; t < nt; t += 2) {
            const bool last = (t == nt - 2);
            const char* a1 = cA + (size_t)(t + 1) * kstep;
            const char* a2 = last ? nA : cA + (size_t)(t + 2) * kstep; const char* b2 = last ? nB : cB + (size_t)(t + 2) * kstep;
            const char* a3 = a2 + kstep; const char* b3 = b2 + kstep;
            if (last && has_next) S.a_ready(nxt);
            if constexpr (SP2) {
            PG8_LDB(B0, 0, 0); PG8_LDB(B1, 0, 1); PG8_SCHED; PG8_LDA(At, 0, 0); PG8_STAGE(PG8_SA(1, 1), a1 + hstep, voffA);
            PG8_WAIT_V(8); PG8_WAIT_L(0); PG8_BAR; PG8_MMA(0, 0, At, B0); PG8_MMA(0, 1, At, B1); PG8_BAR; PG8_SCHED;
            PG8_LDA(At, 0, 1); PG8_STAGE(PG8_SB(0, 0), b2, voffB); PG8_STAGE(PG8_SB(0, 1), b2 + hstep, voffB); PG8_STAGE(PG8_SA(0, 0), a2, voffA);
            PG8_WAIT_V(8); PG8_WAIT_L(0); PG8_BAR; PG8_MMA(1, 0, At, B0); PG8_MMA(1, 1, At, B1); PG8_BAR; PG8_SCHED;
            PG8_LDB(B0, 1, 0); PG8_LDB(B1, 1, 1); PG8_SCHED; PG8_LDA(At, 1, 0); PG8_STAGE(PG8_SA(0, 1), a2 + hstep, voffA);
            PG8_WAIT_V(8); PG8_WAIT_L(0); PG8_BAR; PG8_MMA(0, 0, At, B0); PG8_MMA(0, 1, At, B1); PG8_BAR; PG8_SCHED;
            PG8_LDA(At, 1, 1); PG8_STAGE(PG8_SB(1, 0), b3, voffB); PG8_STAGE(PG8_SB(1, 1), b3 + hstep, voffB); PG8_STAGE(PG8_SA(1, 0), a3, voffA);
            PG8_WAIT_V(8); PG8_WAIT_L(0); PG8_BAR; PG8_MMA(1, 0, At, B0); PG8_MMA(1, 1, At, B1); PG8_BAR; PG8_SCHED;
            } else {
            PG8_LDB(B0, 0, 0); PG8_SCHED; PG8_LDA(At, 0, 0); PG8_STAGE(PG8_SA(1, 1), a1 + hstep, voffA);
            PG8_WAIT_L(8); PG8_BAR; PG8_WAIT_L(0); PG8_MMA(0, 0, At, B0); PG8_BAR; PG8_SCHED;
            PG8_LDB(B1, 0, 1); PG8_STAGE(PG8_SB(0, 0), b2, voffB);
            PG8_BAR; PG8_WAIT_L(0); PG8_MMA(0, 1, At, B1); PG8_BAR;
            PG8_LDA(At, 0, 1); PG8_STAGE(PG8_SA(0, 0), a2, voffA);
            PG8_BAR; PG8_WAIT_L(0); PG8_MMA(1, 0, At, B0); PG8_BAR; PG8_SCHED;
            PG8_STAGE(PG8_SB(0, 1), b2 + hstep, voffB);
            PG8_WAIT_V(6); PG8_BAR; PG8_MMA(1, 1, At, B1); PG8_BAR;
            PG8_LDB(B0, 1, 0); PG8_SCHED; PG8_LDA(At, 1, 0); PG8_STAGE(PG8_SA(0, 1), a2 + hstep, voffA);
            PG8_WAIT_L(8); PG8_BAR; PG8_WAIT_L(0); PG8_MMA(0, 0, At, B0); PG8_BAR; PG8_SCHED;
            PG8_LDB(B1, 1, 1); PG8_STAGE(PG8_SB(1, 0), b3, voffB);
            PG8_BAR; PG8_WAIT_L(0); PG8_MMA(0, 1, At, B1); PG8_BAR;
            PG8_LDA(At, 1, 1); PG8_STAGE(PG8_SA(1, 0), a3, voffA);
            PG8_BAR; PG8_WAIT_L(0); PG8_MMA(1, 0, At, B0); PG8_BAR; PG8_SCHED;
            PG8_STAGE(PG8_SB(1, 1), b3 + hstep, voffB);
            PG8_WAIT_V(6); PG8_BAR; PG8_MMA(1, 1, At, B1); PG8_BAR;
            }
        }
        if constexpr (ALIGN_EPI) { if (wr == 0) PG8_BAR; }
        if constexpr (!Epi::AFTER_DRAIN) { E(acc, cur, wr, wc, fr, fq); S.done(cur); }
        if (!has_next) break;
#pragma unroll
        for (int a = 0; a < 2; ++a)
#pragma unroll
            for (int b = 0; b < 2; ++b)
#pragma unroll
                for (int m = 0; m < 4; ++m)
#pragma unroll
                    for (int n = 0; n < 2; ++n) acc[a][b][m][n] = (f32x4){0.f, 0.f, 0.f, 0.f};
        cur = nxt; cA = nA; cB = nB; ++ui;
        if constexpr (ALIGN_EPI) { if (wr == 1) PG8_BAR; }
    }
    PG8_WAIT_V(0);
    if constexpr (!ALIGN_EPI) { if (wr == 0) PG8_BAR; }
    PG8_BAR;
    if constexpr (Epi::AFTER_DRAIN) { E.fused(acc, cur, wr, wc, fr, fq, lds, wid, lane); S.done(cur); }
#undef PG8_SA
#undef PG8_SB
#undef PG8_STAGE
#undef PG8_LDA
#undef PG8_LDB
#undef PG8_MMA
#undef PG8_WAIT_V
#undef PG8_WAIT_L
#undef PG8_BAR
#undef PG8_SCHED
}
}

#ifndef PG8_SP2
#define PG8_SP2 true
#endif
#ifndef PG8_ALIGN
#define PG8_ALIGN true
#endif

constexpr int S = 16384, DM = 1024, NIN = 2584, NINP = 2816, DFF = 4096, DEPTH = 4;
constexpr int NWAVES = 8, NTHREADS = 512;
constexpr float LN_EPS = 1e-5f;
constexpr float LOG2E = 1.4426950408889634f;
constexpr float QSCALE = 0.125f * LOG2E;
constexpr float DN_ALPHA = 1.681792830507429f;
constexpr int C_AQ = 0, C_AK = 256, C_AV = 512, C_BQ = 768, C_BK = 1024, C_BV = 1152, C_CQ = 1280, C_CKC = 1792, C_CVC = 1920,
              C_CKS = 2048, C_CVS = 2176, C_CKW = 2304, C_CVW = 2432, C_CG = 2560;
constexpr int NCMP = 1023, NSEL = 256;
constexpr int BIASLEN = 2048;

constexpr size_t MiB = 1u << 20;
constexpr size_t WS_CTL = 0, CTL_ZERO_BYTES = 1 * MiB;
constexpr size_t WS_MOD = 1 * MiB;
constexpr size_t WS_BIAS = 1 * MiB + 128 * 1024;
constexpr size_t WS_BMAX = 1 * MiB + 256 * 1024;
constexpr size_t WS_ROPE = 2 * MiB;
constexpr size_t WS_KC = 6 * MiB, WS_VC = 6 * MiB + 512 * 1024;
constexpr size_t WS_CW2T = 6 * MiB;
constexpr size_t WS_POSW1 = 6 * MiB + 512 * 1024;
constexpr size_t WS_WIN = 8 * MiB;
constexpr size_t WS_WOUT = 30 * MiB;
constexpr size_t WS_W1 = 38 * MiB;
constexpr size_t WS_W2 = 70 * MiB;
constexpr size_t WS_CW1 = 102 * MiB;
constexpr size_t WS_RA = 110 * MiB, WS_RB = 142 * MiB;
constexpr size_t WS_BIG = 174 * MiB;
constexpr size_t WS_OWIN = WS_BIG + 88 * MiB;
constexpr size_t WS_OA3 = WS_BIG + 104 * MiB;
constexpr size_t WS_OCMP = 302 * MiB;
constexpr size_t WS_SELB = 318 * MiB;
constexpr size_t WS_LSE = 319 * MiB;
constexpr size_t WS_KSIMG = 320 * MiB;
constexpr size_t WS_END = 328 * MiB;
constexpr size_t WS_KCB = 7 * MiB, WS_VCB = 7 * MiB + 512 * 1024;
constexpr int CW_MAX = 16384;

#define GAS __attribute__((address_space(1)))
#define LAS __attribute__((address_space(3)))
typedef unsigned short bf16;
typedef unsigned v4u __attribute__((ext_vector_type(4)));
typedef unsigned v2u __attribute__((ext_vector_type(2)));
typedef float f32x4 __attribute__((ext_vector_type(4)));
typedef float f32x2 __attribute__((ext_vector_type(2)));
#define LDS_WAIT() asm volatile("s_waitcnt lgkmcnt(0)" ::: "memory")
#define VM_WAIT() asm volatile("s_waitcnt vmcnt(0)" ::: "memory")
__device__ __forceinline__ unsigned f2bf(float f) { unsigned u = __builtin_bit_cast(unsigned, f); return (u + 0x7fffu + ((u >> 16) & 1u)) >> 16; }
__device__ __forceinline__ unsigned pk2(float lo, float hi) { return f2bf(lo) | (f2bf(hi) << 16); }
__device__ __forceinline__ float bf2f(unsigned short b) { return __uint_as_float((unsigned)b << 16); }
__device__ __forceinline__ float bflo(unsigned w) { return __uint_as_float(w << 16); }
__device__ __forceinline__ float bfhi(unsigned w) { return __uint_as_float(w & 0xffff0000u); }
__device__ __forceinline__ float wave_sum(float v) {
#pragma unroll
    for (int o = 1; o < 64; o <<= 1) v += __shfl_xor(v, o);
    return v;
}
__device__ __forceinline__ float wave_max(float v) {
#pragma unroll
    for (int o = 1; o < 64; o <<= 1) v = fmaxf(v, __shfl_xor(v, o));
    return v;
}

constexpr int RING_BYTES = 162816;
constexpr int LDSCTL_OFF = RING_BYTES, MISC_OFF = LDSCTL_OFF + 320;
constexpr int LDS_BYTES = 163840;

struct Args { const float* in[16]; float* out; unsigned char* ws; int ph_lo, ph_hi; };

struct Frame {
    LAS unsigned char* lds;
    int tid, lane, wave, G, vcu;
    unsigned char* ws;
    const float* in[16];
    float* out;
};
enum { I_X = 0, I_C, I_POS, I_WIN, I_WOUT, I_RELB, I_SINK, I_CPOS, I_CW1, I_CW2, I_MW1, I_MW2, I_ADAW, I_ADAB, I_LNG, I_LNB };

__device__ __forceinline__ int t5_bucket(int d) {
    if (d < 16) return d;
    int b = 16;
    b += d >= 22; b += d >= 30; b += d >= 40; b += d >= 54; b += d >= 73; b += d >= 99; b += d >= 134; b += d >= 182;
    b += d >= 246; b += d >= 332; b += d >= 450; b += d >= 609; b += d >= 825; b += d >= 1117; b += d >= 1513;
    return b;
}
__device__ const float ROPE_FREQ[32] = {1.000000000e+00f, 6.890442967e-01f, 4.747820497e-01f, 3.271458745e-01f, 2.254180014e-01f, 1.553229839e-01f, 1.070244238e-01f, 7.374456525e-02f,
    5.081327632e-02f, 3.501259908e-02f, 2.412523143e-02f, 1.662335359e-02f, 1.145422645e-02f, 7.892469876e-03f, 5.438261200e-03f, 3.747202922e-03f,
    2.581988927e-03f, 1.779104699e-03f, 1.225881977e-03f, 8.446869906e-04f, 5.820267834e-04f, 4.010422272e-04f, 2.763358643e-04f, 1.904076635e-04f,
    1.311993110e-04f, 9.040213627e-05f, 6.229108112e-05f, 4.292131416e-05f, 2.957468678e-05f, 2.037826926e-05f, 1.404153045e-05f, 9.675236470e-06f};
__device__ __forceinline__ void sincos_f(float a, float& c, float& s) {
    const float n = rintf(a * 0.636619772367581343f);
    float r = fmaf(-n, 1.5703125f, a); r = fmaf(-n, 0.0004838267923332751f, r); r = fmaf(-n, 2.5632829192545614e-12f, r);
    const float r2 = r * r;
    const float sp = fmaf(r * r2, fmaf(r2, fmaf(r2, fmaf(r2, 2.755731922e-6f, -1.984126984e-4f), 8.333333333e-3f), -1.666666667e-1f), r);
    const float cp = fmaf(r2, fmaf(r2, fmaf(r2, fmaf(r2, fmaf(r2, -2.755731922e-7f, 2.480158730e-5f), -1.388888889e-3f), 4.166666667e-2f), -0.5f), 1.0f);
    const int q = ((int)n) & 3;
    c = (q == 0) ? cp : (q == 1) ? -sp : (q == 2) ? -cp : sp;
    s = (q == 0) ? sp : (q == 1) ? cp : (q == 2) ? -sp : -cp;
}

template <int MODE>
__device__ __forceinline__ int colmap(int n) {
    if (MODE == 0) return n;
    if (n >= NIN) return -1;
    if (n >= C_BQ && n < C_BV) { const int hb = n & ~63, j = n & 63; return hb + (j >> 1) + 32 * (j & 1); }
    return n;
}
template <int MODE>
__device__ __forceinline__ void transpose_item(const float* W, int K, int N, int NP, bf16* WT, LAS float* scr, int item, int lane) {
    const int nblk = NP / 32, kb = item / nblk, nb = item % nblk, k0 = 64 * kb, n0 = 32 * nb;
    const int src = colmap<MODE>(n0 + (lane & 31));
#pragma unroll 8
    for (int i = 0; i < 32; ++i) { const int kk = 2 * i + (lane >> 5); scr[kk * 33 + (lane & 31)] = src >= 0 ? W[(size_t)(k0 + kk) * N + src] : 0.f; }
    LDS_WAIT(); asm volatile("" ::: "memory");
    const int c = lane & 7;
#pragma unroll
    for (int j = 0; j < 4; ++j) { const int n = (lane >> 3) + 8 * j; const LAS float* s = scr + (8 * c) * 33 + n;
        v4u o; o.x = pk2(s[0 * 33], s[1 * 33]); o.y = pk2(s[2 * 33], s[3 * 33]); o.z = pk2(s[4 * 33], s[5 * 33]); o.w = pk2(s[6 * 33], s[7 * 33]);
        *(v4u*)(WT + (size_t)(n0 + n) * K + k0 + 8 * c) = o; }
    LDS_WAIT(); asm volatile("" ::: "memory");
}

__device__ __forceinline__ void p0_prologue(Frame& F) {
    LAS float* scr = (LAS float*)(F.lds + F.wave * 16384);
    const int gw = F.vcu * NWAVES + F.wave, NGW = F.G * NWAVES;
    constexpr int I_IN = (DM / 64) * (NINP / 32), I_OUT = (DM / 64) * (DM / 32), I_1 = (DM / 64) * (DFF / 32), I_2 = (DFF / 64) * (DM / 32);
    constexpr int PER_LAYER = I_IN + I_OUT + I_1 + I_2;
    for (int it = gw; it < DEPTH * PER_LAYER; it += NGW) {
        const int l = it / PER_LAYER; int r = it % PER_LAYER;
        if (r < I_IN) { transpose_item<1>(F.in[I_WIN] + (size_t)l * DM * NIN, DM, NIN, NINP, (bf16*)(F.ws + WS_WIN) + (size_t)l * NINP * DM, scr, r, F.lane); continue; } r -= I_IN;
        if (r < I_OUT) { transpose_item<0>(F.in[I_WOUT] + (size_t)l * DM * DM, DM, DM, DM, (bf16*)(F.ws + WS_WOUT) + (size_t)l * DM * DM, scr, r, F.lane); continue; } r -= I_OUT;
        if (r < I_1) { transpose_item<0>(F.in[I_MW1] + (size_t)l * DM * DFF, DM, DFF, DFF, (bf16*)(F.ws + WS_W1) + (size_t)l * DFF * DM, scr, r, F.lane); continue; } r -= I_1;
        transpose_item<0>(F.in[I_MW2] + (size_t)l * DFF * DM, DFF, DM, DM, (bf16*)(F.ws + WS_W2) + (size_t)l * DM * DFF, scr, r, F.lane);
    }
    {
        __syncthreads();
        LAS float* red = (LAS float*)F.lds;
        const int nl = F.tid & 63, kp = F.tid >> 6;
        for (int it = F.vcu; it < DEPTH * 96; it += F.G) {
            const int l = it / 96, n = (it % 96) * 64 + nl;
            const float* w = F.in[I_ADAW] + (size_t)l * DM * 6144 + n;
            const float* c = F.in[I_C];
            float a = 0.f;
#pragma unroll 8
            for (int k = kp * 128; k < kp * 128 + 128; ++k) { const float cv = c[k]; a += (cv / (1.0f + __expf(-cv))) * w[(size_t)k * 6144]; }
            red[kp * 64 + nl] = a;
            __syncthreads();
            if (kp == 0) { float s = F.in[I_ADAB][l * 6144 + n];
#pragma unroll
                for (int j = 0; j < 8; ++j) s += red[j * 64 + nl];
                ((float*)(F.ws + WS_MOD))[l * 6144 + n] = s; }
            __syncthreads();
        }
    }
    {
        const int gt = F.vcu * NTHREADS + F.tid, NGT = F.G * NTHREADS;
        const int* pos = (const int*)F.in[I_POS];
        f32x2* rt = (f32x2*)(F.ws + WS_ROPE);
        for (int e = gt; e < S * 32; e += NGT) {
            const int r = e >> 5, i = e & 31;
            const float ang = (float)pos[r] * ROPE_FREQ[i];
            float cs, sn; sincos_f(ang, cs, sn);
            rt[e] = (f32x2){cs, sn};
        }
        if (gt < 12) { float m = -1e30f; for (int b = 0; b < 32; ++b) m = fmaxf(m, F.in[I_RELB][b * 12 + gt] * LOG2E); ((float*)(F.ws + WS_BMAX))[gt] = m; }
        for (int e = gt; e < 8 * 256 * 256; e += NGT) { const int mtx = e >> 16, c = (e >> 8) & 255, n = e & 255; const float* w = F.in[I_CW1] + (size_t)mtx * 2048 * 256 + (size_t)(8 * c) * 256 + n;
            v4u o; o.x = pk2(w[0], w[256]); o.y = pk2(w[512], w[768]); o.z = pk2(w[1024], w[1280]); o.w = pk2(w[1536], w[1792]);
            *(v4u*)((bf16*)(F.ws + WS_CW1) + (size_t)e * 8) = o; }
        for (int e = gt; e < 8 * 64 * 32; e += NGT) { const int mtx = e >> 11, ee = (e >> 5) & 63, jc = e & 31; const float* w = F.in[I_CW2] + (size_t)mtx * 256 * 64 + (size_t)(8 * jc) * 64 + ee;
            v4u o; o.x = pk2(w[0], w[64]); o.y = pk2(w[128], w[192]); o.z = pk2(w[256], w[320]); o.w = pk2(w[384], w[448]);
            *(v4u*)((bf16*)(F.ws + WS_CW2T) + (size_t)e * 8) = o; }
        for (int e = gt; e < 8 * 256; e += NGT) { const int mtx = e >> 8, n = e & 255; const float* w = F.in[I_CW1] + (size_t)mtx * 2048 * 256 + n; const float* ps = F.in[I_CPOS] + (size_t)mtx * 2048;
            float a = 0.f;
#pragma unroll 8
            for (int f = 0; f < 2048; ++f) a += ps[f] * w[(size_t)f * 256];
            ((float*)(F.ws + WS_POSW1))[e] = a; }
        float* bt = (float*)(F.ws + WS_BIAS);
        for (int e = gt; e < 12 * BIASLEN; e += NGT) {
            const int h = e / BIASLEN, d = e % BIASLEN;
            bt[e] = F.in[I_RELB][t5_bucket(d) * 12 + h] * LOG2E;
        }
    }
}

template <int MODE>
__device__ __forceinline__ void row_pass(Frame& F, const float* xin, float* xout, bf16* H, const float* lng, const float* lnb, const float* sc, const float* sh) {
    const int gw = F.vcu * NWAVES + F.wave, NGW = F.G * NWAVES;
    for (int m = gw; m < S; m += NGW) {
        const f32x4* xr = (const f32x4*)(xin + (size_t)m * DM) + F.lane;
        f32x4 v[4];
#pragma unroll
        for (int j = 0; j < 4; ++j) v[j] = xr[64 * j];
        if (MODE != 0) {
            float s = 0.f;
#pragma unroll
            for (int j = 0; j < 4; ++j) s += (v[j].x + v[j].y) + (v[j].z + v[j].w);
            const float mean = wave_sum(s) * (1.f / DM); float s2 = 0.f;
#pragma unroll
            for (int j = 0; j < 4; ++j) { v[j] = v[j] - mean; s2 += (v[j].x * v[j].x + v[j].y * v[j].y) + (v[j].z * v[j].z + v[j].w * v[j].w); }
            const float rstd = 1.f / sqrtf(wave_sum(s2) * (1.f / DM) + LN_EPS);
            f32x4* xo = (f32x4*)(xout + (size_t)m * DM) + F.lane;
#pragma unroll
            for (int j = 0; j < 4; ++j) { const f32x4 g = ((const f32x4*)lng)[F.lane + 64 * j], b = ((const f32x4*)lnb)[F.lane + 64 * j]; v[j] = v[j] * rstd * g + b; xo[64 * j] = v[j]; }
        }
        if (MODE != 2) {
            v2u* o8 = (v2u*)(H + (size_t)m * DM) + F.lane;
#pragma unroll
            for (int j = 0; j < 4; ++j) { const f32x4 a = ((const f32x4*)sc)[F.lane + 64 * j] + 1.0f, b = ((const f32x4*)sh)[F.lane + 64 * j]; const f32x4 h = v[j] * a + b;
                o8[64 * j] = (v2u){pk2(h.x, h.y), pk2(h.z, h.w)}; }
        }
    }
}

typedef GAS unsigned gu32;
typedef GAS unsigned long long gu64;
#define RLX_AGENT __ATOMIC_RELAXED, __HIP_MEMORY_SCOPE_AGENT
__device__ __forceinline__ unsigned long long rt() { return __builtin_amdgcn_s_memrealtime(); }

#define XB_TMO      128
#define XB_XCNT(j)  (256  + 64 * (j))
#define XB_XSUB(j)  (1280 + 64 * (j))
#define XB_XGEN(j)  (2304 + 64 * (j))
#define XB_TOP      3328
#define XB_TOPGEN   3392
#define XCD_BAR_WORDS 3456
#define XB_SPIN_CAP (1u << 18)

__device__ __forceinline__ unsigned xb_ld(unsigned* p)              { return __hip_atomic_load(p, __ATOMIC_RELAXED, __HIP_MEMORY_SCOPE_AGENT); }
__device__ __forceinline__ unsigned xb_add(unsigned* p, unsigned v) { return __hip_atomic_fetch_add(p, v, __ATOMIC_RELAXED, __HIP_MEMORY_SCOPE_AGENT); }
__device__ __forceinline__ unsigned xb_xcc_id() { return (unsigned)__builtin_amdgcn_s_getreg((3 << 11) | 20) & 0xFu; }
#define XB_SPIN(cond, bar) do { unsigned _sp = 0; while (cond) { __builtin_amdgcn_s_sleep(1); \
    if ((++_sp & 255u) == 0u) { if (xb_ld(&(bar)[XB_TMO])) break; if (_sp > XB_SPIN_CAP) { atomicAdd(&(bar)[XB_TMO], 1u); break; } } } } while (0)

struct XcdBarrier {
    unsigned* bar; unsigned x;
    volatile LAS unsigned* st;
};

__device__ __forceinline__ XcdBarrier xcd_barrier_post(unsigned* bar, volatile LAS unsigned* st) {
    XcdBarrier b; b.bar = bar; b.x = xb_xcc_id(); b.st = st;
    if (threadIdx.x == 0) (void)xb_add(&bar[XB_XCNT(b.x)], 1u);
    return b;
}
__device__ __forceinline__ void xcd_barrier_complete(unsigned* bar, unsigned x, unsigned& nloc, unsigned& nx) {
    const unsigned G = gridDim.x * gridDim.y * gridDim.z;
    unsigned sum, cnt, mine, sp = 0u;
    for (;;) {
        sum = 0u; cnt = 0u; mine = 0u;
#pragma unroll
        for (unsigned j = 0; j < 16; ++j) { const unsigned c = xb_ld(&bar[XB_XCNT(j)]); sum += c; cnt += (c > 0u) ? 1u : 0u; mine = (j == x) ? c : mine; }
        if (sum == G) break;
        __builtin_amdgcn_s_sleep(1);
        if ((++sp & 255u) == 0u) { if (xb_ld(&bar[XB_TMO])) break; if (sp > XB_SPIN_CAP) { atomicAdd(&bar[XB_TMO], 1u); break; } }
    }
    nloc = mine > 0u ? mine : 1u; nx = cnt > 0u ? cnt : 1u;
}

__device__ __forceinline__ void xcd_barrier(const XcdBarrier& b) {
    asm volatile("s_waitcnt vmcnt(0)" ::: "memory");
    __syncthreads();
    if (threadIdx.x == 0) {
        unsigned* bar = b.bar;
        __builtin_amdgcn_s_waitcnt(0);
        unsigned nloc = b.st[0], nx = b.st[1];
        if (nloc == 0u) { xcd_barrier_complete(bar, b.x, nloc, nx); b.st[0] = nloc; b.st[1] = nx; }
        const unsigned old = xb_add(&bar[XB_XSUB(b.x)], 1u);
        const unsigned gen = old / nloc;
        if (old + 1u == (gen + 1u) * nloc) {
            __builtin_amdgcn_fence(__ATOMIC_RELEASE, "agent");
            asm volatile("s_waitcnt vmcnt(0)" ::: "memory");
            const unsigned og = xb_add(&bar[XB_TOP], 1u);
            const unsigned tg = og / nx;
            if (og + 1u == (tg + 1u) * nx) xb_add(&bar[XB_TOPGEN], 1u);
            else XB_SPIN(xb_ld(&bar[XB_TOPGEN]) == tg, bar);
            __builtin_amdgcn_fence(__ATOMIC_ACQUIRE, "agent");
            xb_add(&bar[XB_XGEN(b.x)], 1u);
            asm volatile("s_waitcnt vmcnt(0)" ::: "memory");
        } else {
            XB_SPIN(xb_ld(&bar[XB_XGEN(b.x)]) == gen, bar);
            __builtin_amdgcn_fence(__ATOMIC_ACQUIRE, "agent");
            asm volatile("s_waitcnt vmcnt(0)" ::: "memory");
        }
    }
    __syncthreads();
}


__device__ __forceinline__ float ld_elem(const bf16* p) { return bf2f(*p); }
__device__ __forceinline__ float ld_elem(const float* p) { return *p; }
template <int G>
__device__ __forceinline__ void dot64(const bf16* k, const LAS float* qs, float (&s)[G]) {
    const v4u* kp = (const v4u*)k;
#pragma unroll 2
    for (int c = 0; c < 8; ++c) { const v4u w = kp[c];
        float kv[8] = {bflo(w.x), bfhi(w.x), bflo(w.y), bfhi(w.y), bflo(w.z), bfhi(w.z), bflo(w.w), bfhi(w.w)};
#pragma unroll
        for (int g = 0; g < G; ++g) { const LAS f32x4* q4 = (const LAS f32x4*)(qs + g * 64 + c * 8); const f32x4 a = q4[0], b = q4[1];
            s[g] += kv[0] * a.x + kv[1] * a.y + kv[2] * a.z + kv[3] * a.w + kv[4] * b.x + kv[5] * b.y + kv[6] * b.z + kv[7] * b.w; } }
}
template <int G>
__device__ __forceinline__ void dot64(const float* k, const LAS float* qs, float (&s)[G]) {
    const f32x4* kp = (const f32x4*)k;
#pragma unroll 2
    for (int c = 0; c < 16; ++c) { const f32x4 w = kp[c];
#pragma unroll
        for (int g = 0; g < G; ++g) { const f32x4 a = *(const LAS f32x4*)(qs + g * 64 + c * 4); s[g] += w.x * a.x + w.y * a.y + w.z * a.z + w.w * a.w; } }
}
template <int G, class KT, class KeyFn>
__device__ __forceinline__ void wave_attend(const KT* K, const KT* V, const LAS float* qs, int nk, const KeyFn& kf, float (&m)[G], float (&l)[G], float (&o)[G], int lane) {
    for (int base = 0; base < nk; base += 64) {
        const int i = base + lane;
        long off = 0; float s[G], p[G];
#pragma unroll
        for (int g = 0; g < G; ++g) s[g] = 0.f;
        bool valid = false;
        if (i < nk) valid = kf(i, off, s);
        const LAS float* qo = qs; asm volatile("" : "+v"(qo));
        if (valid) dot64<G>(K + off, qo, s);
        const unsigned long long mask = __ballot(valid);
        if (mask == 0ull) continue;
#pragma unroll
        for (int g = 0; g < G; ++g) {
            const float sv = valid ? s[g] : -1e30f;
            const float mn = fmaxf(m[g], wave_max(sv));
            const float scl = exp2f(m[g] - mn);
            p[g] = valid ? exp2f(sv - mn) : 0.f;
            l[g] = l[g] * scl + wave_sum(p[g]); o[g] *= scl; m[g] = mn;
        }
#pragma unroll 2
        for (int j = 0; j < 64; ++j) {
            if (!((mask >> j) & 1ull)) continue;
            const unsigned olo = __builtin_amdgcn_readlane((unsigned)(unsigned long long)off, j), ohi = __builtin_amdgcn_readlane((unsigned)((unsigned long long)off >> 32), j);
            const long oj = (long)(((unsigned long long)ohi << 32) | olo);
            const float v = ld_elem(V + oj + lane);
#pragma unroll
            for (int g = 0; g < G; ++g) o[g] += __uint_as_float(__builtin_amdgcn_readlane(__float_as_uint(p[g]), j)) * v;
        }
    }
}

struct KeyA { int p, r; const float* bias; __device__ __forceinline__ bool operator()(int i, long& off, float (&b)[1]) const {
    const int row = p - r * i; if (row < 0) return false; off = (long)row * NINP; const int d = r * i; b[0] = bias[d < BIASLEN ? d : BIASLEN - 1]; return true; } };
struct KeyB { int p; __device__ __forceinline__ bool operator()(int i, long& off, float (&b)[2]) const {
    const int row = p - i; if (row < 0) return false; off = (long)row * NINP; return true; } };
struct KeyW { int p; const float* bias; __device__ __forceinline__ bool operator()(int i, long& off, float (&b)[4]) const {
    const int row = p - i; if (row < 0) return false; off = (long)row * NINP;
#pragma unroll
    for (int g = 0; g < 4; ++g) b[g] = bias[g * BIASLEN + i]; return true; } };

__device__ __forceinline__ void load_q(const bf16* q, LAS float* qs, int lane) { qs[lane] = bf2f(q[lane]); }

__device__ __forceinline__ void p2_token_attention(Frame& F, int layer, const bf16* PROJ, bf16* MIXED, bf16* OWIN) {
    LAS float* qs = (LAS float*)(F.lds + F.wave * 2048);
    const int gw = F.vcu * NWAVES + F.wave, NGW = F.G * NWAVES, lane = F.lane;
    const float* bias2 = (const float*)(F.ws + WS_BIAS);
    for (int it = gw; it < S * 4; it += NGW) {
        const int p = it >> 2, h = it & 3;
        load_q(PROJ + (size_t)p * NINP + C_AQ + h * 64, qs, lane); LDS_WAIT(); asm volatile("" ::: "memory");
        float m[1] = {-1e30f}, l[1] = {0.f}, o[1] = {0.f};
        const bf16* K = PROJ + C_AK + h * 64; const bf16* V = PROJ + C_AV + h * 64;
#pragma unroll 1
        for (int c = 0; c < 3; ++c) { const int r = c == 0 ? 1 : (c == 1 ? 4 : 16); KeyA kf{p, r, bias2 + h * BIASLEN}; wave_attend<1>(K, V, qs, 129, kf, m, l, o, lane); }
        MIXED[(size_t)p * DM + h * 64 + lane] = (bf16)f2bf(o[0] / l[0]);
        LDS_WAIT(); asm volatile("" ::: "memory");
    }
    for (int it = gw; it < S * 2; it += NGW) {
        const int p = it >> 1, kvh = it & 1;
        load_q(PROJ + (size_t)p * NINP + C_BQ + (2 * kvh) * 64, qs, lane); load_q(PROJ + (size_t)p * NINP + C_BQ + (2 * kvh + 1) * 64, qs + 64, lane); LDS_WAIT(); asm volatile("" ::: "memory");
        float m[2] = {-1e30f, -1e30f}, l[2] = {0.f, 0.f}, o[2] = {0.f, 0.f};
        KeyB kf{p}; wave_attend<2>(PROJ + C_BK + kvh * 64, PROJ + C_BV + kvh * 64, qs, 128, kf, m, l, o, lane);
#pragma unroll
        for (int g = 0; g < 2; ++g) { const float sk = F.in[I_SINK][layer * 4 + 2 * kvh + g] * LOG2E; const float mn = fmaxf(m[g], sk); const float scl = exp2f(m[g] - mn);
            const float den = l[g] * scl + exp2f(sk - mn); MIXED[(size_t)p * DM + 256 + (2 * kvh + g) * 64 + lane] = (bf16)f2bf(o[g] * scl / den); }
        LDS_WAIT(); asm volatile("" ::: "memory");
    }
    for (int it = gw; it < S * 2; it += NGW) {
        const int p = it >> 1, kvh = it & 1;
#pragma unroll
        for (int g = 0; g < 4; ++g) load_q(PROJ + (size_t)p * NINP + C_CQ + (4 * kvh + g) * 64, qs + g * 64, lane);
        LDS_WAIT(); asm volatile("" ::: "memory");
        float m[4] = {-1e30f, -1e30f, -1e30f, -1e30f}, l[4] = {0.f, 0.f, 0.f, 0.f}, o[4] = {0.f, 0.f, 0.f, 0.f};
        KeyW kf{p, bias2 + (4 + 4 * kvh) * BIASLEN}; wave_attend<4>(PROJ + C_CKW + kvh * 64, PROJ + C_CVW + kvh * 64, qs, 512, kf, m, l, o, lane);
#pragma unroll
        for (int g = 0; g < 4; ++g) OWIN[(size_t)p * 512 + (4 * kvh + g) * 64 + lane] = (bf16)f2bf(o[g] / l[g]);
        LDS_WAIT(); asm volatile("" ::: "memory");
    }
}

__device__ __forceinline__ float gelu_tanh(float x) { const float u = 0.7978845608028654f * (x + 0.044715f * x * x * x); return 0.5f * x * (1.0f + tanhf(u)); }
__device__ __forceinline__ void p2_compress(Frame& F, int layer, const bf16* PROJ) {
    LAS float* flat = (LAS float*)F.lds;
    LAS float* hid = flat + 8 * 2048;
    const int tid = F.tid;
    for (int it = F.vcu; it < 2 * 256; it += F.G) {
        const int kv = it >> 8, rg = it & 255;
        const float* pos = F.in[I_CPOS] + ((size_t)layer * 2 + kv) * 2048;
        const float* w1 = F.in[I_CW1] + ((size_t)layer * 2 + kv) * 2048 * 256;
        const float* w2 = F.in[I_CW2] + ((size_t)layer * 2 + kv) * 256 * 64;
        float* outp = (float*)(F.ws + (kv ? WS_VC : WS_KC));
        __syncthreads();
        for (int e = tid; e < 8 * 2048; e += NTHREADS) {
            const int r = e >> 11, f = e & 2047, R = rg * 8 + r, i = R >> 1, hk = R & 1, t = f >> 6, d = f & 63;
            float v = 0.f;
            if (i < NCMP) v = bf2f(PROJ[(size_t)(16 * i + t) * NINP + (kv ? C_CVC : C_CKC) + hk * 64 + d]) + pos[f];
            flat[e] = v;
        }
        __syncthreads();
        { const int j = tid & 255, half = tid >> 8; float a[4] = {0.f, 0.f, 0.f, 0.f}; const LAS float* fl = flat + half * 4 * 2048;
#pragma unroll 4
            for (int f = 0; f < 2048; ++f) { const float w = w1[(size_t)f * 256 + j];
#pragma unroll
                for (int r = 0; r < 4; ++r) a[r] += fl[r * 2048 + f] * w; }
#pragma unroll
            for (int r = 0; r < 4; ++r) hid[(half * 4 + r) * 256 + j] = gelu_tanh(a[r]); }
        __syncthreads();
        { const int r = tid >> 6, e = tid & 63, R = rg * 8 + r; float a = 0.f;
#pragma unroll 8
            for (int j = 0; j < 256; ++j) a += hid[r * 256 + j] * w2[j * 64 + e];
            if ((R >> 1) < NCMP) { outp[(size_t)R * 64 + e] = a; const unsigned ab = f2bf(a); ((bf16*)(F.ws + (kv ? WS_VCB : WS_KCB)))[(size_t)R * 64 + e] = (bf16)ab;
                const float ar = bf2f((unsigned short)ab); const float n2 = wave_sum(ar * ar);
                if (kv == 0 && e == 0) __hip_atomic_fetch_max((unsigned*)(F.ws + WS_CTL) + CW_MAX + layer * 16 + (R & 1), __float_as_uint(n2), __ATOMIC_RELAXED, __HIP_MEMORY_SCOPE_AGENT); } }
    }
    __syncthreads();
}

struct KeyCmp { int g; __device__ __forceinline__ bool operator()(int i, long& off, float (&b)[4]) const { off = ((long)i * 2 + g) * 64; return true; } };
struct KeySel { int p, blk; const float* bias; __device__ __forceinline__ bool operator()(int i, long& off, float (&b)[4]) const {
    const int kpos = blk * 64 + i; if (kpos > p) return false; off = (long)kpos * NINP; const int d = p - kpos;
#pragma unroll
    for (int g = 0; g < 4; ++g) b[g] = bias[g * BIASLEN + (d < BIASLEN ? d : BIASLEN - 1)]; return true; } };

__device__ __forceinline__ void p3_nsa(Frame& F, int layer, const bf16* PROJ, const bf16* OWIN, bf16* MIXED) {
    LAS float* qs = (LAS float*)(F.lds + F.wave * 8192);
    LAS float* imp = qs + 256;
    const int gw = F.vcu * NWAVES + F.wave, NGW = F.G * NWAVES, lane = F.lane;
    const float* bias2 = (const float*)(F.ws + WS_BIAS);
    const float* KC = (const float*)(F.ws + WS_KC); const float* VC = (const float*)(F.ws + WS_VC);
    for (int it = gw; it < S * 2; it += NGW) {
        const int p = it >> 1, kvh = it & 1;
#pragma unroll
        for (int g = 0; g < 4; ++g) load_q(PROJ + (size_t)p * NINP + C_CQ + (4 * kvh + g) * 64, qs + g * 64, lane);
        for (int e = lane; e < 1040; e += 64) imp[e] = 0.f;
        LDS_WAIT(); asm volatile("" ::: "memory");
        int nv = p >= 31 ? ((p - 31) >> 4) + 1 : 0; if (nv > NCMP) nv = NCMP;
        float m1[4] = {-1e30f, -1e30f, -1e30f, -1e30f}, l1[4] = {0.f, 0.f, 0.f, 0.f}, o1[4] = {0.f, 0.f, 0.f, 0.f};
        { KeyCmp kf{kvh}; wave_attend<4>(KC, VC, qs, nv, kf, m1, l1, o1, lane); }
        for (int base = 0; base < nv; base += 64) { const int i = base + lane;
            const LAS float* qo = qs; asm volatile("" : "+v"(qo));
            if (i < nv) { float s[4] = {0.f, 0.f, 0.f, 0.f}; dot64<4>(KC + ((size_t)i * 2 + kvh) * 64, qo, s); float a = 0.f;
#pragma unroll
                for (int g = 0; g < 4; ++g) a += exp2f(s[g] - m1[g]) / fmaxf(l1[g], 1e-30f);
                imp[1 + i] = a; } }
        LDS_WAIT(); asm volatile("" ::: "memory");
        const int cur = p >> 6;
        float sc[4];
#pragma unroll
        for (int c = 0; c < 4; ++c) { const int j = lane + 64 * c; const LAS float* q = imp + 4 * j;
            const float is = 0.5f * q[0] + q[1] + q[2] + q[3] + 0.5f * q[4];
            const bool forced = (j == 0) || (j == cur) || (j == cur - 1);
            sc[c] = forced ? 1e4f : ((j * 64 <= p) ? is : -1e30f); }
        float m2[4] = {-1e30f, -1e30f, -1e30f, -1e30f}, l2[4] = {0.f, 0.f, 0.f, 0.f}, o2[4] = {0.f, 0.f, 0.f, 0.f};
#pragma unroll 1
        for (int k = 0; k < 16; ++k) {
            float bv = sc[0]; int bi = lane;
#pragma unroll
            for (int c = 1; c < 4; ++c) if (sc[c] > bv) { bv = sc[c]; bi = lane + 64 * c; }
#pragma unroll
            for (int off = 1; off < 64; off <<= 1) { const float ov = __shfl_xor(bv, off); const int oi = __shfl_xor(bi, off); if (ov > bv || (ov == bv && oi < bi)) { bv = ov; bi = oi; } }
#pragma unroll
            for (int c = 0; c < 4; ++c) if (bi == lane + 64 * c) sc[c] = -3e38f;
            if (bi * 64 <= p) { KeySel kf{p, bi, bias2 + (4 + 4 * kvh) * BIASLEN}; wave_attend<4>(PROJ + C_CKS + kvh * 64, PROJ + C_CVS + kvh * 64, qs, 64, kf, m2, l2, o2, lane); }
        }
#pragma unroll
        for (int g = 0; g < 4; ++g) { const int H = 4 * kvh + g;
            const float g0 = bf2f(PROJ[(size_t)p * NINP + C_CG + H * 3 + 0]), g1 = bf2f(PROJ[(size_t)p * NINP + C_CG + H * 3 + 1]), g2 = bf2f(PROJ[(size_t)p * NINP + C_CG + H * 3 + 2]);
            const float ocmp = o1[g] / fmaxf(l1[g], 1e-30f), oslc = o2[g] / l2[g], owin = bf2f(OWIN[(size_t)p * 512 + H * 64 + lane]);
            MIXED[(size_t)p * DM + 512 + H * 64 + lane] = (bf16)f2bf(g0 * ocmp + g1 * oslc + g2 * owin); }
        LDS_WAIT(); asm volatile("" ::: "memory");
    }
}


namespace ba {
typedef short bf16x8 __attribute__((ext_vector_type(8)));
typedef short s16x4 __attribute__((ext_vector_type(4)));
typedef short v4i16_t __attribute__((ext_vector_type(4)));
typedef float f32x16 __attribute__((ext_vector_type(16)));
typedef float f32x2_t __attribute__((ext_vector_type(2))); typedef __bf16 bf16x2_t __attribute__((ext_vector_type(2)));
typedef LAS const char* lds_cptr;
__device__ __forceinline__ unsigned cvtpk(float lo, float hi) { f32x2_t v = {lo, hi}; bf16x2_t b = __builtin_convertvector(v, bf16x2_t); return __builtin_bit_cast(unsigned, b); }
__device__ __forceinline__ s16x4 vtr(lds_cptr p) { return __builtin_bit_cast(s16x4, __builtin_amdgcn_ds_read_tr16_b64_v4i16((LAS v4i16_t*)p)); }
__device__ __forceinline__ float half_sum(float x) { auto rr = __builtin_amdgcn_permlane32_swap(__float_as_uint(x), __float_as_uint(x), false, false); return __uint_as_float(rr[0]) + __uint_as_float(rr[1]); }
constexpr int KIMG = 0, VIMG = 49152, TBL = 98304, WSCR = 108544, KMAX = 110592;

struct Unit {
    const bf16* Q; const bf16* K; const bf16* V;
    bf16* O; int opitch;
    float* lse; int lse_pitch;
    const float* bias;
    const float* bmax;
    const float* sink;
    int rs, rho, u0;
    int W, Wp;
};

template <int NT, int NH>
__device__ __forceinline__ void run_unit(LAS unsigned char* lds, const Unit& U, int wave, int lane, int tid) {
    static_assert(NT * NH == 8, "one wave-task per wave");
    const int r32 = lane & 31, hi = lane >> 5;
    const int NQ = 32 * NT, NKT = U.Wp + NQ, nch = (NKT + 383) / 384, CH = NKT / nch;
    const int tile = wave % NT, hl = wave / NT, uw = U.u0 + 32 * tile;
    const int TW = U.Wp + 64;
    __syncthreads();
    for (int e = tid; e < NH * TW; e += NTHREADS) { const int h = e / TW, dist = e % TW - 32;
        float v = -1e30f; if (dist >= 0 && dist <= U.W) { v = 0.f; if (U.bias) { const int td = dist * U.rs; v = U.bias[h * BIASLEN + (td < BIASLEN ? td : BIASLEN - 1)]; } }
        ((LAS float*)(lds + TBL))[e] = v; }
    if (tid == 0) *(LAS unsigned*)(lds + KMAX) = 0u;
    __syncthreads();
    { float mx = 0.f;
      for (int idx = tid; idx < NKT * 8; idx += NTHREADS) { const int n = idx >> 3, c = idx & 7, u = U.u0 - U.Wp + n; float s = 0.f;
          if (u >= 0) { const v4u w = *(const v4u*)(U.K + (size_t)(U.rho + U.rs * u) * NINP + c * 8);
              const float a0 = bflo(w.x), a1 = bfhi(w.x), a2 = bflo(w.y), a3 = bfhi(w.y), a4 = bflo(w.z), a5 = bfhi(w.z), a6 = bflo(w.w), a7 = bfhi(w.w);
              s = a0 * a0 + a1 * a1 + a2 * a2 + a3 * a3 + a4 * a4 + a5 * a5 + a6 * a6 + a7 * a7; }
          s += __shfl_xor(s, 1); s += __shfl_xor(s, 2); s += __shfl_xor(s, 4); mx = fmaxf(mx, s); }
      mx = wave_max(mx);
      if (lane == 0) __hip_atomic_fetch_max((LAS unsigned*)(lds + KMAX), __float_as_uint(mx), __ATOMIC_RELAXED, __HIP_MEMORY_SCOPE_WORKGROUP); }
    const int qtok = U.rho + U.rs * (uw + r32);
    bf16x8 qr[4]; float qn = 0.f;
    { const bf16* qp = U.Q + (size_t)qtok * NINP + hl * 64 + hi * 8;
#pragma unroll
      for (int d0 = 0; d0 < 4; ++d0) { qr[d0] = *(const bf16x8*)(qp + d0 * 16);
#pragma unroll
          for (int j = 0; j < 8; ++j) { const float x = bf2f((unsigned short)qr[d0][j]); qn += x * x; } }
      qn = half_sum(qn); }
    __syncthreads();
    const float kmax2 = __uint_as_float(*(LAS unsigned*)(lds + KMAX));
    float M = sqrtf(qn * kmax2) * 1.0002f + 1e-6f;
    if (U.bmax) M += fmaxf(U.bmax[hl], 0.f);
    float sink2 = 0.f; if (U.sink) { sink2 = U.sink[hl] * LOG2E; M = fmaxf(M, sink2); }
    f32x16 negm;
#pragma unroll
    for (int r = 0; r < 16; ++r) negm[r] = -M;
    f32x16 o0 = {}, o1 = {}; float lsum = 0.f;
    const LAS float* tbl = (const LAS float*)(lds + TBL) + hl * TW;
    for (int ck = 0; ck < nch; ++ck) {
        const int kc0 = U.u0 - U.Wp + ck * CH;
        if (ck > 0) __syncthreads();
        for (int idx = tid; idx < CH * 16; idx += NTHREADS) { const int n = idx >> 4, isv = (idx >> 3) & 1, c = idx & 7, u = kc0 + n;
            v4u w = {0u, 0u, 0u, 0u};
            if (u >= 0) w = *(const v4u*)((isv ? U.V : U.K) + (size_t)(U.rho + U.rs * u) * NINP + c * 8);
            if (isv) *(LAS v4u*)(lds + VIMG + (c >> 2) * (CH * 64) + n * 64 + (c & 3) * 16) = w;
            else     *(LAS v4u*)(lds + KIMG + c * (CH * 16) + n * 16) = w; }
        __syncthreads();
        const int nbt = U.Wp / 32 + 1;
        for (int t = 0; t < nbt; ++t) {
            const int kt0 = uw - U.Wp + 32 * t, kl = kt0 - kc0;
            if (kt0 < 0 || kl < 0 || kl >= CH) continue;
            f32x16 s;
            { const lds_cptr kb = (lds_cptr)(lds + KIMG) + hi * (CH * 16) + (kl + r32) * 16;
#pragma unroll
              for (int d0 = 0; d0 < 4; ++d0) { const bf16x8 kf = *(const LAS bf16x8*)(kb + d0 * (2 * CH * 16));
                  s = __builtin_amdgcn_mfma_f32_32x32x16_bf16(kf, qr[d0], d0 == 0 ? negm : s, 0, 0, 0); } }
            { const LAS float* tb = tbl + (U.Wp - 32 * t) + r32 - 4 * hi + 32 - 27;
#pragma unroll
              for (int r = 0; r < 16; ++r) s[r] = __builtin_amdgcn_exp2f(s[r] + tb[27 - ((r & 3) + 8 * (r >> 2))]); }
            float ps = 0.f;
#pragma unroll
            for (int r = 0; r < 16; ++r) ps += s[r];
            lsum += ps;
            bf16x8 pa0, pa1;
            { v4u w0 = {cvtpk(s[0], s[1]), cvtpk(s[2], s[3]), cvtpk(s[4], s[5]), cvtpk(s[6], s[7])}, w1 = {cvtpk(s[8], s[9]), cvtpk(s[10], s[11]), cvtpk(s[12], s[13]), cvtpk(s[14], s[15])};
              pa0 = __builtin_bit_cast(bf16x8, w0); pa1 = __builtin_bit_cast(bf16x8, w1); }
            { const lds_cptr vp = (lds_cptr)(lds + VIMG) + ((lane >> 4) & 1) * 32 + (lane & 3) * 8 + (kl + 4 * hi + ((lane & 15) >> 2)) * 64;
#pragma unroll
              for (int dh = 0; dh < 2; ++dh)
#pragma unroll
                  for (int g = 0; g < 2; ++g) { const s16x4 lo = vtr(vp + dh * (CH * 64) + g * 1024), hv = vtr(vp + dh * (CH * 64) + g * 1024 + 512);
                      const bf16x8 vf = {lo[0], lo[1], lo[2], lo[3], hv[0], hv[1], hv[2], hv[3]};
                      if (dh == 0) o0 = __builtin_amdgcn_mfma_f32_32x32x16_bf16(g == 0 ? pa0 : pa1, vf, o0, 0, 0, 0);
                      else         o1 = __builtin_amdgcn_mfma_f32_32x32x16_bf16(g == 0 ? pa0 : pa1, vf, o1, 0, 0, 0); } }
        }
    }
    float l = half_sum(lsum);
    if (U.sink) l += exp2f(sink2 - M);
    LAS float* wsf = (LAS float*)(lds + WSCR) + wave * 64;
    if (hi == 0) wsf[r32] = 1.0f / l;
    if (U.lse && hi == 0) U.lse[(size_t)qtok * U.lse_pitch + hl] = M + log2f(l);
    LDS_WAIT(); asm volatile("" ::: "memory");
#pragma unroll
    for (int r = 0; r < 16; ++r) { const int qo = (r & 3) + 8 * (r >> 2) + 4 * hi; const float rl = wsf[qo];
        bf16* op = U.O + (size_t)(U.rho + U.rs * (uw + qo)) * U.opitch + hl * 64 + r32;
        op[0] = (bf16)f2bf(o0[r] * rl); op[32] = (bf16)f2bf(o1[r] * rl); }
}
}

constexpr int P2_NA = 3 * 4 * 64, P2_NB = 2 * 128, P2_NC = 2 * 256, P2_NUNITS = P2_NA + P2_NB + P2_NC;
__device__ __forceinline__ void p2_banded(Frame& F, int layer, const bf16* PROJ, bf16* MIXED, bf16* OWIN) {
    const float* bias2 = (const float*)(F.ws + WS_BIAS); const float* bmax = (const float*)(F.ws + WS_BMAX);
    bf16* OA3 = (bf16*)(F.ws + WS_OA3); float* LSE = (float*)(F.ws + WS_LSE);
    for (int it = F.vcu; it < P2_NUNITS; it += F.G) {
        ba::Unit U{};
        if (it < P2_NC) { const int kvh = it & 1, blk = it >> 1;
            U.Q = PROJ + C_CQ + kvh * 256; U.K = PROJ + C_CKW + kvh * 64; U.V = PROJ + C_CVW + kvh * 64; U.O = OWIN + kvh * 256; U.opitch = 512;
            U.bias = bias2 + (4 + 4 * kvh) * BIASLEN; U.bmax = bmax + 4 + 4 * kvh; U.rs = 1; U.rho = 0; U.u0 = blk * 64; U.W = 511; U.Wp = 512;
            ba::run_unit<2, 4>(F.lds, U, F.wave, F.lane, F.tid);
        } else if (it < P2_NC + P2_NA) { const int a = it - P2_NC, h = a & 3, c = (a >> 2) % 3, blk = (a >> 2) / 3;
            const int rs = c == 0 ? 1 : (c == 1 ? 4 : 16), per = S / rs / 256;
            const int rho = blk / per, ub = blk % per;
            U.Q = PROJ + C_AQ + h * 64; U.K = PROJ + C_AK + h * 64; U.V = PROJ + C_AV + h * 64; U.O = OA3 + (size_t)c * S * 256 + h * 64; U.opitch = 256;
            U.lse = LSE + (size_t)c * S * 4 + h; U.lse_pitch = 4;
            U.bias = bias2 + h * BIASLEN; U.bmax = bmax + h; U.rs = rs; U.rho = rho; U.u0 = ub * 256; U.W = 128; U.Wp = 128;
            ba::run_unit<8, 1>(F.lds, U, F.wave, F.lane, F.tid);
        } else { const int b = it - P2_NC - P2_NA, kvh = b & 1, blk = b >> 1;
            U.Q = PROJ + C_BQ + kvh * 128; U.K = PROJ + C_BK + kvh * 64; U.V = PROJ + C_BV + kvh * 64; U.O = MIXED + 256 + kvh * 128; U.opitch = DM;
            U.sink = F.in[I_SINK] + layer * 4 + 2 * kvh; U.rs = 1; U.rho = 0; U.u0 = blk * 128; U.W = 127; U.Wp = 128;
            ba::run_unit<4, 2>(F.lds, U, F.wave, F.lane, F.tid);
        }
    }
    __syncthreads();
}
__device__ __forceinline__ void merge_dilated(Frame& F, bf16* MIXED) {
    const bf16* OA3 = (const bf16*)(F.ws + WS_OA3); const float* LSE = (const float*)(F.ws + WS_LSE);
    const int gw = F.vcu * NWAVES + F.wave, NGW = F.G * NWAVES, lane = F.lane, h = lane >> 4;
    for (int p = gw; p < S; p += NGW) {
        const float l0 = LSE[(size_t)p * 4 + h], l1 = LSE[(size_t)(S + p) * 4 + h], l2 = LSE[(size_t)(2 * S + p) * 4 + h];
        const float mx = fmaxf(l0, fmaxf(l1, l2)); const float e0 = exp2f(l0 - mx), e1 = exp2f(l1 - mx), e2 = exp2f(l2 - mx), inv = 1.0f / (e0 + e1 + e2);
        const v2u a = *(const v2u*)(OA3 + (size_t)p * 256 + lane * 4), b = *(const v2u*)(OA3 + (size_t)(S + p) * 256 + lane * 4), c = *(const v2u*)(OA3 + (size_t)(2 * S + p) * 256 + lane * 4);
        const float w0 = e0 * inv, w1 = e1 * inv, w2 = e2 * inv;
        const float r0 = w0 * bflo(a.x) + w1 * bflo(b.x) + w2 * bflo(c.x), r1 = w0 * bfhi(a.x) + w1 * bfhi(b.x) + w2 * bfhi(c.x);
        const float r2 = w0 * bflo(a.y) + w1 * bflo(b.y) + w2 * bflo(c.y), r3 = w0 * bfhi(a.y) + w1 * bfhi(b.y) + w2 * bfhi(c.y);
        *(v2u*)(MIXED + (size_t)p * DM + lane * 4) = (v2u){pk2(r0, r1), pk2(r2, r3)};
    }
}


namespace ca {
using ba::bf16x8; using ba::s16x4; using ba::f32x16; using ba::lds_cptr; using ba::cvtpk; using ba::vtr; using ba::half_sum;
constexpr int CH = 256, KIMG = 0, VIMG = 32768, IMPSEL = 65536, IMPQ = 264  , IMPW = 8 * IMPQ * 4  , WSCR = IMPSEL + 8 * IMPW;
static_assert(WSCR + 8 * 512 <= RING_BYTES, "P3a LDS map");
__device__ __forceinline__ float quad_sum(float x) {
    x += __int_as_float(__builtin_amdgcn_update_dpp(0, __float_as_int(x), 0xB1, 0xF, 0xF, true));
    x += __int_as_float(__builtin_amdgcn_update_dpp(0, __float_as_int(x), 0x4E, 0xF, 0xF, true));
    return x;
}
__device__ __forceinline__ void stage_chunk(LAS unsigned char* lds, const bf16* KCb, const bf16* VCb, int kvh, int kc0, bool with_v, int tid) {
    for (int idx = tid; idx < CH * 16; idx += NTHREADS) { const int n = idx >> 4, isv = (idx >> 3) & 1, c = idx & 7, i = kc0 + n;
        if (isv && !with_v) continue;
        v4u w = {0u, 0u, 0u, 0u};
        if (i < NCMP) w = *(const v4u*)((isv ? VCb : KCb) + ((size_t)i * 2 + kvh) * 64 + c * 8);
        if (isv) *(LAS v4u*)(lds + VIMG + (c >> 2) * (CH * 64) + n * 64 + (c & 3) * 16) = w;
        else     *(LAS v4u*)(lds + KIMG + c * (CH * 16) + n * 16) = w; }
}
__device__ __forceinline__ void run_unit(LAS unsigned char* lds, const bf16* PROJ, const bf16* KCb, const bf16* VCb, float kcmax2, bf16* OCMP, unsigned* SELB, int kvh, int cur, int wave, int lane, int tid) {
    const int r32 = lane & 31, hi = lane >> 5, p0 = cur * 64;
    const int ql = r32 >> 2, hh = r32 & 3, qpos = p0 + wave * 8 + ql, H = 4 * kvh + hh;
    int nvq = qpos >= 31 ? ((qpos - 31) >> 4) + 1 : 0; if (nvq > NCMP) nvq = NCMP;
    int nvw = (p0 + wave * 8 + 7) >= 31 ? ((p0 + wave * 8 + 7 - 31) >> 4) + 1 : 0; if (nvw > NCMP) nvw = NCMP;
    int nvu = (p0 + 63 - 31) >= 0 ? ((p0 + 63 - 31) >> 4) + 1 : 0; if (nvu > NCMP) nvu = NCMP;
    const int nch = (nvu + CH - 1) / CH;
    bf16x8 qr[4]; float qn = 0.f;
    { const bf16* qp = PROJ + (size_t)qpos * NINP + C_CQ + H * 64 + hi * 8;
#pragma unroll
      for (int d0 = 0; d0 < 4; ++d0) { qr[d0] = *(const bf16x8*)(qp + d0 * 16);
#pragma unroll
          for (int j = 0; j < 8; ++j) { const float x = bf2f((unsigned short)qr[d0][j]); qn += x * x; } }
      qn = half_sum(qn); }
    const float M = sqrtf(qn * kcmax2) * 1.0002f + 1e-6f;
    f32x16 negm;
#pragma unroll
    for (int r = 0; r < 16; ++r) negm[r] = -M;
    LAS float* imps = (LAS float*)(lds + IMPSEL + wave * IMPW);
    __syncthreads();
    for (int e = lane; e < 8 * IMPQ; e += 64) imps[e] = 0.f;
    float lsum = 0.f;
    for (int ck = 0; ck < nch; ++ck) {
        if (ck > 0) __syncthreads();
        stage_chunk(lds, KCb, VCb, kvh, ck * CH, false, tid);
        __syncthreads();
        for (int kl = 0; kl < CH; kl += 32) { const int kt0 = ck * CH + kl; if (kt0 >= nvw) break;
            f32x16 s;
            { const lds_cptr kb = (lds_cptr)(lds + KIMG) + hi * (CH * 16) + (kl + r32) * 16;
#pragma unroll
              for (int d0 = 0; d0 < 4; ++d0) { const bf16x8 kf = *(const LAS bf16x8*)(kb + d0 * (2 * CH * 16)); s = __builtin_amdgcn_mfma_f32_32x32x16_bf16(kf, qr[d0], d0 == 0 ? negm : s, 0, 0, 0); } }
            const int lim = nvq - kt0 - 4 * hi;
#pragma unroll
            for (int r = 0; r < 16; ++r) lsum += ((r & 3) + 8 * (r >> 2)) < lim ? __builtin_amdgcn_exp2f(s[r]) : 0.f; }
    }
    const float rinv = 1.0f / fmaxf(half_sum(lsum), 1e-30f);
    f32x16 o0 = {}, o1 = {};
    for (int ck = 0; ck < nch; ++ck) {
        __syncthreads();
        stage_chunk(lds, KCb, VCb, kvh, ck * CH, true, tid);
        __syncthreads();
        for (int kl = 0; kl < CH; kl += 32) { const int kt0 = ck * CH + kl; if (kt0 >= nvw) break;
            f32x16 s;
            { const lds_cptr kb = (lds_cptr)(lds + KIMG) + hi * (CH * 16) + (kl + r32) * 16;
#pragma unroll
              for (int d0 = 0; d0 < 4; ++d0) { const bf16x8 kf = *(const LAS bf16x8*)(kb + d0 * (2 * CH * 16)); s = __builtin_amdgcn_mfma_f32_32x32x16_bf16(kf, qr[d0], d0 == 0 ? negm : s, 0, 0, 0); } }
            const int lim = nvq - kt0 - 4 * hi;
#pragma unroll
            for (int r = 0; r < 16; ++r) s[r] = ((r & 3) + 8 * (r >> 2)) < lim ? __builtin_amdgcn_exp2f(s[r]) * rinv : 0.f;
            { float mains[4], spills[4];
#pragma unroll
              for (int a = 0; a < 4; ++a) { const float x0 = quad_sum(s[4 * a]), x1 = quad_sum(s[4 * a + 1]), x2 = quad_sum(s[4 * a + 2]), x3 = quad_sum(s[4 * a + 3]);
                  spills[a] = 0.5f * x3; mains[a] = ((x0 + x1) + x2) + spills[a]; }
              const float mn = hh == 0 ? mains[0] : (hh == 1 ? mains[1] : (hh == 2 ? mains[2] : mains[3]));
              const float sp = hh == 0 ? spills[0] : (hh == 1 ? spills[1] : (hh == 2 ? spills[2] : spills[3]));
              const int j = (kt0 >> 2) + 2 * hh + hi;
              __hip_atomic_fetch_add(imps + ql * IMPQ + j, mn, __ATOMIC_RELAXED, __HIP_MEMORY_SCOPE_WORKGROUP);
              __hip_atomic_fetch_add(imps + ql * IMPQ + j + 1, sp, __ATOMIC_RELAXED, __HIP_MEMORY_SCOPE_WORKGROUP); }
            bf16x8 pa0, pa1;
            { v4u w0 = {cvtpk(s[0], s[1]), cvtpk(s[2], s[3]), cvtpk(s[4], s[5]), cvtpk(s[6], s[7])}, w1 = {cvtpk(s[8], s[9]), cvtpk(s[10], s[11]), cvtpk(s[12], s[13]), cvtpk(s[14], s[15])};
              pa0 = __builtin_bit_cast(bf16x8, w0); pa1 = __builtin_bit_cast(bf16x8, w1); }
            { const lds_cptr vp = (lds_cptr)(lds + VIMG) + ((lane >> 4) & 1) * 32 + (lane & 3) * 8 + (kl + 4 * hi + ((lane & 15) >> 2)) * 64;
#pragma unroll
              for (int dh = 0; dh < 2; ++dh)
#pragma unroll
                  for (int g = 0; g < 2; ++g) { const s16x4 lo = vtr(vp + dh * (CH * 64) + g * 1024), hv = vtr(vp + dh * (CH * 64) + g * 1024 + 512);
                      const bf16x8 vf = {lo[0], lo[1], lo[2], lo[3], hv[0], hv[1], hv[2], hv[3]};
                      if (dh == 0) o0 = __builtin_amdgcn_mfma_f32_32x32x16_bf16(g == 0 ? pa0 : pa1, vf, o0, 0, 0, 0);
                      else         o1 = __builtin_amdgcn_mfma_f32_32x32x16_bf16(g == 0 ? pa0 : pa1, vf, o1, 0, 0, 0); } }
        }
    }
#pragma unroll
    for (int r = 0; r < 16; ++r) { const int c = (r & 3) + 8 * (r >> 2) + 4 * hi;
        bf16* op = OCMP + (size_t)(p0 + wave * 8 + (c >> 2)) * 512 + (4 * kvh + (c & 3)) * 64 + r32;
        op[0] = (bf16)f2bf(o0[r]); op[32] = (bf16)f2bf(o1[r]); }
    LDS_WAIT(); asm volatile("" ::: "memory");
#pragma unroll 1
    for (int q = 0; q < 8; ++q) { const int qp = p0 + wave * 8 + q; const LAS float* im = imps + q * IMPQ;
        float sc[4];
#pragma unroll
        for (int c = 0; c < 4; ++c) { const int j = lane + 64 * c; const bool forced = (j == 0) || (j == cur) || (j == cur - 1); sc[c] = forced ? 1e4f : ((j * 64 <= qp) ? im[j] : -1e30f); }
        unsigned bits = 0u;
#pragma unroll 1
        for (int k = 0; k < 16; ++k) {
            float bv = sc[0]; int bi = lane;
#pragma unroll
            for (int c = 1; c < 4; ++c) if (sc[c] > bv) { bv = sc[c]; bi = lane + 64 * c; }
#pragma unroll
            for (int off = 1; off < 64; off <<= 1) { const float ov = __shfl_xor(bv, off); const int oi = __shfl_xor(bi, off); if (ov > bv || (ov == bv && oi < bi)) { bv = ov; bi = oi; } }
#pragma unroll
            for (int c = 0; c < 4; ++c) if (bi == lane + 64 * c) sc[c] = -3e38f;
            if (bi * 64 <= qp && lane == (bi >> 5)) bits |= 1u << (bi & 31);
        }
        if (lane < 8) SELB[((size_t)qp * 2 + kvh) * 8 + lane] = bits;
    }
}
}

__device__ __forceinline__ void p3a_cmp_select(Frame& F, int layer, const bf16* PROJ) {
    const bf16* KCb = (const bf16*)(F.ws + WS_KCB); const bf16* VCb = (const bf16*)(F.ws + WS_VCB);
    bf16* OCMP = (bf16*)(F.ws + WS_OCMP); unsigned* SELB = (unsigned*)(F.ws + WS_SELB);
    const unsigned* mx = (const unsigned*)(F.ws + WS_CTL) + CW_MAX + layer * 16;
    for (int k = F.vcu; k < 256; k += F.G) for (int rep = 0; rep < 2; ++rep) { const int x = rep == 0 ? 511 - k : k;
        const int kvh = x & 1, cur = x >> 1;
        const float kcmax2 = __uint_as_float(__hip_atomic_load(mx + kvh, __ATOMIC_RELAXED, __HIP_MEMORY_SCOPE_AGENT));
        ca::run_unit(F.lds, PROJ, KCb, VCb, kcmax2, OCMP, SELB, kvh, cur, F.wave, F.lane, F.tid); }
    __syncthreads();
}

__device__ __forceinline__ void p3b_naive(Frame& F, int layer, const bf16* PROJ, const bf16* OWIN, bf16* MIXED) {
    LAS float* qs = (LAS float*)(F.lds + F.wave * 2048);
    const int gw = F.vcu * NWAVES + F.wave, NGW = F.G * NWAVES, lane = F.lane;
    const float* bias2 = (const float*)(F.ws + WS_BIAS);
    const bf16* OCMP = (const bf16*)(F.ws + WS_OCMP); const unsigned* SELB = (const unsigned*)(F.ws + WS_SELB);
    for (int it = gw; it < S * 2; it += NGW) {
        const int p = it >> 1, kvh = it & 1;
#pragma unroll
        for (int g = 0; g < 4; ++g) load_q(PROJ + (size_t)p * NINP + C_CQ + (4 * kvh + g) * 64, qs + g * 64, lane);
        LDS_WAIT(); asm volatile("" ::: "memory");
        float m2[4] = {-1e30f, -1e30f, -1e30f, -1e30f}, l2[4] = {0.f, 0.f, 0.f, 0.f}, o2[4] = {0.f, 0.f, 0.f, 0.f};
#pragma unroll 1
        for (int w = 0; w < 8; ++w) { unsigned bits = SELB[((size_t)p * 2 + kvh) * 8 + w];
            while (bits) { const int b = __builtin_ctz(bits); bits &= bits - 1; const int bi = w * 32 + b;
                KeySel kf{p, bi, bias2 + (4 + 4 * kvh) * BIASLEN}; wave_attend<4>(PROJ + C_CKS + kvh * 64, PROJ + C_CVS + kvh * 64, qs, 64, kf, m2, l2, o2, lane); } }
#pragma unroll
        for (int g = 0; g < 4; ++g) { const int H = 4 * kvh + g;
            const float g0 = bf2f(PROJ[(size_t)p * NINP + C_CG + H * 3 + 0]), g1 = bf2f(PROJ[(size_t)p * NINP + C_CG + H * 3 + 1]), g2 = bf2f(PROJ[(size_t)p * NINP + C_CG + H * 3 + 2]);
            const float ocmp = bf2f(OCMP[(size_t)p * 512 + H * 64 + lane]), oslc = o2[g] / l2[g], owin = bf2f(OWIN[(size_t)p * 512 + H * 64 + lane]);
            MIXED[(size_t)p * DM + 512 + H * 64 + lane] = (bf16)f2bf(g0 * ocmp + g1 * oslc + g2 * owin); }
        LDS_WAIT(); asm volatile("" ::: "memory");
    }
}


namespace sa {
using ba::bf16x8; using ba::s16x4; using ba::lds_cptr; using ba::cvtpk; using ba::vtr;
typedef float f32x4v __attribute__((ext_vector_type(4)));
constexpr int SLOTB = 65536, NSLOT = 2, BT = NSLOT * SLOTB, BTH = 1540  , BM = BT + 4 * BTH * 4, LDS_END = BM + 2048;
static_assert(LDS_END <= RING_BYTES, "P3b LDS map");
__device__ __forceinline__ void run_unit(LAS unsigned char* lds, const bf16* PROJ, const unsigned char* KSIMG, const float* bias2, const float* bmax, float ksmax2, const bf16* OCMP, const bf16* OWIN,
                                         const unsigned* SELB, bf16* MIXED, int kvh, int cur, int wave, int lane, int tid) {
    const int p0 = cur * 64, col = lane & 15, g = lane >> 4, qq = col >> 2, hh = col & 3, H = 4 * kvh + hh;
    __syncthreads();
    for (int e = tid; e < 4 * BTH; e += NTHREADS) { const int h = e / BTH, i = e % BTH; int d = i - 3; d = d < 0 ? 0 : (d > 1535 ? 1535 : d);
        ((LAS float*)(lds + BT))[e] = bias2[(4 + 4 * kvh + h) * BIASLEN + d]; }
    ((LAS unsigned*)(lds + BM))[tid] = SELB[((size_t)(p0 + (tid >> 3)) * 2 + kvh) * 8 + (tid & 7)];
    const unsigned char* gsrc = KSIMG + (size_t)kvh * 256 * 16384 + (size_t)wave * 8192 + lane * 16;
    const int nsb = cur / 4 + 1;
#define SA_ISSUE(sb_, slot_) do { _Pragma("unroll") for (int i_ = 0; i_ < 8; ++i_) \
        __builtin_amdgcn_global_load_lds((const unsigned*)(gsrc + (size_t)(sb_) * 65536 + i_ * 1024), (LAS unsigned*)(lds + (slot_) * SLOTB + wave * 8192 + i_ * 1024), 16, 0, 0); } while (0)
    SA_ISSUE(0, 0);
    bf16x8 qf[2][2]; float negM[2], negMfar[2]; int qpos[2];
#pragma unroll
    for (int cg = 0; cg < 2; ++cg) {
        const int ql = wave * 8 + cg * 4 + qq; qpos[cg] = p0 + ql;
        const bf16* qp = PROJ + (size_t)qpos[cg] * NINP + C_CQ + H * 64 + g * 8; float qn = 0.f;
#pragma unroll
        for (int ks = 0; ks < 2; ++ks) { qf[cg][ks] = *(const bf16x8*)(qp + ks * 32);
#pragma unroll
            for (int j = 0; j < 8; ++j) { const float x = bf2f((unsigned short)qf[cg][ks][j]); qn += x * x; } }
        qn += __shfl_xor(qn, 16); qn += __shfl_xor(qn, 32);
        const float M = sqrtf(qn * ksmax2) * 1.0002f + fmaxf(bmax[4 + H], 0.f) + 1e-6f;
        negM[cg] = -M; negMfar[cg] = -M + bias2[(4 + H) * BIASLEN + 1535];
    }
    asm volatile("s_waitcnt vmcnt(0) lgkmcnt(0)" ::: "memory"); __builtin_amdgcn_s_barrier(); asm volatile("" ::: "memory");
    unsigned cgm[2];
#pragma unroll
    for (int cg = 0; cg < 2; ++cg) { unsigned m = 0u;
        if (lane < 8) { const LAS unsigned* b = (const LAS unsigned*)(lds + BM) + (wave * 8 + cg * 4) * 8 + lane; m = b[0] | b[8] | b[16] | b[24]; }
        cgm[cg] = m; }
    f32x4v oacc[2][4]; float lsum[2] = {0.f, 0.f};
#pragma unroll
    for (int cg = 0; cg < 2; ++cg)
#pragma unroll
        for (int dt = 0; dt < 4; ++dt) oacc[cg][dt] = (f32x4v){0.f, 0.f, 0.f, 0.f};
    const LAS float* bt = (const LAS float*)(lds + BT) + hh * BTH;
    for (int sb = 0; sb < nsb; ++sb) {
        if (sb + 1 < nsb) SA_ISSUE(sb + 1, (sb + 1) & 1);
#pragma unroll 1
        for (int blk = 0; blk < 4; ++blk) { const int j = 4 * sb + blk; if (j > cur) break;
        const LAS unsigned char* slot = lds + (sb & 1) * SLOTB + blk * 16384;
        const bool far = cur - j >= 25, diag = j == cur;
#pragma unroll
        for (int cg = 0; cg < 2; ++cg) {
            const unsigned word = __builtin_amdgcn_readlane(cgm[cg], j >> 5);
            if (!((word >> (j & 31)) & 1u)) continue;
            const bool mine = (((const LAS unsigned*)(lds + BM))[(wave * 8 + cg * 4 + qq) * 8 + (j >> 5)] >> (j & 31)) & 1u;
            const float nm = mine ? (far ? negMfar[cg] : negM[cg]) : -1e30f;
            f32x4v s[4];
#pragma unroll
            for (int t = 0; t < 4; ++t) { s[t] = (f32x4v){nm, nm, nm, nm};
#pragma unroll
                for (int ks = 0; ks < 2; ++ks) { const bf16x8 kf = *(const LAS bf16x8*)(slot + (4 * ks + g) * 1024 + (16 * t + col) * 16);
                    s[t] = __builtin_amdgcn_mfma_f32_16x16x32_bf16(kf, qf[cg][ks], s[t], 0, 0, 0); } }
            float ps = 0.f;
            if (far) {
#pragma unroll
                for (int t = 0; t < 4; ++t)
#pragma unroll
                    for (int e = 0; e < 4; ++e) { const float pv = __builtin_amdgcn_exp2f(s[t][e]); s[t][e] = pv; ps += pv; }
            } else {
#pragma unroll
                for (int t = 0; t < 4; ++t) { const int d0 = qpos[cg] - (64 * j + 16 * t + 4 * g); int db = d0 + 3; db = db < 3 ? 3 : (db > 1538 ? 1538 : db);
                    const LAS float* tb = bt + db - 3;
#pragma unroll
                    for (int e = 0; e < 4; ++e) { float pv = __builtin_amdgcn_exp2f(s[t][e] + tb[3 - e]); if (diag && d0 - e < 0) pv = 0.f; s[t][e] = pv; ps += pv; } }
            }
            lsum[cg] += ps;
#pragma unroll
            for (int ks2 = 0; ks2 < 2; ++ks2) {
                const v4u pw = {cvtpk(s[2 * ks2][0], s[2 * ks2][1]), cvtpk(s[2 * ks2][2], s[2 * ks2][3]), cvtpk(s[2 * ks2 + 1][0], s[2 * ks2 + 1][1]), cvtpk(s[2 * ks2 + 1][2], s[2 * ks2 + 1][3])};
                const bf16x8 pf = __builtin_bit_cast(bf16x8, pw);
                const lds_cptr vb = (lds_cptr)slot + 8192 + (32 * ks2 + 4 * g + (col >> 2)) * 32 + (col & 3) * 8;
#pragma unroll
                for (int dt = 0; dt < 4; ++dt) { const s16x4 lo = vtr(vb + dt * 2048), hv = vtr(vb + dt * 2048 + 512);
                    const bf16x8 vf = {lo[0], lo[1], lo[2], lo[3], hv[0], hv[1], hv[2], hv[3]};
                    oacc[cg][dt] = __builtin_amdgcn_mfma_f32_16x16x32_bf16(vf, pf, oacc[cg][dt], 0, 0, 0); } }
        } }
        asm volatile("s_waitcnt vmcnt(0) lgkmcnt(0)" ::: "memory"); __builtin_amdgcn_s_barrier(); asm volatile("" ::: "memory");
    }
#undef SA_ISSUE
#pragma unroll
    for (int cg = 0; cg < 2; ++cg) {
        float l = lsum[cg]; l += __shfl_xor(l, 16); l += __shfl_xor(l, 32);
        const float rl = 1.0f / l; const size_t q = (size_t)qpos[cg];
        const float g0 = bf2f(PROJ[q * NINP + C_CG + H * 3 + 0]), g1 = bf2f(PROJ[q * NINP + C_CG + H * 3 + 1]) * rl, g2 = bf2f(PROJ[q * NINP + C_CG + H * 3 + 2]);
#pragma unroll
        for (int dt = 0; dt < 4; ++dt) { const int d = 16 * dt + 4 * g;
            const v2u a = *(const v2u*)(OCMP + q * 512 + H * 64 + d), b = *(const v2u*)(OWIN + q * 512 + H * 64 + d);
            const float r0 = g0 * bflo(a.x) + g1 * oacc[cg][dt][0] + g2 * bflo(b.x), r1 = g0 * bfhi(a.x) + g1 * oacc[cg][dt][1] + g2 * bfhi(b.x);
            const float r2 = g0 * bflo(a.y) + g1 * oacc[cg][dt][2] + g2 * bflo(b.y), r3 = g0 * bfhi(a.y) + g1 * oacc[cg][dt][3] + g2 * bfhi(b.y);
            *(v2u*)(MIXED + q * DM + 512 + H * 64 + d) = (v2u){pk2(r0, r1), pk2(r2, r3)}; }
    }
}
}

__device__ __forceinline__ void p3b_select(Frame& F, int layer, const bf16* PROJ, const bf16* OWIN, bf16* MIXED) {
    const float* bias2 = (const float*)(F.ws + WS_BIAS); const float* bmax = (const float*)(F.ws + WS_BMAX);
    const bf16* OCMP = (const bf16*)(F.ws + WS_OCMP); const unsigned* SELB = (const unsigned*)(F.ws + WS_SELB);
    const unsigned* mx = (const unsigned*)(F.ws + WS_CTL) + CW_MAX + layer * 16;
    for (int k = F.vcu; k < 256; k += F.G) for (int rep = 0; rep < 2; ++rep) { const int x = rep == 0 ? 511 - k : k;
        const int kvh = x & 1, cur = x >> 1;
        const float ksmax2 = __uint_as_float(__hip_atomic_load(mx + 2 + kvh, __ATOMIC_RELAXED, __HIP_MEMORY_SCOPE_AGENT));
        sa::run_unit(F.lds, PROJ, F.ws + WS_KSIMG, bias2, bmax, ksmax2, OCMP, OWIN, SELB, MIXED, kvh, cur, F.wave, F.lane, F.tid); }
    __syncthreads();
}
__device__ __forceinline__ void p2_kslc_norm(Frame& F, int layer, const bf16* PROJ) {
    const int gt = F.vcu * NTHREADS + F.tid, NGT = F.G * NTHREADS; float m0 = 0.f, m1 = 0.f;
    for (int idx = gt; idx < S * 16; idx += NGT) { const int n = idx >> 3, c = idx & 7, p = n >> 1, kvh = n & 1;
        const v4u w = *(const v4u*)(PROJ + (size_t)p * NINP + C_CKS + kvh * 64 + c * 8);
        const float a0 = bflo(w.x), a1 = bfhi(w.x), a2 = bflo(w.y), a3 = bfhi(w.y), a4 = bflo(w.z), a5 = bfhi(w.z), a6 = bflo(w.w), a7 = bfhi(w.w);
        float s = a0 * a0 + a1 * a1 + a2 * a2 + a3 * a3 + a4 * a4 + a5 * a5 + a6 * a6 + a7 * a7;
        s += __shfl_xor(s, 1); s += __shfl_xor(s, 2); s += __shfl_xor(s, 4);
        if (kvh) m1 = fmaxf(m1, s); else m0 = fmaxf(m0, s); }
    m0 = wave_max(m0); m1 = wave_max(m1);
    if (F.lane == 0) { unsigned* mx = (unsigned*)(F.ws + WS_CTL) + CW_MAX + layer * 16;
        __hip_atomic_fetch_max(mx + 2, __float_as_uint(m0), __ATOMIC_RELAXED, __HIP_MEMORY_SCOPE_AGENT); __hip_atomic_fetch_max(mx + 3, __float_as_uint(m1), __ATOMIC_RELAXED, __HIP_MEMORY_SCOPE_AGENT); }
}


namespace cm {
using ba::bf16x8; using ba::f32x16;
constexpr int AIMG = 0, HIMG = 32768, LDS_END = HIMG + 16384;
__device__ __forceinline__ void run_unit(LAS unsigned char* lds, const bf16* PROJ, const bf16* W1C, const float* posw1, const bf16* W2T, bf16* OUTB, unsigned* maxw,
                                         int kv, int ru, int wave, int lane, int tid) {
    const int r32 = lane & 31, hi = lane >> 5, R0 = ru * 32, ccol = kv ? C_CVC : C_CKC;
    f32x16 acc = {};
    for (int kc = 0; kc < 4; ++kc) {
        __syncthreads();
#pragma unroll
        for (int i_ = 0; i_ < 4; ++i_) { const int idx = tid + i_ * NTHREADS, row = idx >> 6, c = idx & 63; int R = R0 + row; if (R > 2045) R = 2045;
            const v4u w = *(const v4u*)(PROJ + (size_t)(16 * (R >> 1) + 8 * kc + (c >> 3)) * NINP + ccol + (R & 1) * 64 + (c & 7) * 8);
            *(LAS v4u*)(lds + AIMG + c * 512 + row * 16) = w; }
        __syncthreads();
        const bf16* wb = W1C + ((size_t)(kc * 64 + hi) * 256 + wave * 32 + r32) * 8;
#pragma unroll 4
        for (int ks = 0; ks < 32; ++ks) {
            const bf16x8 af = *(const LAS bf16x8*)(lds + AIMG + (2 * ks + hi) * 512 + r32 * 16);
            const bf16x8 bfr = *(const bf16x8*)(wb + (size_t)ks * 2 * 256 * 8);
            acc = __builtin_amdgcn_mfma_f32_32x32x16_bf16(af, bfr, acc, 0, 0, 0); }
    }
    { const int n = wave * 32 + r32; const float pb = posw1[n];
#pragma unroll
      for (int r = 0; r < 16; ++r) { const int row = (r & 3) + 8 * (r >> 2) + 4 * hi; const float x = acc[r] + pb;
          const float u2 = 1.5957691216057308f * (x + 0.044715f * x * x * x); const float gl = x / (1.0f + __expf(-u2));
          *(LAS bf16*)(lds + HIMG + (n >> 3) * 512 + row * 16 + (n & 7) * 2) = (bf16)f2bf(gl); } }
    __syncthreads();
    if (wave == 0) {
        f32x16 o0 = {}, o1 = {};
#pragma unroll 4
        for (int ks = 0; ks < 16; ++ks) { const bf16x8 af = *(const LAS bf16x8*)(lds + HIMG + (2 * ks + hi) * 512 + r32 * 16);
            const bf16x8 b0 = *(const bf16x8*)(W2T + (size_t)r32 * 256 + ks * 16 + hi * 8), b1 = *(const bf16x8*)(W2T + (size_t)(32 + r32) * 256 + ks * 16 + hi * 8);
            o0 = __builtin_amdgcn_mfma_f32_32x32x16_bf16(af, b0, o0, 0, 0, 0); o1 = __builtin_amdgcn_mfma_f32_32x32x16_bf16(af, b1, o1, 0, 0, 0); }
#pragma unroll
        for (int r = 0; r < 16; ++r) { const int R = R0 + (r & 3) + 8 * (r >> 2) + 4 * hi;
            if (R < 2046) { OUTB[(size_t)R * 64 + r32] = (bf16)f2bf(o0[r]); OUTB[(size_t)R * 64 + 32 + r32] = (bf16)f2bf(o1[r]); } }
        if (maxw) { float m0 = 0.f, m1 = 0.f;
#pragma unroll
            for (int r = 0; r < 16; ++r) { const int R = R0 + (r & 3) + 8 * (r >> 2) + 4 * hi; const float fa = bf2f((unsigned short)f2bf(o0[r])), fb = bf2f((unsigned short)f2bf(o1[r])); float n2 = fa * fa + fb * fb;
                n2 += __shfl_xor(n2, 1); n2 += __shfl_xor(n2, 2); n2 += __shfl_xor(n2, 4); n2 += __shfl_xor(n2, 8); n2 += __shfl_xor(n2, 16);
                if (R < 2046) { if (r & 1) m1 = fmaxf(m1, n2); else m0 = fmaxf(m0, n2); } }
            m0 = fmaxf(m0, __shfl_xor(m0, 32)); m1 = fmaxf(m1, __shfl_xor(m1, 32));
            if (lane == 0) { __hip_atomic_fetch_max(maxw, __float_as_uint(m0), __ATOMIC_RELAXED, __HIP_MEMORY_SCOPE_AGENT); __hip_atomic_fetch_max(maxw + 1, __float_as_uint(m1), __ATOMIC_RELAXED, __HIP_MEMORY_SCOPE_AGENT); } }
    }
}
}
__device__ __forceinline__ void p2_compress_mfma(Frame& F, int layer, const bf16* PROJ) {
    for (int it = F.vcu; it < 128; it += F.G) { const int kv = it & 1, ru = it >> 1;
        cm::run_unit(F.lds, PROJ, (const bf16*)(F.ws + WS_CW1) + (size_t)(layer * 2 + kv) * 2048 * 256, (const float*)(F.ws + WS_POSW1) + (layer * 2 + kv) * 256,
                     (const bf16*)(F.ws + WS_CW2T) + (size_t)(layer * 2 + kv) * 64 * 256, (bf16*)(F.ws + (kv ? WS_VCB : WS_KCB)),
                     kv == 0 ? (unsigned*)(F.ws + WS_CTL) + CW_MAX + layer * 16 : nullptr, kv, ru, F.wave, F.lane, F.tid); }
    __syncthreads();
}

constexpr int NSUB = 9;
constexpr int N_PHASES = 2 + NSUB * DEPTH;
__device__ __forceinline__ void run_phase(Frame& F, int ph) {
    unsigned char* ws = F.ws;
    const float* mod = (const float*)(ws + WS_MOD);
    if (ph == 0) { p0_prologue(F); return; }
    if (ph == 1) { row_pass<0>(F, F.in[I_X], nullptr, (bf16*)(ws + WS_RA), nullptr, nullptr, mod + 1024, mod + 0); return; }
    const int l = (ph - 2) / NSUB, si = (ph - 2) % NSUB;
    const int sub = si <= 2 ? si : (si == 3 ? 8 : si - 1);
    const float* modl = mod + l * 6144;
    bf16* bufX = (bf16*)(ws + ((l & 1) ? WS_RB : WS_RA));
    bf16* bufY = (bf16*)(ws + ((l & 1) ? WS_RA : WS_RB));
    bf16* PROJ = (bf16*)(ws + WS_BIG); bf16* HID = (bf16*)(ws + WS_BIG); bf16* OWIN = (bf16*)(ws + WS_OWIN);
    const float* xres = (l == 0) ? F.in[I_X] : F.out;
    switch (sub) {
    case 0: {
        pg8::Gemm g{bufX, (const bf16*)(ws + WS_WIN) + (size_t)l * NINP * DM, S, NINP, DM}; pg8::StaticOrder So; So.init(S, NINP, F.G, (int)blockIdx.x);
        pg8::EpiInProj E{PROJ, NINP, (const float*)(ws + WS_ROPE), QSCALE, ws + WS_KSIMG};
        pg8::gemm_phase<pg8::EpiInProj, pg8::StaticOrder, PG8_ALIGN, PG8_SP2>(F.lds, g, So, E, F.wave);
    } break;
    case 1: p2_kslc_norm(F, l, PROJ); p2_compress_mfma(F, l, PROJ); p2_banded(F, l, PROJ, bufY, OWIN);
#if DUP_ACT == 1
        p2_banded(F, l, PROJ, bufY, OWIN);
#elif DUP_ACT == 11
        p2_compress_mfma(F, l, PROJ);
#endif
        break;
    case 2: merge_dilated(F, bufY); p3a_cmp_select(F, l, PROJ);
#if DUP_ACT == 2
        p3a_cmp_select(F, l, PROJ);
#endif
        break;
    case 8: p3b_select(F, l, PROJ, OWIN, bufY);
#if DUP_ACT == 8
        p3b_select(F, l, PROJ, OWIN, bufY);
#endif
        break;
    case 3: {
        pg8::Gemm g{bufY, (const bf16*)(ws + WS_WOUT) + (size_t)l * DM * DM, S, DM, DM}; pg8::StaticOrder So; So.init(S, DM, F.G, (int)blockIdx.x);
        pg8::EpiResid E{xres, F.out, DM, modl + 2048, DN_ALPHA};
        pg8::gemm_phase<pg8::EpiResid, pg8::StaticOrder, PG8_ALIGN, PG8_SP2>(F.lds, g, So, E, F.wave);
    } break;
    case 4: row_pass<1>(F, F.out, F.out, bufX, F.in[I_LNG] + (l * 2 + 0) * DM, F.in[I_LNB] + (l * 2 + 0) * DM, modl + 4096, modl + 3072); break;
    case 5: {
        pg8::Gemm g{bufX, (const bf16*)(ws + WS_W1) + (size_t)l * DFF * DM, S, DFF, DM}; pg8::StaticOrder So; So.init(S, DFF, F.G, (int)blockIdx.x);
        pg8::EpiRelu2 E{HID, DFF};
        pg8::gemm_phase<pg8::EpiRelu2, pg8::StaticOrder, PG8_ALIGN, PG8_SP2>(F.lds, g, So, E, F.wave);
    } break;
    case 6: {
        pg8::Gemm g{HID, (const bf16*)(ws + WS_W2) + (size_t)l * DM * DFF, S, DM, DFF}; pg8::StaticOrder So; So.init(S, DM, F.G, (int)blockIdx.x);
        pg8::EpiResid E{F.out, F.out, DM, modl + 5120, DN_ALPHA};
        pg8::gemm_phase<pg8::EpiResid, pg8::StaticOrder, PG8_ALIGN, PG8_SP2>(F.lds, g, So, E, F.wave);
    } break;
    default: {
        if (l + 1 < DEPTH) row_pass<1>(F, F.out, F.out, bufY, F.in[I_LNG] + (l * 2 + 1) * DM, F.in[I_LNB] + (l * 2 + 1) * DM, modl + 6144 + 1024, modl + 6144 + 0);
        else row_pass<2>(F, F.out, F.out, nullptr, F.in[I_LNG] + (l * 2 + 1) * DM, F.in[I_LNB] + (l * 2 + 1) * DM, nullptr, nullptr);
    } break;
    }
}

__global__ void __launch_bounds__(NTHREADS, 2) fwd_kernel(Args args) {
    extern __shared__ __attribute__((aligned(16))) unsigned char lds[];
    Frame F;
    F.lds = (LAS unsigned char*)lds;
    F.tid = threadIdx.x; F.lane = F.tid & 63; F.wave = __builtin_amdgcn_readfirstlane(F.tid >> 6);
    F.G = gridDim.x; { const int bx = blockIdx.x; F.vcu = (F.G % 8 == 0) ? (bx % 8) * (F.G / 8) + bx / 8 : bx; }
    F.ws = args.ws; F.out = args.out;
#pragma unroll
    for (int i = 0; i < 16; ++i) F.in[i] = args.in[i];
    for (int u = F.tid; u < (LDS_BYTES - LDSCTL_OFF) / 4; u += NTHREADS) ((LAS unsigned*)(F.lds + LDSCTL_OFF))[u] = 0u;
    __syncthreads();
    const int wave0 = __builtin_amdgcn_readfirstlane(threadIdx.x >> 6);
    const bool multi = (args.ph_hi - args.ph_lo) > 1;
    XcdBarrier bar; bar.bar = (unsigned*)(F.ws + WS_CTL) + 4096; bar.x = 0; bar.st = nullptr;
    if (multi) bar = xcd_barrier_post((unsigned*)(F.ws + WS_CTL) + 4096, (volatile LAS unsigned*)(F.lds + MISC_OFF) + 8);
    for (int ph = args.ph_lo; ph < args.ph_hi; ++ph) {
        { int ln = __builtin_amdgcn_mbcnt_hi(~0u, __builtin_amdgcn_mbcnt_lo(~0u, 0u)); asm volatile("" : "+v"(ln)); F.lane = ln; F.wave = wave0; F.tid = wave0 * 64 + ln; }
        run_phase(F, ph);
        if (ph + 1 < args.ph_hi) xcd_barrier(bar);
    }
}

#ifndef DUP_ACT
#define DUP_ACT 0
#endif
#ifndef N_LAUNCH_MODE
#define N_LAUNCH_MODE 1
#endif
extern "C" void kernel_launch(void* const* d_in, const int* in_sizes, int n_in, void* d_out, int out_size, void* d_ws, size_t ws_size, hipStream_t stream) {
    static int grid = 0;
    if (grid == 0) {
        if (n_in != 16 || out_size != S * DM || ws_size < WS_END) { fprintf(stderr, "kernel_launch: unexpected shapes (n_in %d out %d ws %zu)\n", n_in, out_size, ws_size); grid = -1; return; }
        int dev = 0, cus = 0;
        if (hipGetDevice(&dev) != hipSuccess || hipDeviceGetAttribute(&cus, hipDeviceAttributeMultiprocessorCount, dev) != hipSuccess) { grid = -1; return; }
        if (hipFuncSetAttribute((const void*)fwd_kernel, hipFuncAttributeMaxDynamicSharedMemorySize, LDS_BYTES) != hipSuccess) { fprintf(stderr, "kernel_launch: hipFuncSetAttribute failed\n"); grid = -1; return; }
        int per_cu = 0;
        if (hipOccupancyMaxActiveBlocksPerMultiprocessor(&per_cu, (const void*)fwd_kernel, NTHREADS, LDS_BYTES) != hipSuccess || per_cu < 1) fprintf(stderr, "kernel_launch: occupancy query says %d\n", per_cu);
        (void)hipGetLastError();
        grid = cus;
    }
    if (grid < 0) return;
    (void)hipMemsetAsync((char*)d_ws + WS_CTL, 0, CTL_ZERO_BYTES, stream);
    Args a{};
    for (int i = 0; i < 16; ++i) a.in[i] = (const float*)d_in[i];
    a.out = (float*)d_out; a.ws = (unsigned char*)d_ws;
#if N_LAUNCH_MODE == 1
    a.ph_lo = 0; a.ph_hi = N_PHASES;
    hipLaunchKernelGGL(fwd_kernel, dim3(grid), dim3(NTHREADS), LDS_BYTES, stream, a);
#else
    for (int ph = 0; ph < N_PHASES; ++ph) { a.ph_lo = ph; a.ph_hi = ph + 1; hipLaunchKernelGGL(fwd_kernel, dim3(grid), dim3(NTHREADS), LDS_BYTES, stream, a); }
#endif
}
```

```cpp
#include <hip/hip_runtime.h>
#include <cstdio>
#include <cstdint>
#include <cmath>
#ifndef DUP_ACT
#define DUP_ACT 0
#endif
namespace pg8 {
#define PG8_LAS __attribute__((address_space(3)))
typedef unsigned short bf16_t;
typedef short bf16x8 __attribute__((ext_vector_type(8)));
typedef float f32x4 __attribute__((ext_vector_type(4)));
typedef unsigned u32x4 __attribute__((ext_vector_type(4)));
constexpr int BM = 256, BK = 64, HALF = 128, HTB = HALF * BK * 2  , STAGE_BYTES = 8 * HTB, NXCD = 8, WGM = 8;

__host__ __device__ __forceinline__ int lds_byte(int r, int c) { const int st = (r >> 4) * 2 + (c >> 5), rr = r & 15, cc = c & 31, ob = rr * 64 + cc * 2; return st * 1024 + (ob ^ (((ob >> 9) & 1) << 5)); }
__host__ __device__ __forceinline__ void stage_rc(int b, int& R, int& C) { const int st = b / 1024, sb = b % 1024, swz = sb ^ (((sb >> 9) & 1) << 5); R = (st >> 1) * 16 + swz / 64; C = (st & 1) * 32 + (swz % 64) / 2; }
__host__ __device__ __forceinline__ int perm32(int rho) { const int n = rho >> 4, i = rho & 15; return 8 * (i >> 2) + 4 * n + (i & 3); }

struct Unit { int pm, pn; };
struct Gemm { const bf16_t* A; const bf16_t* Bt; int M, N, K; };

struct StaticOrder {
    int nM, nN, nwg, G, c;
    __host__ __device__ void init(int M, int N, int G_, int c_) { nM = M / BM; nN = N / BM; nwg = nM * nN; G = G_; c = c_; }
    __host__ __device__ bool next(int i, Unit& u) const {
        const long L = (long)i * G + c; if (L >= nwg) return false;
        int wgid = (int)L; { const int q = nwg / NXCD, r = nwg % NXCD, xcd = wgid % NXCD, off = wgid / NXCD; wgid = (xcd < r ? xcd * (q + 1) : r * (q + 1) + (xcd - r) * q) + off; }
        const int nig = WGM * nN, gid = wgid / nig, fm = gid * WGM, gsz = (nM - fm) < WGM ? (nM - fm) : WGM;
        u.pm = fm + ((wgid % nig) % gsz); u.pn = (wgid % nig) / gsz; return true;
    }
    __device__ __forceinline__ void a_ready(const Unit&) const {}
    __device__ __forceinline__ void done(const Unit&) const {}
};


__device__ __forceinline__ unsigned cvt_pk_bf16(float lo, float hi) { unsigned r; asm volatile("v_cvt_pk_bf16_f32 %0, %1, %2" : "=v"(r) : "v"(lo), "v"(hi)); return r; }
typedef float f32x2 __attribute__((ext_vector_type(2)));

struct EpiInProj {
    static constexpr bool PERM = true, AFTER_DRAIN = false;
    bf16_t* O; int ldc; const float* rope; float qscale; unsigned char* simg;
    __device__ __forceinline__ void operator()(const f32x4 (&acc)[2][2][4][2], const Unit& u, int wr, int wc, int fr, int fq) const {
        const int row0 = u.pm * BM + wr * 64 + fr; const int col0 = u.pn * BM + wc * 32 + 8 * fq;
        const int i0 = 16 * (wc & 1) + 4 * fq;
#pragma unroll
        for (int bj = 0; bj < 2; ++bj) {
            const int pn = u.pn;
            const bool do_rope = (pn == 3) || (pn == 4 && bj == 0);
            const bool do_sig = (pn == 10);
            const float sc = (pn == 0 || pn == 3 || pn == 5 || pn == 6) ? qscale : 1.0f;
#pragma unroll
            for (int ai = 0; ai < 2; ++ai)
#pragma unroll
                for (int m = 0; m < 4; ++m) {
                    const int row = row0 + ai * HALF + m * 16;
                    f32x4 v0 = acc[ai][bj][m][0], v1 = acc[ai][bj][m][1];
                    if (do_rope) {
                        const f32x4* rp = (const f32x4*)(rope + ((size_t)row * 32 + i0) * 2);
                        const f32x4 c01 = rp[0], c23 = rp[1];
                        f32x4 w0, w1;
                        w0[0] = v0[0] * c01[0] - v0[1] * c01[1]; w0[1] = v0[1] * c01[0] + v0[0] * c01[1];
                        w0[2] = v0[2] * c01[2] - v0[3] * c01[3]; w0[3] = v0[3] * c01[2] + v0[2] * c01[3];
                        w1[0] = v1[0] * c23[0] - v1[1] * c23[1]; w1[1] = v1[1] * c23[0] + v1[0] * c23[1];
                        w1[2] = v1[2] * c23[2] - v1[3] * c23[3]; w1[3] = v1[3] * c23[2] + v1[2] * c23[3];
                        v0 = w0; v1 = w1;
                    }
                    if (do_sig) {
#pragma unroll
                        for (int e = 0; e < 4; ++e) { v0[e] = 1.0f / (1.0f + __expf(-v0[e])); v1[e] = 1.0f / (1.0f + __expf(-v1[e])); }
                    }
                    v0 = v0 * sc; v1 = v1 * sc;
                    u32x4 w; w.x = cvt_pk_bf16(v0[0], v0[1]); w.y = cvt_pk_bf16(v0[2], v0[3]); w.z = cvt_pk_bf16(v1[0], v1[1]); w.w = cvt_pk_bf16(v1[2], v1[3]);
                    *(u32x4*)(O + (size_t)row * ldc + col0 + bj * HALF) = w;
                    if (pn == 8) {
                        const unsigned kvh = wc >> 1, blk = (unsigned)row >> 6, key = row & 63;
                        const unsigned off = ((kvh * 256u + blk) << 14) + (bj == 0 ? (4u * (wc & 1) + fq) * 1024u + key * 16u : 8192u + (2u * (wc & 1) + (fq >> 1)) * 2048u + key * 32u + (fq & 1) * 16u);
                        *(u32x4*)(simg + off) = w;
                    }
                }
        }
    }
};
struct EpiRelu2 {
    static constexpr bool PERM = true, AFTER_DRAIN = false;
    bf16_t* O; int ldc;
    __device__ __forceinline__ void operator()(const f32x4 (&acc)[2][2][4][2], const Unit& u, int wr, int wc, int fr, int fq) const {
        const int row0 = u.pm * BM + wr * 64 + fr; const int col0 = u.pn * BM + wc * 32 + 8 * fq;
#pragma unroll
        for (int ai = 0; ai < 2; ++ai)
#pragma unroll
            for (int m = 0; m < 4; ++m) { bf16_t* rowp = O + (size_t)(row0 + ai * HALF + m * 16) * ldc + col0;
#pragma unroll
                for (int bj = 0; bj < 2; ++bj) { f32x4 v0 = acc[ai][bj][m][0], v1 = acc[ai][bj][m][1];
#pragma unroll
                    for (int e = 0; e < 4; ++e) { const float a = fmaxf(v0[e], 0.f), b = fmaxf(v1[e], 0.f); v0[e] = a * a; v1[e] = b * b; }
                    u32x4 w; w.x = cvt_pk_bf16(v0[0], v0[1]); w.y = cvt_pk_bf16(v0[2], v0[3]); w.z = cvt_pk_bf16(v1[0], v1[1]); w.w = cvt_pk_bf16(v1[2], v1[3]);
                    *(u32x4*)(rowp + bj * HALF) = w; } }
    }
};
struct EpiResid {
    static constexpr bool PERM = false, AFTER_DRAIN = false;
    const float* base; float* out; int ldc; const float* gate; float alpha;
    __device__ __forceinline__ void operator()(const f32x4 (&acc)[2][2][4][2], const Unit& u, int wr, int wc, int fr, int fq) const {
        const int col0 = u.pn * BM + wc * 32 + 4 * fq;
#pragma unroll
        for (int bj = 0; bj < 2; ++bj)
#pragma unroll
            for (int n = 0; n < 2; ++n) { const f32x4 gv = *(const f32x4*)(gate + col0 + bj * HALF + n * 16) + 1.0f;
#pragma unroll
                for (int ai = 0; ai < 2; ++ai)
#pragma unroll
                    for (int m = 0; m < 4; ++m) { const size_t off = (size_t)(u.pm * BM + ai * HALF + wr * 64 + m * 16 + fr) * ldc + col0 + bj * HALF + n * 16;
                        const f32x4 bs = *(const f32x4*)(base + off); *(f32x4*)(out + off) = bs * alpha + gv * acc[ai][bj][m][n]; } }
    }
};
template <class Epi, class Sched, bool ALIGN_EPI = false, bool SP2 = false>
__device__ __forceinline__ void gemm_phase(PG8_LAS unsigned char* lds, const Gemm g, const Sched& S, const Epi& E, const int wid  ) {
    int lane_ = __builtin_amdgcn_mbcnt_hi(~0u, __builtin_amdgcn_mbcnt_lo(~0u, 0u)); asm volatile("" : "+v"(lane_));
    const int lane = lane_, tid = wid * 64 + lane, wr = wid >> 2, wc = wid & 3, fr = lane & 15, fq = lane >> 4;
    const int K = g.K, nt = K / BK;
    unsigned voffA[2], voffB[2];
#pragma unroll
    for (int i = 0; i < 2; ++i) { int R, C; stage_rc(tid * 16 + i * 8192, R, C); const int Rb = Epi::PERM ? ((R & ~31) + perm32(R & 31)) : R;
        voffA[i] = (unsigned)(R * K + C) * 2u; voffB[i] = (unsigned)(Rb * K + C) * 2u; }
    const size_t kstep = (size_t)(BK * 2);
    const size_t hstep = (size_t)HALF * K * 2;
    const size_t tstep = 2 * hstep;
    const unsigned ldsw = (unsigned)wid * 1024u;
    const int aoff = lds_byte(wr * 64 + fr, fq * 8), boff = lds_byte(wc * 32 + fr, fq * 8);
#define PG8_SA(b, h) (((b) * 2 + (h)) * HTB)
#define PG8_SB(b, h) ((4 + (b) * 2 + (h)) * HTB)
#define PG8_STAGE(bufoff, gbase, voff) do { _Pragma("unroll") for (int _i = 0; _i < 2; ++_i) \
        __builtin_amdgcn_global_load_lds((const unsigned*)((const char*)(gbase) + (voff)[_i]), (PG8_LAS unsigned*)(lds + (bufoff) + ldsw + _i * 8192), 16, 0, 0); } while (0)
#define PG8_LDA(dst, b, h) do { _Pragma("unroll") for (int m = 0; m < 4; ++m) _Pragma("unroll") for (int k = 0; k < 2; ++k) dst[m][k] = *(const PG8_LAS bf16x8*)(lds + PG8_SA(b, h) + aoff + m * 2048 + k * 1024); } while (0)
#define PG8_LDB(dst, b, h) do { _Pragma("unroll") for (int n = 0; n < 2; ++n) _Pragma("unroll") for (int k = 0; k < 2; ++k) dst[n][k] = *(const PG8_LAS bf16x8*)(lds + PG8_SB(b, h) + boff + n * 2048 + k * 1024); } while (0)
#define PG8_MMA(ai, bj, At, Bt) do { __builtin_amdgcn_s_setprio(1); _Pragma("unroll") for (int m = 0; m < 4; ++m) _Pragma("unroll") for (int n = 0; n < 2; ++n) _Pragma("unroll") for (int k = 0; k < 2; ++k) \
        acc[ai][bj][m][n] = __builtin_amdgcn_mfma_f32_16x16x32_bf16(Bt[n][k], At[m][k], acc[ai][bj][m][n], 0, 0, 0); __builtin_amdgcn_s_setprio(0); } while (0)
#define PG8_WAIT_V(n) asm volatile("s_waitcnt vmcnt(" #n ")" ::: "memory")
#define PG8_WAIT_L(n) asm volatile("s_waitcnt lgkmcnt(" #n ")" ::: "memory")
#define PG8_BAR __builtin_amdgcn_s_barrier()
#define PG8_SCHED __builtin_amdgcn_sched_barrier(0)
    Unit cur, nxt; int ui = 0;
    if (!S.next(0, cur)) return;
    f32x4 acc[2][2][4][2];
#pragma unroll
    for (int a = 0; a < 2; ++a)
#pragma unroll
        for (int b = 0; b < 2; ++b)
#pragma unroll
            for (int m = 0; m < 4; ++m)
#pragma unroll
                for (int n = 0; n < 2; ++n) acc[a][b][m][n] = (f32x4){0.f, 0.f, 0.f, 0.f};
    bf16x8 At[4][2], B0[2][2], B1[2][2];
    const char* cA = (const char*)g.A + (size_t)cur.pm * tstep; const char* cB = (const char*)g.Bt + (size_t)cur.pn * tstep;
    S.a_ready(cur);
    if constexpr (SP2) {
        PG8_STAGE(PG8_SB(0, 0), cB, voffB); PG8_STAGE(PG8_SB(0, 1), cB + hstep, voffB); PG8_STAGE(PG8_SA(0, 0), cA, voffA); PG8_STAGE(PG8_SA(0, 1), cA + hstep, voffA);
        if (wr == 1) PG8_BAR;
        PG8_WAIT_V(2); PG8_BAR;
        PG8_STAGE(PG8_SB(1, 0), cB + kstep, voffB); PG8_STAGE(PG8_SA(1, 0), cA + kstep, voffA); PG8_STAGE(PG8_SB(1, 1), cB + hstep + kstep, voffB);
        PG8_WAIT_V(6); PG8_BAR;
    } else {
        PG8_STAGE(PG8_SB(0, 0), cB, voffB); PG8_STAGE(PG8_SA(0, 0), cA, voffA); PG8_STAGE(PG8_SB(0, 1), cB + hstep, voffB); PG8_STAGE(PG8_SA(0, 1), cA + hstep, voffA);
        if (wr == 1) PG8_BAR;
        PG8_WAIT_V(4); PG8_BAR;
        PG8_STAGE(PG8_SB(1, 0), cB + kstep, voffB); PG8_STAGE(PG8_SA(1, 0), cA + kstep, voffA); PG8_STAGE(PG8_SB(1, 1), cB + hstep + kstep, voffB);
        PG8_WAIT_V(6); PG8_BAR;
    }
    for (;;) {
        const bool has_next = S.next(ui + 1, nxt);
        const char* nA = has_next ? (const char*)g.A + (size_t)nxt.pm * tstep : cA; const char* nB = has_next ? (const char*)g.Bt + (size_t)nxt.pn * tstep : cB;
        for (int t = 0; t < nt; t += 2) {
            const bool last = (t == nt - 2);
            const char* a1 = cA + (size_t)(t + 1) * kstep;
            const char* a2 = last ? nA : cA + (size_t)(t + 2) * kstep; const char* b2 = last ? nB : cB + (size_t)(t + 2) * kstep;
            const char* a3 = a2 + kstep; const char* b3 = b2 + kstep;
            if (last && has_next) S.a_ready(nxt);
            if constexpr (SP2) {
            PG8_LDB(B0, 0, 0); PG8_LDB(B1, 0, 1); PG8_SCHED; PG8_LDA(At, 0, 0); PG8_STAGE(PG8_SA(1, 1), a1 + hstep, voffA);
            PG8_WAIT_V(8); PG8_WAIT_L(0); PG8_BAR; PG8_MMA(0, 0, At, B0); PG8_MMA(0, 1, At, B1); PG8_BAR; PG8_SCHED;
            PG8_LDA(At, 0, 1); PG8_STAGE(PG8_SB(0, 0), b2, voffB); PG8_STAGE(PG8_SB(0, 1), b2 + hstep, voffB); PG8_STAGE(PG8_SA(0, 0), a2, voffA);
            PG8_WAIT_V(8); PG8_WAIT_L(0); PG8_BAR; PG8_MMA(1, 0, At, B0); PG8_MMA(1, 1, At, B1); PG8_BAR; PG8_SCHED;
            PG8_LDB(B0, 1, 0); PG8_LDB(B1, 1, 1); PG8_SCHED; PG8_LDA(At, 1, 0); PG8_STAGE(PG8_SA(0, 1), a2 + hstep, voffA);
            PG8_WAIT_V(8); PG8_WAIT_L(0); PG8_BAR; PG8_MMA(0, 0, At, B0); PG8_MMA(0, 1, At, B1); PG8_BAR; PG8_SCHED;
            PG8_LDA(At, 1, 1); PG8_STAGE(PG8_SB(1, 0), b3, voffB); PG8_STAGE(PG8_SB(1, 1), b3 + hstep, voffB); PG8_STAGE(PG8_SA(1, 0), a3, voffA);
            PG8_WAIT_V(8); PG8_WAIT_L(0); PG8_BAR; PG8_MMA(1, 0, At, B0); PG8_MMA(1, 1, At, B1); PG8_BAR; PG8_SCHED;
            } else {
            PG8_LDB(B0, 0, 0); PG8_SCHED; PG8_LDA(At, 0, 0); PG8_STAGE(PG8_SA(1, 1), a1 + hstep, voffA);
            PG8_WAIT_L(8); PG8_BAR; PG8_WAIT_L(0); PG8_MMA(0, 0, At, B0); PG8_BAR; PG8_SCHED;
            PG8_LDB(B1, 0, 1); PG8_STAGE(PG8_SB(0, 0), b2, voffB);
            PG8_BAR; PG8_WAIT_L(0); PG8_MMA(0, 1, At, B1); PG8_BAR;
            PG8_LDA(At, 0, 1); PG8_STAGE(PG8_SA(0, 0), a2, voffA);
            PG8_BAR; PG8_WAIT_L(0); PG8_MMA(1, 0, At, B0); PG8_BAR; PG8_SCHED;
            PG8_STAGE(PG8_SB(0, 1), b2 + hstep, voffB);
            PG8_WAIT_V(6); PG8_BAR; PG8_MMA(1, 1, At, B1); PG8_BAR;
            PG8_LDB(B0, 1, 0); PG8_SCHED; PG8_LDA(At, 1, 0); PG8_STAGE(PG8_SA(0, 1), a2 + hstep, voffA);
            PG8_WAIT_L(8); PG8_BAR; PG8_WAIT_L(0); PG8_MMA(0, 0, At, B0); PG8_BAR; PG8_SCHED;
            PG8_LDB(B1, 1, 1); PG8_STAGE(PG8_SB(1, 0), b3, voffB);
            PG8_BAR; PG8_WAIT_L(0); PG8_MMA(0, 1, At, B1); PG8_BAR;
            PG8_LDA(At, 1, 1); PG8_STAGE(PG8_SA(1, 0), a3, voffA);
            PG8_BAR; PG8_WAIT_L(0); PG8_MMA(1, 0, At, B0); PG8_BAR; PG8_SCHED;
            PG8_STAGE(PG8_SB(1, 1), b3 + hstep, voffB);
            PG8_WAIT_V(6); PG8_BAR; PG8_MMA(1, 1, At, B1); PG8_BAR;
            }
        }
        if constexpr (ALIGN_EPI) { if (wr == 0) PG8_BAR; }
        if constexpr (!Epi::AFTER_DRAIN) { E(acc, cur, wr, wc, fr, fq); S.done(cur); }
        if (!has_next) break;
#pragma unroll
        for (int a = 0; a < 2; ++a)
#pragma unroll
            for (int b = 0; b < 2; ++b)
#pragma unroll
                for (int m = 0; m < 4; ++m)
#pragma unroll
                    for (int n = 0; n < 2; ++n) acc[a][b][m][n] = (f32x4){0.f, 0.f, 0.f, 0.f};
        cur = nxt; cA = nA; cB = nB; ++ui;
        if constexpr (ALIGN_EPI) { if (wr == 1) PG8_BAR; }
    }
    PG8_WAIT_V(0);
    if constexpr (!ALIGN_EPI) { if (wr == 0) PG8_BAR; }
    PG8_BAR;
    if constexpr (Epi::AFTER_DRAIN) { E.fused(acc, cur, wr, wc, fr, fq, lds, wid, lane); S.done(cur); }
#undef PG8_SA
#undef PG8_SB
#undef PG8_STAGE
#undef PG8_LDA
#undef PG8_LDB
#undef PG8_MMA
#undef PG8_WAIT_V
#undef PG8_WAIT_L
#undef PG8_BAR
#undef PG8_SCHED
}
}

#ifndef PG8_SP2
#define PG8_SP2 true
#endif
#ifndef PG8_ALIGN
#define PG8_ALIGN true
#endif

constexpr int S = 16384, DM = 1024, NIN = 2584, NINP = 2816, DFF = 4096, DEPTH = 4;
constexpr int NWAVES = 8, NTHREADS = 512;
constexpr float LN_EPS = 1e-5f;
constexpr float LOG2E = 1.4426950408889634f;
constexpr float QSCALE = 0.125f * LOG2E;
constexpr float DN_ALPHA = 1.681792830507429f;
constexpr int C_AQ = 0, C_AK = 256, C_AV = 512, C_BQ = 768, C_BK = 1024, C_BV = 1152, C_CQ = 1280, C_CKC = 1792, C_CVC = 1920,
              C_CKS = 2048, C_CVS = 2176, C_CKW = 2304, C_CVW = 2432, C_CG = 2560;
constexpr int NCMP = 1023, NSEL = 256;
constexpr int BIASLEN = 2048;

constexpr size_t MiB = 1u << 20;
constexpr size_t WS_CTL = 0, CTL_ZERO_BYTES = 1 * MiB;
constexpr size_t WS_MOD = 1 * MiB;
constexpr size_t WS_BIAS = 1 * MiB + 128 * 1024;
constexpr size_t WS_BMAX = 1 * MiB + 256 * 1024;
constexpr size_t WS_ROPE = 2 * MiB;
constexpr size_t WS_KC = 6 * MiB, WS_VC = 6 * MiB + 512 * 1024;
constexpr size_t WS_CW2T = 6 * MiB;
constexpr size_t WS_POSW1 = 6 * MiB + 512 * 1024;
constexpr size_t WS_WIN = 8 * MiB;
constexpr size_t WS_WOUT = 30 * MiB;
constexpr size_t WS_W1 = 38 * MiB;
constexpr size_t WS_W2 = 70 * MiB;
constexpr size_t WS_CW1 = 102 * MiB;
constexpr size_t WS_RA = 110 * MiB, WS_RB = 142 * MiB;
constexpr size_t WS_BIG = 174 * MiB;
constexpr size_t WS_OWIN = WS_BIG + 88 * MiB;
constexpr size_t WS_OA3 = WS_BIG + 104 * MiB;
constexpr size_t WS_OCMP = 302 * MiB;
constexpr size_t WS_SELB = 318 * MiB;
constexpr size_t WS_LSE = 319 * MiB;
constexpr size_t WS_KSIMG = 320 * MiB;
constexpr size_t WS_END = 328 * MiB;
constexpr size_t WS_KCB = 7 * MiB;
constexpr int CW_MAX = 16384;

#define GAS __attribute__((address_space(1)))
#define LAS __attribute__((address_space(3)))
typedef unsigned short bf16;
typedef unsigned v4u __attribute__((ext_vector_type(4)));
typedef unsigned v2u __attribute__((ext_vector_type(2)));
typedef float f32x4 __attribute__((ext_vector_type(4)));
typedef float f32x2 __attribute__((ext_vector_type(2)));
#define LDS_WAIT() asm volatile("s_waitcnt lgkmcnt(0)" ::: "memory")
#define VM_WAIT() asm volatile("s_waitcnt vmcnt(0)" ::: "memory")
__device__ __forceinline__ unsigned f2bf(float f) { unsigned u = __builtin_bit_cast(unsigned, f); return (u + 0x7fffu + ((u >> 16) & 1u)) >> 16; }
__device__ __forceinline__ unsigned pk2(float lo, float hi) { return f2bf(lo) | (f2bf(hi) << 16); }
__device__ __forceinline__ float bf2f(unsigned short b) { return __uint_as_float((unsigned)b << 16); }
__device__ __forceinline__ float bflo(unsigned w) { return __uint_as_float(w << 16); }
__device__ __forceinline__ float bfhi(unsigned w) { return __uint_as_float(w & 0xffff0000u); }
__device__ __forceinline__ float wave_sum(float v) {
#pragma unroll
    for (int o = 1; o < 64; o <<= 1) v += __shfl_xor(v, o);
    return v;
}
__device__ __forceinline__ float wave_max(float v) {
#pragma unroll
    for (int o = 1; o < 64; o <<= 1) v = fmaxf(v, __shfl_xor(v, o));
    return v;
}

constexpr int RING_BYTES = 162816;
constexpr int LDSCTL_OFF = RING_BYTES, MISC_OFF = LDSCTL_OFF + 320;
constexpr int LDS_BYTES = 163840;

struct Args { const float* in[16]; float* out; unsigned char* ws; int ph_lo, ph_hi; };

struct Frame {
    LAS unsigned char* lds;
    int tid, lane, wave, G, vcu;
    unsigned char* ws;
    const float* in[16];
    float* out;
};
enum { I_X = 0, I_C, I_POS, I_WIN, I_WOUT, I_RELB, I_SINK, I_CPOS, I_CW1, I_CW2, I_MW1, I_MW2, I_ADAW, I_ADAB, I_LNG, I_LNB };

__device__ __forceinline__ int t5_bucket(int d) {
    if (d < 16) return d;
    int b = 16;
    b += d >= 22; b += d >= 30; b += d >= 40; b += d >= 54; b += d >= 73; b += d >= 99; b += d >= 134; b += d >= 182;
    b += d >= 246; b += d >= 332; b += d >= 450; b += d >= 609; b += d >= 825; b += d >= 1117; b += d >= 1513;
    return b;
}
__device__ const float ROPE_FREQ[32] = {1.000000000e+00f, 6.890442967e-01f, 4.747820497e-01f, 3.271458745e-01f, 2.254180014e-01f, 1.553229839e-01f, 1.070244238e-01f, 7.374456525e-02f,
    5.081327632e-02f, 3.501259908e-02f, 2.412523143e-02f, 1.662335359e-02f, 1.145422645e-02f, 7.892469876e-03f, 5.438261200e-03f, 3.747202922e-03f,
    2.581988927e-03f, 1.779104699e-03f, 1.225881977e-03f, 8.446869906e-04f, 5.820267834e-04f, 4.010422272e-04f, 2.763358643e-04f, 1.904076635e-04f,
    1.311993110e-04f, 9.040213627e-05f, 6.229108112e-05f, 4.292131416e-05f, 2.957468678e-05f, 2.037826926e-05f, 1.404153045e-05f, 9.675236470e-06f};
__device__ __forceinline__ void sincos_f(float a, float& c, float& s) {
    const float n = rintf(a * 0.636619772367581343f);
    float r = fmaf(-n, 1.5703125f, a); r = fmaf(-n, 0.0004838267923332751f, r); r = fmaf(-n, 2.5632829192545614e-12f, r);
    const float r2 = r * r;
    const float sp = fmaf(r * r2, fmaf(r2, fmaf(r2, fmaf(r2, 2.755731922e-6f, -1.984126984e-4f), 8.333333333e-3f), -1.666666667e-1f), r);
    const float cp = fmaf(r2, fmaf(r2, fmaf(r2, fmaf(r2, fmaf(r2, -2.755731922e-7f, 2.480158730e-5f), -1.388888889e-3f), 4.166666667e-2f), -0.5f), 1.0f);
    const int q = ((int)n) & 3;
    c = (q == 0) ? cp : (q == 1) ? -sp : (q == 2) ? -cp : sp;
    s = (q == 0) ? sp : (q == 1) ? cp : (q == 2) ? -sp : -cp;
}

template <int MODE>
__device__ __forceinline__ int colmap(int n) {
    if (MODE == 0) return n;
    if (n >= NIN) return -1;
    if (n >= C_BQ && n < C_BV) { const int hb = n & ~63, j = n & 63; return hb + (j >> 1) + 32 * (j & 1); }
    return n;
}
template <int MODE>
__device__ __forceinline__ void transpose_item(const float* W, int K, int N, int NP, bf16* WT, LAS float* scr, int item, int lane) {
    const int nblk = NP / 32, kb = item / nblk, nb = item % nblk, k0 = 64 * kb, n0 = 32 * nb;
    const int src = colmap<MODE>(n0 + (lane & 31));
#pragma unroll 8
    for (int i = 0; i < 32; ++i) { const int kk = 2 * i + (lane >> 5); scr[kk * 33 + (lane & 31)] = src >= 0 ? W[(size_t)(k0 + kk) * N + src] : 0.f; }
    LDS_WAIT(); asm volatile("" ::: "memory");
    const int c = lane & 7;
#pragma unroll
    for (int j = 0; j < 4; ++j) { const int n = (lane >> 3) + 8 * j; const LAS float* s = scr + (8 * c) * 33 + n;
        v4u o; o.x = pk2(s[0 * 33], s[1 * 33]); o.y = pk2(s[2 * 33], s[3 * 33]); o.z = pk2(s[4 * 33], s[5 * 33]); o.w = pk2(s[6 * 33], s[7 * 33]);
        *(v4u*)(WT + (size_t)(n0 + n) * K + k0 + 8 * c) = o; }
    LDS_WAIT(); asm volatile("" ::: "memory");
}

__device__ __forceinline__ void p0_prologue(Frame& F) {
    LAS float* scr = (LAS float*)(F.lds + F.wave * 16384);
    const int gw = F.vcu * NWAVES + F.wave, NGW = F.G * NWAVES;
    constexpr int I_IN = (DM / 64) * (NINP / 32), I_OUT = (DM / 64) * (DM / 32), I_1 = (DM / 64) * (DFF / 32), I_2 = (DFF / 64) * (DM / 32);
    constexpr int PER_LAYER = I_IN + I_OUT + I_1 + I_2;
    for (int it = gw; it < DEPTH * PER_LAYER; it += NGW) {
        const int l = it / PER_LAYER; int r = it % PER_LAYER;
        if (r < I_IN) { transpose_item<1>(F.in[I_WIN] + (size_t)l * DM * NIN, DM, NIN, NINP, (bf16*)(F.ws + WS_WIN) + (size_t)l * NINP * DM, scr, r, F.lane); continue; } r -= I_IN;
        if (r < I_OUT) { transpose_item<0>(F.in[I_WOUT] + (size_t)l * DM * DM, DM, DM, DM, (bf16*)(F.ws + WS_WOUT) + (size_t)l * DM * DM, scr, r, F.lane); continue; } r -= I_OUT;
        if (r < I_1) { transpose_item<0>(F.in[I_MW1] + (size_t)l * DM * DFF, DM, DFF, DFF, (bf16*)(F.ws + WS_W1) + (size_t)l * DFF * DM, scr, r, F.lane); continue; } r -= I_1;
        transpose_item<0>(F.in[I_MW2] + (size_t)l * DFF * DM, DFF, DM, DM, (bf16*)(F.ws + WS_W2) + (size_t)l * DM * DFF, scr, r, F.lane);
    }
    {
        __syncthreads();
        LAS float* red = (LAS float*)F.lds;
        const int nl = F.tid & 63, kp = F.tid >> 6;
        for (int it = F.vcu; it < DEPTH * 96; it += F.G) {
            const int l = it / 96, n = (it % 96) * 64 + nl;
            const float* w = F.in[I_ADAW] + (size_t)l * DM * 6144 + n;
            const float* c = F.in[I_C];
            float a = 0.f;
#pragma unroll 8
            for (int k = kp * 128; k < kp * 128 + 128; ++k) { const float cv = c[k]; a += (cv / (1.0f + __expf(-cv))) * w[(size_t)k * 6144]; }
            red[kp * 64 + nl] = a;
            __syncthreads();
            if (kp == 0) { float s = F.in[I_ADAB][l * 6144 + n];
#pragma unroll
                for (int j = 0; j < 8; ++j) s += red[j * 64 + nl];
                ((float*)(F.ws + WS_MOD))[l * 6144 + n] = s; }
            __syncthreads();
        }
    }
    {
        const int gt = F.vcu * NTHREADS + F.tid, NGT = F.G * NTHREADS;
        const int* pos = (const int*)F.in[I_POS];
        f32x2* rt = (f32x2*)(F.ws + WS_ROPE);
        for (int e = gt; e < S * 32; e += NGT) {
            const int r = e >> 5, i = e & 31;
            const float ang = (float)pos[r] * ROPE_FREQ[i];
            float cs, sn; sincos_f(ang, cs, sn);
            rt[e] = (f32x2){cs, sn};
        }
        if (gt < 12) { float m = -1e30f; for (int b = 0; b < 32; ++b) m = fmaxf(m, F.in[I_RELB][b * 12 + gt] * LOG2E); ((float*)(F.ws + WS_BMAX))[gt] = m; }
        for (int e = gt; e < 8 * 256 * 256; e += NGT) { const int mtx = e >> 16, c = (e >> 8) & 255, n = e & 255; const float* w = F.in[I_CW1] + (size_t)mtx * 2048 * 256 + (size_t)(8 * c) * 256 + n;
            v4u o; o.x = pk2(w[0], w[256]); o.y = pk2(w[512], w[768]); o.z = pk2(w[1024], w[1280]); o.w = pk2(w[1536], w[1792]);
            *(v4u*)((bf16*)(F.ws + WS_CW1) + (size_t)e * 8) = o; }
        for (int e = gt; e < 8 * 64 * 32; e += NGT) { const int mtx = e >> 11, ee = (e >> 5) & 63, jc = e & 31; const float* w = F.in[I_CW2] + (size_t)mtx * 256 * 64 + (size_t)(8 * jc) * 64 + ee;
            v4u o; o.x = pk2(w[0], w[64]); o.y = pk2(w[128], w[192]); o.z = pk2(w[256], w[320]); o.w = pk2(w[384], w[448]);
            *(v4u*)((bf16*)(F.ws + WS_CW2T) + (size_t)e * 8) = o; }
        for (int e = gt; e < 8 * 256; e += NGT) { const int mtx = e >> 8, n = e & 255; const float* w = F.in[I_CW1] + (size_t)mtx * 2048 * 256 + n; const float* ps = F.in[I_CPOS] + (size_t)mtx * 2048;
            float a = 0.f;
#pragma unroll 8
            for (int f = 0; f < 2048; ++f) a += ps[f] * w[(size_t)f * 256];
            ((float*)(F.ws + WS_POSW1))[e] = a; }
        float* bt = (float*)(F.ws + WS_BIAS);
        for (int e = gt; e < 12 * BIASLEN; e += NGT) {
            const int h = e / BIASLEN, d = e % BIASLEN;
            bt[e] = F.in[I_RELB][t5_bucket(d) * 12 + h] * LOG2E;
        }
    }
}

template <int MODE>
__device__ __forceinline__ void row_pass(Frame& F, const float* xin, float* xout, bf16* H, const float* lng, const float* lnb, const float* sc, const float* sh) {
    const int gw = F.vcu * NWAVES + F.wave, NGW = F.G * NWAVES;
    for (int m = gw; m < S; m += NGW) {
        const f32x4* xr = (const f32x4*)(xin + (size_t)m * DM) + F.lane;
        f32x4 v[4];
#pragma unroll
        for (int j = 0; j < 4; ++j) v[j] = xr[64 * j];
        if (MODE != 0) {
            float s = 0.f;
#pragma unroll
            for (int j = 0; j < 4; ++j) s += (v[j].x + v[j].y) + (v[j].z + v[j].w);
            const float mean = wave_sum(s) * (1.f / DM); float s2 = 0.f;
#pragma unroll
            for (int j = 0; j < 4; ++j) { v[j] = v[j] - mean; s2 += (v[j].x * v[j].x + v[j].y * v[j].y) + (v[j].z * v[j].z + v[j].w * v[j].w); }
            const float rstd = 1.f / sqrtf(wave_sum(s2) * (1.f / DM) + LN_EPS);
            f32x4* xo = (f32x4*)(xout + (size_t)m * DM) + F.lane;
#pragma unroll
            for (int j = 0; j < 4; ++j) { const f32x4 g = ((const f32x4*)lng)[F.lane + 64 * j], b = ((const f32x4*)lnb)[F.lane + 64 * j]; v[j] = v[j] * rstd * g + b; xo[64 * j] = v[j]; }
        }
        if (MODE != 2) {
            v2u* o8 = (v2u*)(H + (size_t)m * DM) + F.lane;
#pragma unroll
            for (int j = 0; j < 4; ++j) { const f32x4 a = ((const f32x4*)sc)[F.lane + 64 * j] + 1.0f, b = ((const f32x4*)sh)[F.lane + 64 * j]; const f32x4 h = v[j] * a + b;
                o8[64 * j] = (v2u){pk2(h.x, h.y), pk2(h.z, h.w)}; }
        }
    }
}

typedef GAS unsigned gu32;
typedef GAS unsigned long long gu64;
#define RLX_AGENT __ATOMIC_RELAXED, __HIP_MEMORY_SCOPE_AGENT
__device__ __forceinline__ unsigned long long rt() { return __builtin_amdgcn_s_memrealtime(); }

#define XB_TMO      128
#define XB_XCNT(j)  (256  + 64 * (j))
#define XB_XSUB(j)  (1280 + 64 * (j))
#define XB_XGEN(j)  (2304 + 64 * (j))
#define XB_TOP      3328
#define XB_TOPGEN   3392
#define XCD_BAR_WORDS 3456
#define XB_SPIN_CAP (1u << 18)

__device__ __forceinline__ unsigned xb_ld(unsigned* p)              { return __hip_atomic_load(p, __ATOMIC_RELAXED, __HIP_MEMORY_SCOPE_AGENT); }
__device__ __forceinline__ unsigned xb_add(unsigned* p, unsigned v) { return __hip_atomic_fetch_add(p, v, __ATOMIC_RELAXED, __HIP_MEMORY_SCOPE_AGENT); }
__device__ __forceinline__ unsigned xb_xcc_id() { return (unsigned)__builtin_amdgcn_s_getreg((3 << 11) | 20) & 0xFu; }
#define XB_SPIN(cond, bar) do { unsigned _sp = 0; while (cond) { __builtin_amdgcn_s_sleep(1); \
    if ((++_sp & 255u) == 0u) { if (xb_ld(&(bar)[XB_TMO])) break; if (_sp > XB_SPIN_CAP) { atomicAdd(&(bar)[XB_TMO], 1u); break; } } } } while (0)

struct XcdBarrier {
    unsigned* bar; unsigned x;
    volatile LAS unsigned* st;
};

__device__ __forceinline__ XcdBarrier xcd_barrier_post(unsigned* bar, volatile LAS unsigned* st) {
    XcdBarrier b; b.bar = bar; b.x = xb_xcc_id(); b.st = st;
    if (threadIdx.x == 0) (void)xb_add(&bar[XB_XCNT(b.x)], 1u);
    return b;
}
__device__ __forceinline__ void xcd_barrier_complete(unsigned* bar, unsigned x, unsigned& nloc, unsigned& nx) {
    const unsigned G = gridDim.x * gridDim.y * gridDim.z;
    unsigned sum, cnt, mine, sp = 0u;
    for (;;) {
        sum = 0u; cnt = 0u; mine = 0u;
#pragma unroll
        for (unsigned j = 0; j < 16; ++j) { const unsigned c = xb_ld(&bar[XB_XCNT(j)]); sum += c; cnt += (c > 0u) ? 1u : 0u; mine = (j == x) ? c : mine; }
        if (sum == G) break;
        __builtin_amdgcn_s_sleep(1);
        if ((++sp & 255u) == 0u) { if (xb_ld(&bar[XB_TMO])) break; if (sp > XB_SPIN_CAP) { atomicAdd(&bar[XB_TMO], 1u); break; } }
    }
    nloc = mine > 0u ? mine : 1u; nx = cnt > 0u ? cnt : 1u;
}

__device__ __forceinline__ void xcd_barrier(const XcdBarrier& b) {
    asm volatile("s_waitcnt vmcnt(0)" ::: "memory");
    __syncthreads();
    if (threadIdx.x == 0) {
        unsigned* bar = b.bar;
        __builtin_amdgcn_s_waitcnt(0);
        unsigned nloc = b.st[0], nx = b.st[1];
        if (nloc == 0u) { xcd_barrier_complete(bar, b.x, nloc, nx); b.st[0] = nloc; b.st[1] = nx; }
        const unsigned old = xb_add(&bar[XB_XSUB(b.x)], 1u);
        const unsigned gen = old / nloc;
        if (old + 1u == (gen + 1u) * nloc) {
            __builtin_amdgcn_fence(__ATOMIC_RELEASE, "agent");
            asm volatile("s_waitcnt vmcnt(0)" ::: "memory");
            const unsigned og = xb_add(&bar[XB_TOP], 1u);
            const unsigned tg = og / nx;
            if (og + 1u == (tg + 1u) * nx) xb_add(&bar[XB_TOPGEN], 1u);
            else XB_SPIN(xb_ld(&bar[XB_TOPGEN]) == tg, bar);
            __builtin_amdgcn_fence(__ATOMIC_ACQUIRE, "agent");
            xb_add(&bar[XB_XGEN(b.x)], 1u);
            asm volatile("s_waitcnt vmcnt(0)" ::: "memory");
        } else {
            XB_SPIN(xb_ld(&bar[XB_XGEN(b.x)]) == gen, bar);
            __builtin_amdgcn_fence(__ATOMIC_ACQUIRE, "agent");
            asm volatile("s_waitcnt vmcnt(0)" ::: "memory");
        }
    }
    __syncthreads();
}


__device__ __forceinline__ float ld_elem(const bf16* p) { return bf2f(*p); }
__device__ __forceinline__ float ld_elem(const float* p) { return *p; }
template <int G>
__device__ __forceinline__ void dot64(const bf16* k, const LAS float* qs, float (&s)[G]) {
    const v4u* kp = (const v4u*)k;
#pragma unroll 2
    for (int c = 0; c < 8; ++c) { const v4u w = kp[c];
        float kv[8] = {bflo(w.x), bfhi(w.x), bflo(w.y), bfhi(w.y), bflo(w.z), bfhi(w.z), bflo(w.w), bfhi(w.w)};
#pragma unroll
        for (int g = 0; g < G; ++g) { const LAS f32x4* q4 = (const LAS f32x4*)(qs + g * 64 + c * 8); const f32x4 a = q4[0], b = q4[1];
            s[g] += kv[0] * a.x + kv[1] * a.y + kv[2] * a.z + kv[3] * a.w + kv[4] * b.x + kv[5] * b.y + kv[6] * b.z + kv[7] * b.w; } }
}
template <int G>
__device__ __forceinline__ void dot64(const float* k, const LAS float* qs, float (&s)[G]) {
    const f32x4* kp = (const f32x4*)k;
#pragma unroll 2
    for (int c = 0; c < 16; ++c) { const f32x4 w = kp[c];
#pragma unroll
        for (int g = 0; g < G; ++g) { const f32x4 a = *(const LAS f32x4*)(qs + g * 64 + c * 4); s[g] += w.x * a.x + w.y * a.y + w.z * a.z + w.w * a.w; } }
}
template <int G, class KT, class KeyFn>
__device__ __forceinline__ void wave_attend(const KT* K, const KT* V, const LAS float* qs, int nk, const KeyFn& kf, float (&m)[G], float (&l)[G], float (&o)[G], int lane) {
    for (int base = 0; base < nk; base += 64) {
        const int i = base + lane;
        long off = 0; float s[G], p[G];
#pragma unroll
        for (int g = 0; g < G; ++g) s[g] = 0.f;
        bool valid = false;
        if (i < nk) valid = kf(i, off, s);
        const LAS float* qo = qs; asm volatile("" : "+v"(qo));
        if (valid) dot64<G>(K + off, qo, s);
        const unsigned long long mask = __ballot(valid);
        if (mask == 0ull) continue;
#pragma unroll
        for (int g = 0; g < G; ++g) {
            const float sv = valid ? s[g] : -1e30f;
            const float mn = fmaxf(m[g], wave_max(sv));
            const float scl = exp2f(m[g] - mn);
            p[g] = valid ? exp2f(sv - mn) : 0.f;
            l[g] = l[g] * scl + wave_sum(p[g]); o[g] *= scl; m[g] = mn;
        }
#pragma unroll 2
        for (int j = 0; j < 64; ++j) {
            if (!((mask >> j) & 1ull)) continue;
            const unsigned olo = __builtin_amdgcn_readlane((unsigned)(unsigned long long)off, j), ohi = __builtin_amdgcn_readlane((unsigned)((unsigned long long)off >> 32), j);
            const long oj = (long)(((unsigned long long)ohi << 32) | olo);
            const float v = ld_elem(V + oj + lane);
#pragma unroll
            for (int g = 0; g < G; ++g) o[g] += __uint_as_float(__builtin_amdgcn_readlane(__float_as_uint(p[g]), j)) * v;
        }
    }
}

struct KeyA { int p, r; const float* bias; __device__ __forceinline__ bool operator()(int i, long& off, float (&b)[1]) const {
    const int row = p - r * i; if (row < 0) return false; off = (long)row * NINP; const int d = r * i; b[0] = bias[d < BIASLEN ? d : BIASLEN - 1]; return true; } };
struct KeyB { int p; __device__ __forceinline__ bool operator()(int i, long& off, float (&b)[2]) const {
    const int row = p - i; if (row < 0) return false; off = (long)row * NINP; return true; } };
struct KeyW { int p; const float* bias; __device__ __forceinline__ bool operator()(int i, long& off, float (&b)[4]) const {
    const int row = p - i; if (row < 0) return false; off = (long)row * NINP;
#pragma unroll
    for (int g = 0; g < 4; ++g) b[g] = bias[g * BIASLEN + i]; return true; } };

__device__ __forceinline__ void load_q(const bf16* q, LAS float* qs, int lane) { qs[lane] = bf2f(q[lane]); }

__device__ __forceinline__ void p2_token_attention(Frame& F, int layer, const bf16* PROJ, bf16* MIXED, bf16* OWIN) {
    LAS float* qs = (LAS float*)(F.lds + F.wave * 2048);
    const int gw = F.vcu * NWAVES + F.wave, NGW = F.G * NWAVES, lane = F.lane;
    const float* bias2 = (const float*)(F.ws + WS_BIAS);
    for (int it = gw; it < S * 4; it += NGW) {
        const int p = it >> 2, h = it & 3;
        load_q(PROJ + (size_t)p * NINP + C_AQ + h * 64, qs, lane); LDS_WAIT(); asm volatile("" ::: "memory");
        float m[1] = {-1e30f}, l[1] = {0.f}, o[1] = {0.f};
        const bf16* K = PROJ + C_AK + h * 64; const bf16* V = PROJ + C_AV + h * 64;
#pragma unroll 1
        for (int c = 0; c < 3; ++c) { const int r = c == 0 ? 1 : (c == 1 ? 4 : 16); KeyA kf{p, r, bias2 + h * BIASLEN}; wave_attend<1>(K, V, qs, 129, kf, m, l, o, lane); }
        MIXED[(size_t)p * DM + h * 64 + lane] = (bf16)f2bf(o[0] / l[0]);
        LDS_WAIT(); asm volatile("" ::: "memory");
    }
    for (int it = gw; it < S * 2; it += NGW) {
        const int p = it >> 1, kvh = it & 1;
        load_q(PROJ + (size_t)p * NINP + C_BQ + (2 * kvh) * 64, qs, lane); load_q(PROJ + (size_t)p * NINP + C_BQ + (2 * kvh + 1) * 64, qs + 64, lane); LDS_WAIT(); asm volatile("" ::: "memory");
        float m[2] = {-1e30f, -1e30f}, l[2] = {0.f, 0.f}, o[2] = {0.f, 0.f};
        KeyB kf{p}; wave_attend<2>(PROJ + C_BK + kvh * 64, PROJ + C_BV + kvh * 64, qs, 128, kf, m, l, o, lane);
#pragma unroll
        for (int g = 0; g < 2; ++g) { const float sk = F.in[I_SINK][layer * 4 + 2 * kvh + g] * LOG2E; const float mn = fmaxf(m[g], sk); const float scl = exp2f(m[g] - mn);
            const float den = l[g] * scl + exp2f(sk - mn); MIXED[(size_t)p * DM + 256 + (2 * kvh + g) * 64 + lane] = (bf16)f2bf(o[g] * scl / den); }
        LDS_WAIT(); asm volatile("" ::: "memory");
    }
    for (int it = gw; it < S * 2; it += NGW) {
        const int p = it >> 1, kvh = it & 1;
#pragma unroll
        for (int g = 0; g < 4; ++g) load_q(PROJ + (size_t)p * NINP + C_CQ + (4 * kvh + g) * 64, qs + g * 64, lane);
        LDS_WAIT(); asm volatile("" ::: "memory");
        float m[4] = {-1e30f, -1e30f, -1e30f, -1e30f}, l[4] = {0.f, 0.f, 0.f, 0.f}, o[4] = {0.f, 0.f, 0.f, 0.f};
        KeyW kf{p, bias2 + (4 + 4 * kvh) * BIASLEN}; wave_attend<4>(PROJ + C_CKW + kvh * 64, PROJ + C_CVW + kvh * 64, qs, 512, kf, m, l, o, lane);
#pragma unroll
        for (int g = 0; g < 4; ++g) OWIN[(size_t)p * 512 + (4 * kvh + g) * 64 + lane] = (bf16)f2bf(o[g] / l[g]);
        LDS_WAIT(); asm volatile("" ::: "memory");
    }
}

__device__ __forceinline__ float gelu_tanh(float x) { const float u = 0.7978845608028654f * (x + 0.044715f * x * x * x); return 0.5f * x * (1.0f + tanhf(u)); }
__device__ __forceinline__ void p2_compress(Frame& F, int layer, const bf16* PROJ) {
    LAS float* flat = (LAS float*)F.lds;
    LAS float* hid = flat + 8 * 2048;
    const int tid = F.tid;
    for (int it = F.vcu; it < 2 * 256; it += F.G) {
        const int kv = it >> 8, rg = it & 255;
        const float* pos = F.in[I_CPOS] + ((size_t)layer * 2 + kv) * 2048;
        const float* w1 = F.in[I_CW1] + ((size_t)layer * 2 + kv) * 2048 * 256;
        const float* w2 = F.in[I_CW2] + ((size_t)layer * 2 + kv) * 256 * 64;
        float* outp = (float*)(F.ws + (kv ? WS_VC : WS_KC));
        __syncthreads();
        for (int e = tid; e < 8 * 2048; e += NTHREADS) {
            const int r = e >> 11, f = e & 2047, R = rg * 8 + r, i = R >> 1, hk = R & 1, t = f >> 6, d = f & 63;
            float v = 0.f;
            if (i < NCMP) v = bf2f(PROJ[(size_t)(16 * i + t) * NINP + (kv ? C_CVC : C_CKC) + hk * 64 + d]) + pos[f];
            flat[e] = v;
        }
        __syncthreads();
        { const int j = tid & 255, half = tid >> 8; float a[4] = {0.f, 0.f, 0.f, 0.f}; const LAS float* fl = flat + half * 4 * 2048;
#pragma unroll 4
            for (int f = 0; f < 2048; ++f) { const float w = w1[(size_t)f * 256 + j];
#pragma unroll
                for (int r = 0; r < 4; ++r) a[r] += fl[r * 2048 + f] * w; }
#pragma unroll
            for (int r = 0; r < 4; ++r) hid[(half * 4 + r) * 256 + j] = gelu_tanh(a[r]); }
        __syncthreads();
        { const int r = tid >> 6, e = tid & 63, R = rg * 8 + r; float a = 0.f;
#pragma unroll 8
            for (int j = 0; j < 256; ++j) a += hid[r * 256 + j] * w2[j * 64 + e];
            if ((R >> 1) < NCMP) { outp[(size_t)R * 64 + e] = a; const unsigned ab = f2bf(a); (void)ab;
                const float ar = bf2f((unsigned short)ab); const float n2 = wave_sum(ar * ar);
                if (kv == 0 && e == 0) __hip_atomic_fetch_max((unsigned*)(F.ws + WS_CTL) + CW_MAX + layer * 16 + (R & 1), __float_as_uint(n2), __ATOMIC_RELAXED, __HIP_MEMORY_SCOPE_AGENT); } }
    }
    __syncthreads();
}

struct KeyCmp { int g; __device__ __forceinline__ bool operator()(int i, long& off, float (&b)[4]) const { off = ((long)i * 2 + g) * 64; return true; } };
struct KeySel { int p, blk; const float* bias; __device__ __forceinline__ bool operator()(int i, long& off, float (&b)[4]) const {
    const int kpos = blk * 64 + i; if (kpos > p) return false; off = (long)kpos * NINP; const int d = p - kpos;
#pragma unroll
    for (int g = 0; g < 4; ++g) b[g] = bias[g * BIASLEN + (d < BIASLEN ? d : BIASLEN - 1)]; return true; } };

__device__ __forceinline__ void p3_nsa(Frame& F, int layer, const bf16* PROJ, const bf16* OWIN, bf16* MIXED) {
    LAS float* qs = (LAS float*)(F.lds + F.wave * 8192);
    LAS float* imp = qs + 256;
    const int gw = F.vcu * NWAVES + F.wave, NGW = F.G * NWAVES, lane = F.lane;
    const float* bias2 = (const float*)(F.ws + WS_BIAS);
    const float* KC = (const float*)(F.ws + WS_KC); const float* VC = (const float*)(F.ws + WS_VC);
    for (int it = gw; it < S * 2; it += NGW) {
        const int p = it >> 1, kvh = it & 1;
#pragma unroll
        for (int g = 0; g < 4; ++g) load_q(PROJ + (size_t)p * NINP + C_CQ + (4 * kvh + g) * 64, qs + g * 64, lane);
        for (int e = lane; e < 1040; e += 64) imp[e] = 0.f;
        LDS_WAIT(); asm volatile("" ::: "memory");
        int nv = p >= 31 ? ((p - 31) >> 4) + 1 : 0; if (nv > NCMP) nv = NCMP;
        float m1[4] = {-1e30f, -1e30f, -1e30f, -1e30f}, l1[4] = {0.f, 0.f, 0.f, 0.f}, o1[4] = {0.f, 0.f, 0.f, 0.f};
        { KeyCmp kf{kvh}; wave_attend<4>(KC, VC, qs, nv, kf, m1, l1, o1, lane); }
        for (int base = 0; base < nv; base += 64) { const int i = base + lane;
            const LAS float* qo = qs; asm volatile("" : "+v"(qo));
            if (i < nv) { float s[4] = {0.f, 0.f, 0.f, 0.f}; dot64<4>(KC + ((size_t)i * 2 + kvh) * 64, qo, s); float a = 0.f;
#pragma unroll
                for (int g = 0; g < 4; ++g) a += exp2f(s[g] - m1[g]) / fmaxf(l1[g], 1e-30f);
                imp[1 + i] = a; } }
        LDS_WAIT(); asm volatile("" ::: "memory");
        const int cur = p >> 6;
        float sc[4];
#pragma unroll
        for (int c = 0; c < 4; ++c) { const int j = lane + 64 * c; const LAS float* q = imp + 4 * j;
            const float is = 0.5f * q[0] + q[1] + q[2] + q[3] + 0.5f * q[4];
            const bool forced = (j == 0) || (j == cur) || (j == cur - 1);
            sc[c] = forced ? 1e4f : ((j * 64 <= p) ? is : -1e30f); }
        float m2[4] = {-1e30f, -1e30f, -1e30f, -1e30f}, l2[4] = {0.f, 0.f, 0.f, 0.f}, o2[4] = {0.f, 0.f, 0.f, 0.f};
#pragma unroll 1
        for (int k = 0; k < 16; ++k) {
            float bv = sc[0]; int bi = lane;
#pragma unroll
            for (int c = 1; c < 4; ++c) if (sc[c] > bv) { bv = sc[c]; bi = lane + 64 * c; }
#pragma unroll
            for (int off = 1; off < 64; off <<= 1) { const float ov = __shfl_xor(bv, off); const int oi = __shfl_xor(bi, off); if (ov > bv || (ov == bv && oi < bi)) { bv = ov; bi = oi; } }
#pragma unroll
            for (int c = 0; c < 4; ++c) if (bi == lane + 64 * c) sc[c] = -3e38f;
            if (bi * 64 <= p) { KeySel kf{p, bi, bias2 + (4 + 4 * kvh) * BIASLEN}; wave_attend<4>(PROJ + C_CKS + kvh * 64, PROJ + C_CVS + kvh * 64, qs, 64, kf, m2, l2, o2, lane); }
        }
#pragma unroll
        for (int g = 0; g < 4; ++g) { const int H = 4 * kvh + g;
            const float g0 = bf2f(PROJ[(size_t)p * NINP + C_CG + H * 3 + 0]), g1 = bf2f(PROJ[(size_t)p * NINP + C_CG + H * 3 + 1]), g2 = bf2f(PROJ[(size_t)p * NINP + C_CG + H * 3 + 2]);
            const float ocmp = o1[g] / fmaxf(l1[g], 1e-30f), oslc = o2[g] / l2[g], owin = bf2f(OWIN[(size_t)p * 512 + H * 64 + lane]);
            MIXED[(size_t)p * DM + 512 + H * 64 + lane] = (bf16)f2bf(g0 * ocmp + g1 * oslc + g2 * owin); }
        LDS_WAIT(); asm volatile("" ::: "memory");
    }
}


namespace ba {
typedef short bf16x8 __attribute__((ext_vector_type(8)));
typedef short s16x4 __attribute__((ext_vector_type(4)));
typedef short v4i16_t __attribute__((ext_vector_type(4)));
typedef float f32x16 __attribute__((ext_vector_type(16)));
typedef float f32x2_t __attribute__((ext_vector_type(2))); typedef __bf16 bf16x2_t __attribute__((ext_vector_type(2)));
typedef LAS const char* lds_cptr;
__device__ __forceinline__ unsigned cvtpk(float lo, float hi) { f32x2_t v = {lo, hi}; bf16x2_t b = __builtin_convertvector(v, bf16x2_t); return __builtin_bit_cast(unsigned, b); }
__device__ __forceinline__ s16x4 vtr(lds_cptr p) { return __builtin_bit_cast(s16x4, __builtin_amdgcn_ds_read_tr16_b64_v4i16((LAS v4i16_t*)p)); }
__device__ __forceinline__ float half_sum(float x) { auto rr = __builtin_amdgcn_permlane32_swap(__float_as_uint(x), __float_as_uint(x), false, false); return __uint_as_float(rr[0]) + __uint_as_float(rr[1]); }
constexpr int KIMG = 0, VIMG = 49152, TBL = 98304, WSCR = 108544, KMAX = 110592;

struct Unit {
    const bf16* Q; const bf16* K; const bf16* V;
    bf16* O; int opitch;
    float* lse; int lse_pitch;
    const float* bias;
    const float* bmax;
    const float* sink;
    int rs, rho, u0;
    int W, Wp;
};

template <int NT, int NH>
__device__ __forceinline__ void run_unit(LAS unsigned char* lds, const Unit& U, int wave, int lane, int tid) {
    static_assert(NT * NH == 8, "one wave-task per wave");
    const int r32 = lane & 31, hi = lane >> 5;
    const int NQ = 32 * NT, NKT = U.Wp + NQ, nch = (NKT + 383) / 384, CH = NKT / nch;
    const int tile = wave % NT, hl = wave / NT, uw = U.u0 + 32 * tile;
    const int TW = U.Wp + 64;
    __syncthreads();
    for (int e = tid; e < NH * TW; e += NTHREADS) { const int h = e / TW, dist = e % TW - 32;
        float v = -1e30f; if (dist >= 0 && dist <= U.W) { v = 0.f; if (U.bias) { const int td = dist * U.rs; v = U.bias[h * BIASLEN + (td < BIASLEN ? td : BIASLEN - 1)]; } }
        ((LAS float*)(lds + TBL))[e] = v; }
    if (tid == 0) *(LAS unsigned*)(lds + KMAX) = 0u;
    __syncthreads();
    { float mx = 0.f;
      for (int idx = tid; idx < NKT * 8; idx += NTHREADS) { const int n = idx >> 3, c = idx & 7, u = U.u0 - U.Wp + n; float s = 0.f;
          if (u >= 0) { const v4u w = *(const v4u*)(U.K + (size_t)(U.rho + U.rs * u) * NINP + c * 8);
              const float a0 = bflo(w.x), a1 = bfhi(w.x), a2 = bflo(w.y), a3 = bfhi(w.y), a4 = bflo(w.z), a5 = bfhi(w.z), a6 = bflo(w.w), a7 = bfhi(w.w);
              s = a0 * a0 + a1 * a1 + a2 * a2 + a3 * a3 + a4 * a4 + a5 * a5 + a6 * a6 + a7 * a7; }
          s += __shfl_xor(s, 1); s += __shfl_xor(s, 2); s += __shfl_xor(s, 4); mx = fmaxf(mx, s); }
      mx = wave_max(mx);
      if (lane == 0) __hip_atomic_fetch_max((LAS unsigned*)(lds + KMAX), __float_as_uint(mx), __ATOMIC_RELAXED, __HIP_MEMORY_SCOPE_WORKGROUP); }
    const int qtok = U.rho + U.rs * (uw + r32);
    bf16x8 qr[4]; float qn = 0.f;
    { const bf16* qp = U.Q + (size_t)qtok * NINP + hl * 64 + hi * 8;
#pragma unroll
      for (int d0 = 0; d0 < 4; ++d0) { qr[d0] = *(const bf16x8*)(qp + d0 * 16);
#pragma unroll
          for (int j = 0; j < 8; ++j) { const float x = bf2f((unsigned short)qr[d0][j]); qn += x * x; } }
      qn = half_sum(qn); }
    __syncthreads();
    const float kmax2 = __uint_as_float(*(LAS unsigned*)(lds + KMAX));
    float M = sqrtf(qn * kmax2) * 1.0002f + 1e-6f;
    if (U.bmax) M += fmaxf(U.bmax[hl], 0.f);
    float sink2 = 0.f; if (U.sink) { sink2 = U.sink[hl] * LOG2E; M = fmaxf(M, sink2); }
    f32x16 negm;
#pragma unroll
    for (int r = 0; r < 16; ++r) negm[r] = -M;
    f32x16 o0 = {}, o1 = {}; float lsum = 0.f;
    const LAS float* tbl = (const LAS float*)(lds + TBL) + hl * TW;
    for (int ck = 0; ck < nch; ++ck) {
        const int kc0 = U.u0 - U.Wp + ck * CH;
        if (ck > 0) __syncthreads();
        for (int idx = tid; idx < CH * 16; idx += NTHREADS) { const int n = idx >> 4, isv = (idx >> 3) & 1, c = idx & 7, u = kc0 + n;
            v4u w = {0u, 0u, 0u, 0u};
            if (u >= 0) w = *(const v4u*)((isv ? U.V : U.K) + (size_t)(U.rho + U.rs * u) * NINP + c * 8);
            if (isv) *(LAS v4u*)(lds + VIMG + (c >> 2) * (CH * 64) + n * 64 + (c & 3) * 16) = w;
            else     *(LAS v4u*)(lds + KIMG + c * (CH * 16) + n * 16) = w; }
        __syncthreads();
        const int nbt = U.Wp / 32 + 1;
        for (int t = 0; t < nbt; ++t) {
            const int kt0 = uw - U.Wp + 32 * t, kl = kt0 - kc0;
            if (kt0 < 0 || kl < 0 || kl >= CH) continue;
            f32x16 s;
            { const lds_cptr kb = (lds_cptr)(lds + KIMG) + hi * (CH * 16) + (kl + r32) * 16;
#pragma unroll
              for (int d0 = 0; d0 < 4; ++d0) { const bf16x8 kf = *(const LAS bf16x8*)(kb + d0 * (2 * CH * 16));
                  s = __builtin_amdgcn_mfma_f32_32x32x16_bf16(kf, qr[d0], d0 == 0 ? negm : s, 0, 0, 0); } }
            { const LAS float* tb = tbl + (U.Wp - 32 * t) + r32 - 4 * hi + 32 - 27;
#pragma unroll
              for (int r = 0; r < 16; ++r) s[r] = __builtin_amdgcn_exp2f(s[r] + tb[27 - ((r & 3) + 8 * (r >> 2))]); }
            float ps = 0.f;
#pragma unroll
            for (int r = 0; r < 16; ++r) ps += s[r];
            lsum += ps;
            bf16x8 pa0, pa1;
            { v4u w0 = {cvtpk(s[0], s[1]), cvtpk(s[2], s[3]), cvtpk(s[4], s[5]), cvtpk(s[6], s[7])}, w1 = {cvtpk(s[8], s[9]), cvtpk(s[10], s[11]), cvtpk(s[12], s[13]), cvtpk(s[14], s[15])};
              pa0 = __builtin_bit_cast(bf16x8, w0); pa1 = __builtin_bit_cast(bf16x8, w1); }
            { const lds_cptr vp = (lds_cptr)(lds + VIMG) + ((lane >> 4) & 1) * 32 + (lane & 3) * 8 + (kl + 4 * hi + ((lane & 15) >> 2)) * 64;
#pragma unroll
              for (int dh = 0; dh < 2; ++dh)
#pragma unroll
                  for (int g = 0; g < 2; ++g) { const s16x4 lo = vtr(vp + dh * (CH * 64) + g * 1024), hv = vtr(vp + dh * (CH * 64) + g * 1024 + 512);
                      const bf16x8 vf = {lo[0], lo[1], lo[2], lo[3], hv[0], hv[1], hv[2], hv[3]};
                      if (dh == 0) o0 = __builtin_amdgcn_mfma_f32_32x32x16_bf16(g == 0 ? pa0 : pa1, vf, o0, 0, 0, 0);
                      else         o1 = __builtin_amdgcn_mfma_f32_32x32x16_bf16(g == 0 ? pa0 : pa1, vf, o1, 0, 0, 0); } }
        }
    }
    float l = half_sum(lsum);
    if (U.sink) l += exp2f(sink2 - M);
    LAS float* wsf = (LAS float*)(lds + WSCR) + wave * 64;
    if (hi == 0) wsf[r32] = 1.0f / l;
    if (U.lse && hi == 0) U.lse[(size_t)qtok * U.lse_pitch + hl] = M + log2f(l);
    LDS_WAIT(); asm volatile("" ::: "memory");
#pragma unroll
    for (int r = 0; r < 16; ++r) { const int qo = (r & 3) + 8 * (r >> 2) + 4 * hi; const float rl = wsf[qo];
        bf16* op = U.O + (size_t)(U.rho + U.rs * (uw + qo)) * U.opitch + hl * 64 + r32;
        op[0] = (bf16)f2bf(o0[r] * rl); op[32] = (bf16)f2bf(o1[r] * rl); }
}
}

constexpr int P2_NA = 3 * 4 * 64, P2_NB = 2 * 128, P2_NC = 2 * 256, P2_NUNITS = P2_NA + P2_NB + P2_NC;
__device__ __forceinline__ void p2_banded(Frame& F, int layer, const bf16* PROJ, bf16* MIXED, bf16* OWIN) {
    const float* bias2 = (const float*)(F.ws + WS_BIAS); const float* bmax = (const float*)(F.ws + WS_BMAX);
    bf16* OA3 = (bf16*)(F.ws + WS_OA3); float* LSE = (float*)(F.ws + WS_LSE);
    for (int it = F.vcu; it < P2_NUNITS; it += F.G) {
        ba::Unit U{};
        if (it < P2_NC) { const int kvh = it & 1, blk = it >> 1;
            U.Q = PROJ + C_CQ + kvh * 256; U.K = PROJ + C_CKW + kvh * 64; U.V = PROJ + C_CVW + kvh * 64; U.O = OWIN + kvh * 256; U.opitch = 512;
            U.bias = bias2 + (4 + 4 * kvh) * BIASLEN; U.bmax = bmax + 4 + 4 * kvh; U.rs = 1; U.rho = 0; U.u0 = blk * 64; U.W = 511; U.Wp = 512;
            ba::run_unit<2, 4>(F.lds, U, F.wave, F.lane, F.tid);
        } else if (it < P2_NC + P2_NA) { const int a = it - P2_NC, h = a & 3, c = (a >> 2) % 3, blk = (a >> 2) / 3;
            const int rs = c == 0 ? 1 : (c == 1 ? 4 : 16), per = S / rs / 256;
            const int rho = blk / per, ub = blk % per;
            U.Q = PROJ + C_AQ + h * 64; U.K = PROJ + C_AK + h * 64; U.V = PROJ + C_AV + h * 64; U.O = OA3 + (size_t)c * S * 256 + h * 64; U.opitch = 256;
            U.lse = LSE + (size_t)c * S * 4 + h; U.lse_pitch = 4;
            U.bias = bias2 + h * BIASLEN; U.bmax = bmax + h; U.rs = rs; U.rho = rho; U.u0 = ub * 256; U.W = 128; U.Wp = 128;
            ba::run_unit<8, 1>(F.lds, U, F.wave, F.lane, F.tid);
        } else { const int b = it - P2_NC - P2_NA, kvh = b & 1, blk = b >> 1;
            U.Q = PROJ + C_BQ + kvh * 128; U.K = PROJ + C_BK + kvh * 64; U.V = PROJ + C_BV + kvh * 64; U.O = MIXED + 256 + kvh * 128; U.opitch = DM;
            U.sink = F.in[I_SINK] + layer * 4 + 2 * kvh; U.rs = 1; U.rho = 0; U.u0 = blk * 128; U.W = 127; U.Wp = 128;
            ba::run_unit<4, 2>(F.lds, U, F.wave, F.lane, F.tid);
        }
    }
    __syncthreads();
}
__device__ __forceinline__ void merge_dilated(Frame& F, bf16* MIXED) {
    const bf16* OA3 = (const bf16*)(F.ws + WS_OA3); const float* LSE = (const float*)(F.ws + WS_LSE);
    const int gw = F.vcu * NWAVES + F.wave, NGW = F.G * NWAVES, lane = F.lane, h = lane >> 4;
    for (int p = gw; p < S; p += NGW) {
        const float l0 = LSE[(size_t)p * 4 + h], l1 = LSE[(size_t)(S + p) * 4 + h], l2 = LSE[(size_t)(2 * S + p) * 4 + h];
        const float mx = fmaxf(l0, fmaxf(l1, l2)); const float e0 = exp2f(l0 - mx), e1 = exp2f(l1 - mx), e2 = exp2f(l2 - mx), inv = 1.0f / (e0 + e1 + e2);
        const v2u a = *(const v2u*)(OA3 + (size_t)p * 256 + lane * 4), b = *(const v2u*)(OA3 + (size_t)(S + p) * 256 + lane * 4), c = *(const v2u*)(OA3 + (size_t)(2 * S + p) * 256 + lane * 4);
        const float w0 = e0 * inv, w1 = e1 * inv, w2 = e2 * inv;
        const float r0 = w0 * bflo(a.x) + w1 * bflo(b.x) + w2 * bflo(c.x), r1 = w0 * bfhi(a.x) + w1 * bfhi(b.x) + w2 * bfhi(c.x);
        const float r2 = w0 * bflo(a.y) + w1 * bflo(b.y) + w2 * bflo(c.y), r3 = w0 * bfhi(a.y) + w1 * bfhi(b.y) + w2 * bfhi(c.y);
        *(v2u*)(MIXED + (size_t)p * DM + lane * 4) = (v2u){pk2(r0, r1), pk2(r2, r3)};
    }
}


namespace ca {
using ba::bf16x8; using ba::s16x4; using ba::f32x16; using ba::lds_cptr; using ba::cvtpk; using ba::vtr; using ba::half_sum;
constexpr int CH = 128, SLOTB = 32768, IMPSEL = 2 * SLOTB, IMPQ = 264  , IMPW = 8 * IMPQ * 4  , LDS_END = IMPSEL + 8 * IMPW;
static_assert(LDS_END <= RING_BYTES, "P3a LDS map");
__device__ __forceinline__ float quad_sum(float x) {
    x += __int_as_float(__builtin_amdgcn_update_dpp(0, __float_as_int(x), 0xB1, 0xF, 0xF, true));
    x += __int_as_float(__builtin_amdgcn_update_dpp(0, __float_as_int(x), 0x4E, 0xF, 0xF, true));
    return x;
}
__device__ __forceinline__ unsigned sortkey(float v) { const unsigned b = __float_as_uint(v); return (b & 0x80000000u) ? ~b : (b | 0x80000000u); }
__device__ __forceinline__ void run_unit(LAS unsigned char* lds, const bf16* PROJ, const unsigned char* KVIMG, float kcmax2, bf16* OCMP, unsigned* SELB, int kvh, int cur, int wave, int lane, int tid) {
    const int r32 = lane & 31, hi = lane >> 5, p0 = cur * 64;
    const int ql = r32 >> 2, hh = r32 & 3, qpos = p0 + wave * 8 + ql, H = 4 * kvh + hh;
    int nvq = qpos >= 31 ? ((qpos - 31) >> 4) + 1 : 0; if (nvq > NCMP) nvq = NCMP;
    int nvw = (p0 + wave * 8 + 7) >= 31 ? ((p0 + wave * 8 + 7 - 31) >> 4) + 1 : 0; if (nvw > NCMP) nvw = NCMP;
    int nvu = (p0 + 63 - 31) >= 0 ? ((p0 + 63 - 31) >> 4) + 1 : 0; if (nvu > NCMP) nvu = NCMP;
    const int nch = (nvu + CH - 1) / CH;
    __syncthreads();
    const unsigned char* gsrc = KVIMG + (size_t)kvh * 8 * SLOTB + (size_t)wave * 2048 + lane * 16;
#define CA_ISSUE(ck_, slot_, withv_) do { _Pragma("unroll") for (int i_ = 0; i_ < 2; ++i_) { \
        __builtin_amdgcn_global_load_lds((const unsigned*)(gsrc + (size_t)(ck_) * SLOTB + i_ * 1024), (LAS unsigned*)(lds + (slot_) * SLOTB + wave * 2048 + i_ * 1024), 16, 0, 0); \
        if (withv_) __builtin_amdgcn_global_load_lds((const unsigned*)(gsrc + (size_t)(ck_) * SLOTB + 16384 + i_ * 1024), (LAS unsigned*)(lds + (slot_) * SLOTB + 16384 + wave * 2048 + i_ * 1024), 16, 0, 0); } } while (0)
    CA_ISSUE(0, 0, false);
    bf16x8 qr[4]; float qn = 0.f;
    { const bf16* qp = PROJ + (size_t)qpos * NINP + C_CQ + H * 64 + hi * 8;
#pragma unroll
      for (int d0 = 0; d0 < 4; ++d0) { qr[d0] = *(const bf16x8*)(qp + d0 * 16);
#pragma unroll
          for (int j = 0; j < 8; ++j) { const float x = bf2f((unsigned short)qr[d0][j]); qn += x * x; } }
      qn = half_sum(qn); }
    const float M = sqrtf(qn * kcmax2) * 1.0002f + 1e-6f;
    f32x16 negm;
#pragma unroll
    for (int r = 0; r < 16; ++r) negm[r] = -M;
    LAS float* imps = (LAS float*)(lds + IMPSEL + wave * IMPW);
    for (int e = lane; e < 8 * IMPQ; e += 64) imps[e] = 0.f;
    asm volatile("s_waitcnt vmcnt(0) lgkmcnt(0)" ::: "memory"); __builtin_amdgcn_s_barrier(); asm volatile("" ::: "memory");
    float lsum = 0.f;
    for (int ck = 0; ck < nch; ++ck) {
        if (ck + 1 < nch) CA_ISSUE(ck + 1, (ck + 1) & 1, false); else CA_ISSUE(0, (ck + 1) & 1, true);
        const LAS unsigned char* slot = lds + (ck & 1) * SLOTB;
        for (int kl = 0; kl < CH; kl += 32) { const int kt0 = ck * CH + kl; if (kt0 >= nvw) break;
            f32x16 s;
            { const lds_cptr kb = (lds_cptr)slot + hi * (CH * 16) + (kl + r32) * 16;
#pragma unroll
              for (int d0 = 0; d0 < 4; ++d0) { const bf16x8 kf = *(const LAS bf16x8*)(kb + d0 * (2 * CH * 16)); s = __builtin_amdgcn_mfma_f32_32x32x16_bf16(kf, qr[d0], d0 == 0 ? negm : s, 0, 0, 0); } }
            const int lim = nvq - kt0 - 4 * hi;
#pragma unroll
            for (int r = 0; r < 16; ++r) lsum += ((r & 3) + 8 * (r >> 2)) < lim ? __builtin_amdgcn_exp2f(s[r]) : 0.f; }
        asm volatile("s_waitcnt vmcnt(0) lgkmcnt(0)" ::: "memory"); __builtin_amdgcn_s_barrier(); asm volatile("" ::: "memory");
    }
    const float rinv = 1.0f / fmaxf(half_sum(lsum), 1e-30f);
    f32x16 o0 = {}, o1 = {};
    for (int ck = 0; ck < nch; ++ck) {
        const int sl = (nch + ck) & 1;
        if (ck + 1 < nch) CA_ISSUE(ck + 1, sl ^ 1, true);
        const LAS unsigned char* slot = lds + sl * SLOTB;
        for (int kl = 0; kl < CH; kl += 32) { const int kt0 = ck * CH + kl; if (kt0 >= nvw) break;
            f32x16 s;
            { const lds_cptr kb = (lds_cptr)slot + hi * (CH * 16) + (kl + r32) * 16;
#pragma unroll
              for (int d0 = 0; d0 < 4; ++d0) { const bf16x8 kf = *(const LAS bf16x8*)(kb + d0 * (2 * CH * 16)); s = __builtin_amdgcn_mfma_f32_32x32x16_bf16(kf, qr[d0], d0 == 0 ? negm : s, 0, 0, 0); } }
            const int lim = nvq - kt0 - 4 * hi;
#pragma unroll
            for (int r = 0; r < 16; ++r) s[r] = ((r & 3) + 8 * (r >> 2)) < lim ? __builtin_amdgcn_exp2f(s[r]) * rinv : 0.f;
            { float mains[4], spills[4];
#pragma unroll
              for (int a = 0; a < 4; ++a) { const float x0 = quad_sum(s[4 * a]), x1 = quad_sum(s[4 * a + 1]), x2 = quad_sum(s[4 * a + 2]), x3 = quad_sum(s[4 * a + 3]);
                  spills[a] = 0.5f * x3; mains[a] = ((x0 + x1) + x2) + spills[a]; }
              const float mn = hh == 0 ? mains[0] : (hh == 1 ? mains[1] : (hh == 2 ? mains[2] : mains[3]));
              const float sp = hh == 0 ? spills[0] : (hh == 1 ? spills[1] : (hh == 2 ? spills[2] : spills[3]));
              const int j = (kt0 >> 2) + 2 * hh + hi;
              __hip_atomic_fetch_add(imps + ql * IMPQ + j, mn, __ATOMIC_RELAXED, __HIP_MEMORY_SCOPE_WORKGROUP);
              __hip_atomic_fetch_add(imps + ql * IMPQ + j + 1, sp, __ATOMIC_RELAXED, __HIP_MEMORY_SCOPE_WORKGROUP); }
            bf16x8 pa0, pa1;
            { v4u w0 = {cvtpk(s[0], s[1]), cvtpk(s[2], s[3]), cvtpk(s[4], s[5]), cvtpk(s[6], s[7])}, w1 = {cvtpk(s[8], s[9]), cvtpk(s[10], s[11]), cvtpk(s[12], s[13]), cvtpk(s[14], s[15])};
              pa0 = __builtin_bit_cast(bf16x8, w0); pa1 = __builtin_bit_cast(bf16x8, w1); }
            { const lds_cptr vp = (lds_cptr)slot + 16384 + ((lane >> 4) & 1) * 32 + (lane & 3) * 8 + (kl + 4 * hi + ((lane & 15) >> 2)) * 64;
#pragma unroll
              for (int dh = 0; dh < 2; ++dh)
#pragma unroll
                  for (int g = 0; g < 2; ++g) { const s16x4 lo = vtr(vp + dh * (CH * 64) + g * 1024), hv = vtr(vp + dh * (CH * 64) + g * 1024 + 512);
                      const bf16x8 vf = {lo[0], lo[1], lo[2], lo[3], hv[0], hv[1], hv[2], hv[3]};
                      if (dh == 0) o0 = __builtin_amdgcn_mfma_f32_32x32x16_bf16(g == 0 ? pa0 : pa1, vf, o0, 0, 0, 0);
                      else         o1 = __builtin_amdgcn_mfma_f32_32x32x16_bf16(g == 0 ? pa0 : pa1, vf, o1, 0, 0, 0); } }
        }
        asm volatile("s_waitcnt vmcnt(0) lgkmcnt(0)" ::: "memory"); __builtin_amdgcn_s_barrier(); asm volatile("" ::: "memory");
    }
#undef CA_ISSUE
#pragma unroll
    for (int r = 0; r < 16; ++r) { const int c = (r & 3) + 8 * (r >> 2) + 4 * hi;
        bf16* op = OCMP + (size_t)(p0 + wave * 8 + (c >> 2)) * 512 + (4 * kvh + (c & 3)) * 64 + r32;
        op[0] = (bf16)f2bf(o0[r]); op[32] = (bf16)f2bf(o1[r]); }
    { unsigned key[8][4]; unsigned T[8];
#pragma unroll
      for (int q = 0; q < 8; ++q) { const int qp = p0 + wave * 8 + q; const LAS float* im = imps + q * IMPQ; T[q] = 0u;
#pragma unroll
          for (int c = 0; c < 4; ++c) { const int j = lane + 64 * c; const bool forced = (j == 0) || (j == cur) || (j == cur - 1);
              key[q][c] = sortkey(forced ? 1e4f : ((j * 64 <= qp) ? im[j] : -1e30f)); } }
      int exact = 0;
#pragma unroll 1
      for (int b = 31; b >= 0 && exact != 0xff; --b) {
#pragma unroll
          for (int q = 0; q < 8; ++q) { const unsigned trial = T[q] | (1u << b);
              const int cnt = __popcll(__ballot(key[q][0] >= trial)) + __popcll(__ballot(key[q][1] >= trial)) + __popcll(__ballot(key[q][2] >= trial)) + __popcll(__ballot(key[q][3] >= trial));
              if (!((exact >> q) & 1)) { T[q] = cnt >= 16 ? trial : T[q]; exact |= (cnt == 16) << q; } } }
#pragma unroll
      for (int q = 0; q < 8; ++q) { const int qp = p0 + wave * 8 + q;
          unsigned long long sel[4]; int rem = 16;
#pragma unroll
          for (int c = 0; c < 4; ++c) { sel[c] = __ballot(key[q][c] > T[q]); rem -= __popcll(sel[c]); }
#pragma unroll
          for (int c = 0; c < 4; ++c) { const unsigned long long e = __ballot(key[q][c] == T[q]); const int n = __popcll(e);
              if (n <= rem) { sel[c] |= e; rem -= n; } else { unsigned long long t = e; for (int z = 0; z < rem; ++z) t &= t - 1ull; sel[c] |= e & ~t; rem = 0; } }
#pragma unroll
          for (int c = 0; c < 4; ++c) sel[c] &= __ballot((lane + 64 * c) * 64 <= qp);
          const unsigned long long mine = lane < 2 ? sel[0] : (lane < 4 ? sel[1] : (lane < 6 ? sel[2] : sel[3]));
          if (lane < 8) SELB[((size_t)qp * 2 + kvh) * 8 + lane] = (lane & 1) ? (unsigned)(mine >> 32) : (unsigned)mine; }
    }
}
}

__device__ __forceinline__ void p3a_cmp_select(Frame& F, int layer, const bf16* PROJ) {
    bf16* OCMP = (bf16*)(F.ws + WS_OCMP); unsigned* SELB = (unsigned*)(F.ws + WS_SELB);
    const unsigned* mx = (const unsigned*)(F.ws + WS_CTL) + CW_MAX + layer * 16;
    for (int k = F.vcu; k < 256; k += F.G) for (int rep = 0; rep < 2; ++rep) { const int x = rep == 0 ? 511 - k : k;
        const int kvh = x & 1, cur = x >> 1;
        const float kcmax2 = __uint_as_float(__hip_atomic_load(mx + kvh, __ATOMIC_RELAXED, __HIP_MEMORY_SCOPE_AGENT));
        ca::run_unit(F.lds, PROJ, F.ws + WS_KCB, kcmax2, OCMP, SELB, kvh, cur, F.wave, F.lane, F.tid); }
    __syncthreads();
}

__device__ __forceinline__ void p3b_naive(Frame& F, int layer, const bf16* PROJ, const bf16* OWIN, bf16* MIXED) {
    LAS float* qs = (LAS float*)(F.lds + F.wave * 2048);
    const int gw = F.vcu * NWAVES + F.wave, NGW = F.G * NWAVES, lane = F.lane;
    const float* bias2 = (const float*)(F.ws + WS_BIAS);
    const bf16* OCMP = (const bf16*)(F.ws + WS_OCMP); const unsigned* SELB = (const unsigned*)(F.ws + WS_SELB);
    for (int it = gw; it < S * 2; it += NGW) {
        const int p = it >> 1, kvh = it & 1;
#pragma unroll
        for (int g = 0; g < 4; ++g) load_q(PROJ + (size_t)p * NINP + C_CQ + (4 * kvh + g) * 64, qs + g * 64, lane);
        LDS_WAIT(); asm volatile("" ::: "memory");
        float m2[4] = {-1e30f, -1e30f, -1e30f, -1e30f}, l2[4] = {0.f, 0.f, 0.f, 0.f}, o2[4] = {0.f, 0.f, 0.f, 0.f};
#pragma unroll 1
        for (int w = 0; w < 8; ++w) { unsigned bits = SELB[((size_t)p * 2 + kvh) * 8 + w];
            while (bits) { const int b = __builtin_ctz(bits); bits &= bits - 1; const int bi = w * 32 + b;
                KeySel kf{p, bi, bias2 + (4 + 4 * kvh) * BIASLEN}; wave_attend<4>(PROJ + C_CKS + kvh * 64, PROJ + C_CVS + kvh * 64, qs, 64, kf, m2, l2, o2, lane); } }
#pragma unroll
        for (int g = 0; g < 4; ++g) { const int H = 4 * kvh + g;
            const float g0 = bf2f(PROJ[(size_t)p * NINP + C_CG + H * 3 + 0]), g1 = bf2f(PROJ[(size_t)p * NINP + C_CG + H * 3 + 1]), g2 = bf2f(PROJ[(size_t)p * NINP + C_CG + H * 3 + 2]);
            const float ocmp = bf2f(OCMP[(size_t)p * 512 + H * 64 + lane]), oslc = o2[g] / l2[g], owin = bf2f(OWIN[(size_t)p * 512 + H * 64 + lane]);
            MIXED[(size_t)p * DM + 512 + H * 64 + lane] = (bf16)f2bf(g0 * ocmp + g1 * oslc + g2 * owin); }
        LDS_WAIT(); asm volatile("" ::: "memory");
    }
}


namespace sa {
using ba::bf16x8; using ba::s16x4; using ba::lds_cptr; using ba::cvtpk; using ba::vtr;
typedef float f32x4v __attribute__((ext_vector_type(4)));
constexpr int SLOTB = 65536, NSLOT = 2, BT = NSLOT * SLOTB, BTH = 1540  , BM = BT + 4 * BTH * 4, LDS_END = BM + 2048;
static_assert(LDS_END <= RING_BYTES, "P3b LDS map");
__device__ __forceinline__ void run_unit(LAS unsigned char* lds, const bf16* PROJ, const unsigned char* KSIMG, const float* bias2, const float* bmax, float ksmax2, const bf16* OCMP, const bf16* OWIN,
                                         const unsigned* SELB, bf16* MIXED, int kvh, int cur, int wave, int lane, int tid) {
    const int p0 = cur * 64, col = lane & 15, g = lane >> 4, qq = col >> 2, hh = col & 3, H = 4 * kvh + hh;
    __syncthreads();
    for (int e = tid; e < 4 * BTH; e += NTHREADS) { const int h = e / BTH, i = e % BTH; int d = i - 3; d = d < 0 ? 0 : (d > 1535 ? 1535 : d);
        ((LAS float*)(lds + BT))[e] = bias2[(4 + 4 * kvh + h) * BIASLEN + d]; }
    ((LAS unsigned*)(lds + BM))[tid] = SELB[((size_t)(p0 + (tid >> 3)) * 2 + kvh) * 8 + (tid & 7)];
    const unsigned char* gsrc = KSIMG + (size_t)kvh * 256 * 16384 + (size_t)wave * 8192 + lane * 16;
    const int nsb = cur / 4 + 1;
#define SA_ISSUE(sb_, slot_) do { _Pragma("unroll") for (int i_ = 0; i_ < 8; ++i_) \
        __builtin_amdgcn_global_load_lds((const unsigned*)(gsrc + (size_t)(sb_) * 65536 + i_ * 1024), (LAS unsigned*)(lds + (slot_) * SLOTB + wave * 8192 + i_ * 1024), 16, 0, 0); } while (0)
    SA_ISSUE(0, 0);
    bf16x8 qf[2][2]; float negM[2], negMfar[2]; int qpos[2];
#pragma unroll
    for (int cg = 0; cg < 2; ++cg) {
        const int ql = wave * 8 + cg * 4 + qq; qpos[cg] = p0 + ql;
        const bf16* qp = PROJ + (size_t)qpos[cg] * NINP + C_CQ + H * 64 + g * 8; float qn = 0.f;
#pragma unroll
        for (int ks = 0; ks < 2; ++ks) { qf[cg][ks] = *(const bf16x8*)(qp + ks * 32);
#pragma unroll
            for (int j = 0; j < 8; ++j) { const float x = bf2f((unsigned short)qf[cg][ks][j]); qn += x * x; } }
        qn += __shfl_xor(qn, 16); qn += __shfl_xor(qn, 32);
        const float M = sqrtf(qn * ksmax2) * 1.0002f + fmaxf(bmax[4 + H], 0.f) + 1e-6f;
        negM[cg] = -M; negMfar[cg] = -M + bias2[(4 + H) * BIASLEN + 1535];
    }
    asm volatile("s_waitcnt vmcnt(0) lgkmcnt(0)" ::: "memory"); __builtin_amdgcn_s_barrier(); asm volatile("" ::: "memory");
    unsigned cgm[2];
#pragma unroll
    for (int cg = 0; cg < 2; ++cg) { unsigned m = 0u;
        if (lane < 8) { const LAS unsigned* b = (const LAS unsigned*)(lds + BM) + (wave * 8 + cg * 4) * 8 + lane; m = b[0] | b[8] | b[16] | b[24]; }
        cgm[cg] = m; }
    f32x4v oacc[2][4]; float lsum[2] = {0.f, 0.f};
#pragma unroll
    for (int cg = 0; cg < 2; ++cg)
#pragma unroll
        for (int dt = 0; dt < 4; ++dt) oacc[cg][dt] = (f32x4v){0.f, 0.f, 0.f, 0.f};
    const LAS float* bt = (const LAS float*)(lds + BT) + hh * BTH;
    for (int sb = 0; sb < nsb; ++sb) {
        if (sb + 1 < nsb) SA_ISSUE(sb + 1, (sb + 1) & 1);
#pragma unroll 1
        for (int blk = 0; blk < 4; ++blk) { const int j = 4 * sb + blk; if (j > cur) break;
        const LAS unsigned char* slot = lds + (sb & 1) * SLOTB + blk * 16384;
        const bool far = cur - j >= 25, diag = j == cur;
#pragma unroll
        for (int cg = 0; cg < 2; ++cg) {
            const unsigned word = __builtin_amdgcn_readlane(cgm[cg], j >> 5);
            if (!((word >> (j & 31)) & 1u)) continue;
            const bool mine = (((const LAS unsigned*)(lds + BM))[(wave * 8 + cg * 4 + qq) * 8 + (j >> 5)] >> (j & 31)) & 1u;
            const float nm = mine ? (far ? negMfar[cg] : negM[cg]) : -1e30f;
            f32x4v s[4];
#pragma unroll
            for (int t = 0; t < 4; ++t) { s[t] = (f32x4v){nm, nm, nm, nm};
#pragma unroll
                for (int ks = 0; ks < 2; ++ks) { const bf16x8 kf = *(const LAS bf16x8*)(slot + (4 * ks + g) * 1024 + (16 * t + col) * 16);
                    s[t] = __builtin_amdgcn_mfma_f32_16x16x32_bf16(kf, qf[cg][ks], s[t], 0, 0, 0); } }
            float ps = 0.f;
            if (far) {
#pragma unroll
                for (int t = 0; t < 4; ++t)
#pragma unroll
                    for (int e = 0; e < 4; ++e) { const float pv = __builtin_amdgcn_exp2f(s[t][e]); s[t][e] = pv; ps += pv; }
            } else {
#pragma unroll
                for (int t = 0; t < 4; ++t) { const int d0 = qpos[cg] - (64 * j + 16 * t + 4 * g); int db = d0 + 3; db = db < 3 ? 3 : (db > 1538 ? 1538 : db);
                    const LAS float* tb = bt + db - 3;
#pragma unroll
                    for (int e = 0; e < 4; ++e) { float pv = __builtin_amdgcn_exp2f(s[t][e] + tb[3 - e]); if (diag && d0 - e < 0) pv = 0.f; s[t][e] = pv; ps += pv; } }
            }
            lsum[cg] += ps;
#pragma unroll
            for (int ks2 = 0; ks2 < 2; ++ks2) {
                const v4u pw = {cvtpk(s[2 * ks2][0], s[2 * ks2][1]), cvtpk(s[2 * ks2][2], s[2 * ks2][3]), cvtpk(s[2 * ks2 + 1][0], s[2 * ks2 + 1][1]), cvtpk(s[2 * ks2 + 1][2], s[2 * ks2 + 1][3])};
                const bf16x8 pf = __builtin_bit_cast(bf16x8, pw);
                const lds_cptr vb = (lds_cptr)slot + 8192 + (32 * ks2 + 4 * g + (col >> 2)) * 32 + (col & 3) * 8;
#pragma unroll
                for (int dt = 0; dt < 4; ++dt) { const s16x4 lo = vtr(vb + dt * 2048), hv = vtr(vb + dt * 2048 + 512);
                    const bf16x8 vf = {lo[0], lo[1], lo[2], lo[3], hv[0], hv[1], hv[2], hv[3]};
                    oacc[cg][dt] = __builtin_amdgcn_mfma_f32_16x16x32_bf16(vf, pf, oacc[cg][dt], 0, 0, 0); } }
        } }
        asm volatile("s_waitcnt vmcnt(0) lgkmcnt(0)" ::: "memory"); __builtin_amdgcn_s_barrier(); asm volatile("" ::: "memory");
    }
#undef SA_ISSUE
#pragma unroll
    for (int cg = 0; cg < 2; ++cg) {
        float l = lsum[cg]; l += __shfl_xor(l, 16); l += __shfl_xor(l, 32);
        const float rl = 1.0f / l; const size_t q = (size_t)qpos[cg];
        const float g0 = bf2f(PROJ[q * NINP + C_CG + H * 3 + 0]), g1 = bf2f(PROJ[q * NINP + C_CG + H * 3 + 1]) * rl, g2 = bf2f(PROJ[q * NINP + C_CG + H * 3 + 2]);
#pragma unroll
        for (int dt = 0; dt < 4; ++dt) { const int d = 16 * dt + 4 * g;
            const v2u a = *(const v2u*)(OCMP + q * 512 + H * 64 + d), b = *(const v2u*)(OWIN + q * 512 + H * 64 + d);
            const float r0 = g0 * bflo(a.x) + g1 * oacc[cg][dt][0] + g2 * bflo(b.x), r1 = g0 * bfhi(a.x) + g1 * oacc[cg][dt][1] + g2 * bfhi(b.x);
            const float r2 = g0 * bflo(a.y) + g1 * oacc[cg][dt][2] + g2 * bflo(b.y), r3 = g0 * bfhi(a.y) + g1 * oacc[cg][dt][3] + g2 * bfhi(b.y);
            *(v2u*)(MIXED + q * DM + 512 + H * 64 + d) = (v2u){pk2(r0, r1), pk2(r2, r3)}; }
    }
}
}

__device__ __forceinline__ void p3b_select(Frame& F, int layer, const bf16* PROJ, const bf16* OWIN, bf16* MIXED) {
    const float* bias2 = (const float*)(F.ws + WS_BIAS); const float* bmax = (const float*)(F.ws + WS_BMAX);
    const bf16* OCMP = (const bf16*)(F.ws + WS_OCMP); const unsigned* SELB = (const unsigned*)(F.ws + WS_SELB);
    const unsigned* mx = (const unsigned*)(F.ws + WS_CTL) + CW_MAX + layer * 16;
    for (int k = F.vcu; k < 256; k += F.G) for (int rep = 0; rep < 2; ++rep) { const int x = rep == 0 ? 511 - k : k;
        const int kvh = x & 1, cur = x >> 1;
        const float ksmax2 = __uint_as_float(__hip_atomic_load(mx + 2 + kvh, __ATOMIC_RELAXED, __HIP_MEMORY_SCOPE_AGENT));
        sa::run_unit(F.lds, PROJ, F.ws + WS_KSIMG, bias2, bmax, ksmax2, OCMP, OWIN, SELB, MIXED, kvh, cur, F.wave, F.lane, F.tid); }
    __syncthreads();
}
__device__ __forceinline__ void p2_kslc_norm(Frame& F, int layer, const bf16* PROJ) {
    const int gt = F.vcu * NTHREADS + F.tid, NGT = F.G * NTHREADS; float m0 = 0.f, m1 = 0.f;
    for (int idx = gt; idx < S * 16; idx += NGT) { const int n = idx >> 3, c = idx & 7, p = n >> 1, kvh = n & 1;
        const v4u w = *(const v4u*)(PROJ + (size_t)p * NINP + C_CKS + kvh * 64 + c * 8);
        const float a0 = bflo(w.x), a1 = bfhi(w.x), a2 = bflo(w.y), a3 = bfhi(w.y), a4 = bflo(w.z), a5 = bfhi(w.z), a6 = bflo(w.w), a7 = bfhi(w.w);
        float s = a0 * a0 + a1 * a1 + a2 * a2 + a3 * a3 + a4 * a4 + a5 * a5 + a6 * a6 + a7 * a7;
        s += __shfl_xor(s, 1); s += __shfl_xor(s, 2); s += __shfl_xor(s, 4);
        if (kvh) m1 = fmaxf(m1, s); else m0 = fmaxf(m0, s); }
    m0 = wave_max(m0); m1 = wave_max(m1);
    if (F.lane == 0) { unsigned* mx = (unsigned*)(F.ws + WS_CTL) + CW_MAX + layer * 16;
        __hip_atomic_fetch_max(mx + 2, __float_as_uint(m0), __ATOMIC_RELAXED, __HIP_MEMORY_SCOPE_AGENT); __hip_atomic_fetch_max(mx + 3, __float_as_uint(m1), __ATOMIC_RELAXED, __HIP_MEMORY_SCOPE_AGENT); }
}


namespace cm {
using ba::bf16x8; using ba::f32x16;
constexpr int AIMG = 0, HIMG = 32768, LDS_END = HIMG + 16384;
__device__ __forceinline__ void run_unit(LAS unsigned char* lds, const bf16* PROJ, const bf16* W1C, const float* posw1, const bf16* W2T, bf16* OUTB, unsigned* maxw,
                                         int kv, int ru, int wave, int lane, int tid) {
    const int r32 = lane & 31, hi = lane >> 5, R0 = ru * 32, ccol = kv ? C_CVC : C_CKC;
    f32x16 acc = {};
    for (int kc = 0; kc < 4; ++kc) {
        __syncthreads();
#pragma unroll
        for (int i_ = 0; i_ < 4; ++i_) { const int idx = tid + i_ * NTHREADS, row = idx >> 6, c = idx & 63; int R = R0 + row; if (R > 2045) R = 2045;
            const v4u w = *(const v4u*)(PROJ + (size_t)(16 * (R >> 1) + 8 * kc + (c >> 3)) * NINP + ccol + (R & 1) * 64 + (c & 7) * 8);
            *(LAS v4u*)(lds + AIMG + c * 512 + row * 16) = w; }
        __syncthreads();
        const bf16* wb = W1C + ((size_t)(kc * 64 + hi) * 256 + wave * 32 + r32) * 8;
#pragma unroll 4
        for (int ks = 0; ks < 32; ++ks) {
            const bf16x8 af = *(const LAS bf16x8*)(lds + AIMG + (2 * ks + hi) * 512 + r32 * 16);
            const bf16x8 bfr = *(const bf16x8*)(wb + (size_t)ks * 2 * 256 * 8);
            acc = __builtin_amdgcn_mfma_f32_32x32x16_bf16(af, bfr, acc, 0, 0, 0); }
    }
    { const int n = wave * 32 + r32; const float pb = posw1[n];
#pragma unroll
      for (int r = 0; r < 16; ++r) { const int row = (r & 3) + 8 * (r >> 2) + 4 * hi; const float x = acc[r] + pb;
          const float u2 = 1.5957691216057308f * (x + 0.044715f * x * x * x); const float gl = x / (1.0f + __expf(-u2));
          *(LAS bf16*)(lds + HIMG + (n >> 3) * 512 + row * 16 + (n & 7) * 2) = (bf16)f2bf(gl); } }
    __syncthreads();
    if (wave == 0) {
        f32x16 o0 = {}, o1 = {};
#pragma unroll 4
        for (int ks = 0; ks < 16; ++ks) { const bf16x8 af = *(const LAS bf16x8*)(lds + HIMG + (2 * ks + hi) * 512 + r32 * 16);
            const bf16x8 b0 = *(const bf16x8*)(W2T + (size_t)r32 * 256 + ks * 16 + hi * 8), b1 = *(const bf16x8*)(W2T + (size_t)(32 + r32) * 256 + ks * 16 + hi * 8);
            o0 = __builtin_amdgcn_mfma_f32_32x32x16_bf16(af, b0, o0, 0, 0, 0); o1 = __builtin_amdgcn_mfma_f32_32x32x16_bf16(af, b1, o1, 0, 0, 0); }
#pragma unroll
        for (int r = 0; r < 16; ++r) { const int R = R0 + (r & 3) + 8 * (r >> 2) + 4 * hi, i = R >> 1, hk = R & 1;
            unsigned char* ib = (unsigned char*)OUTB + ((size_t)hk * 8 + (i >> 7)) * 32768; const int kk = i & 127;
            const unsigned a = R < 2046 ? f2bf(o0[r]) : 0u, b = R < 2046 ? f2bf(o1[r]) : 0u;
            if (kv == 0) { *(bf16*)(ib + (r32 >> 3) * 2048 + kk * 16 + (r32 & 7) * 2) = (bf16)a; *(bf16*)(ib + (4 + (r32 >> 3)) * 2048 + kk * 16 + (r32 & 7) * 2) = (bf16)b; }
            else         { *(bf16*)(ib + 16384 + kk * 64 + r32 * 2) = (bf16)a;                            *(bf16*)(ib + 16384 + 8192 + kk * 64 + r32 * 2) = (bf16)b; } }
        if (maxw) { float m0 = 0.f, m1 = 0.f;
#pragma unroll
            for (int r = 0; r < 16; ++r) { const int R = R0 + (r & 3) + 8 * (r >> 2) + 4 * hi; const float fa = bf2f((unsigned short)f2bf(o0[r])), fb = bf2f((unsigned short)f2bf(o1[r])); float n2 = fa * fa + fb * fb;
                n2 += __shfl_xor(n2, 1); n2 += __shfl_xor(n2, 2); n2 += __shfl_xor(n2, 4); n2 += __shfl_xor(n2, 8); n2 += __shfl_xor(n2, 16);
                if (R < 2046) { if (r & 1) m1 = fmaxf(m1, n2); else m0 = fmaxf(m0, n2); } }
            m0 = fmaxf(m0, __shfl_xor(m0, 32)); m1 = fmaxf(m1, __shfl_xor(m1, 32));
            if (lane == 0) { __hip_atomic_fetch_max(maxw, __float_as_uint(m0), __ATOMIC_RELAXED, __HIP_MEMORY_SCOPE_AGENT); __hip_atomic_fetch_max(maxw + 1, __float_as_uint(m1), __ATOMIC_RELAXED, __HIP_MEMORY_SCOPE_AGENT); } }
    }
}
}
__device__ __forceinline__ void p2_compress_mfma(Frame& F, int layer, const bf16* PROJ) {
    for (int it = F.vcu; it < 128; it += F.G) { const int kv = it & 1, ru = it >> 1;
        cm::run_unit(F.lds, PROJ, (const bf16*)(F.ws + WS_CW1) + (size_t)(layer * 2 + kv) * 2048 * 256, (const float*)(F.ws + WS_POSW1) + (layer * 2 + kv) * 256,
                     (const bf16*)(F.ws + WS_CW2T) + (size_t)(layer * 2 + kv) * 64 * 256, (bf16*)(F.ws + WS_KCB),
                     kv == 0 ? (unsigned*)(F.ws + WS_CTL) + CW_MAX + layer * 16 : nullptr, kv, ru, F.wave, F.lane, F.tid); }
    __syncthreads();
}

constexpr int NSUB = 9;
constexpr int N_PHASES = 2 + NSUB * DEPTH;
__device__ __forceinline__ void run_phase(Frame& F, int ph) {
    unsigned char* ws = F.ws;
    const float* mod = (const float*)(ws + WS_MOD);
    if (ph == 0) { p0_prologue(F); return; }
    if (ph == 1) { row_pass<0>(F, F.in[I_X], nullptr, (bf16*)(ws + WS_RA), nullptr, nullptr, mod + 1024, mod + 0); return; }
    const int l = (ph - 2) / NSUB, si = (ph - 2) % NSUB;
    const int sub = si <= 2 ? si : (si == 3 ? 8 : si - 1);
    const float* modl = mod + l * 6144;
    bf16* bufX = (bf16*)(ws + ((l & 1) ? WS_RB : WS_RA));
    bf16* bufY = (bf16*)(ws + ((l & 1) ? WS_RA : WS_RB));
    bf16* PROJ = (bf16*)(ws + WS_BIG); bf16* HID = (bf16*)(ws + WS_BIG); bf16* OWIN = (bf16*)(ws + WS_OWIN);
    const float* xres = (l == 0) ? F.in[I_X] : F.out;
    switch (sub) {
    case 0: {
        pg8::Gemm g{bufX, (const bf16*)(ws + WS_WIN) + (size_t)l * NINP * DM, S, NINP, DM}; pg8::StaticOrder So; So.init(S, NINP, F.G, (int)blockIdx.x);
        pg8::EpiInProj E{PROJ, NINP, (const float*)(ws + WS_ROPE), QSCALE, ws + WS_KSIMG};
        pg8::gemm_phase<pg8::EpiInProj, pg8::StaticOrder, PG8_ALIGN, PG8_SP2>(F.lds, g, So, E, F.wave);
    } break;
    case 1: p2_kslc_norm(F, l, PROJ); p2_compress_mfma(F, l, PROJ); p2_banded(F, l, PROJ, bufY, OWIN);
#if DUP_ACT == 1
        p2_banded(F, l, PROJ, bufY, OWIN);
#elif DUP_ACT == 11
        p2_compress_mfma(F, l, PROJ);
#endif
        break;
    case 2: merge_dilated(F, bufY); p3a_cmp_select(F, l, PROJ);
#if DUP_ACT == 2
        p3a_cmp_select(F, l, PROJ);
#endif
        break;
    case 8: p3b_select(F, l, PROJ, OWIN, bufY);
#if DUP_ACT == 8
        p3b_select(F, l, PROJ, OWIN, bufY);
#endif
        break;
    case 3: {
        pg8::Gemm g{bufY, (const bf16*)(ws + WS_WOUT) + (size_t)l * DM * DM, S, DM, DM}; pg8::StaticOrder So; So.init(S, DM, F.G, (int)blockIdx.x);
        pg8::EpiResid E{xres, F.out, DM, modl + 2048, DN_ALPHA};
        pg8::gemm_phase<pg8::EpiResid, pg8::StaticOrder, PG8_ALIGN, PG8_SP2>(F.lds, g, So, E, F.wave);
    } break;
    case 4: row_pass<1>(F, F.out, F.out, bufX, F.in[I_LNG] + (l * 2 + 0) * DM, F.in[I_LNB] + (l * 2 + 0) * DM, modl + 4096, modl + 3072); break;
    case 5: {
        pg8::Gemm g{bufX, (const bf16*)(ws + WS_W1) + (size_t)l * DFF * DM, S, DFF, DM}; pg8::StaticOrder So; So.init(S, DFF, F.G, (int)blockIdx.x);
        pg8::EpiRelu2 E{HID, DFF};
        pg8::gemm_phase<pg8::EpiRelu2, pg8::StaticOrder, PG8_ALIGN, PG8_SP2>(F.lds, g, So, E, F.wave);
    } break;
    case 6: {
        pg8::Gemm g{HID, (const bf16*)(ws + WS_W2) + (size_t)l * DM * DFF, S, DM, DFF}; pg8::StaticOrder So; So.init(S, DM, F.G, (int)blockIdx.x);
        pg8::EpiResid E{F.out, F.out, DM, modl + 5120, DN_ALPHA};
        pg8::gemm_phase<pg8::EpiResid, pg8::StaticOrder, PG8_ALIGN, PG8_SP2>(F.lds, g, So, E, F.wave);
    } break;
    default: {
        if (l + 1 < DEPTH) row_pass<1>(F, F.out, F.out, bufY, F.in[I_LNG] + (l * 2 + 1) * DM, F.in[I_LNB] + (l * 2 + 1) * DM, modl + 6144 + 1024, modl + 6144 + 0);
        else row_pass<2>(F, F.out, F.out, nullptr, F.in[I_LNG] + (l * 2 + 1) * DM, F.in[I_LNB] + (l * 2 + 1) * DM, nullptr, nullptr);
    } break;
    }
}

__global__ void __launch_bounds__(NTHREADS, 2) fwd_kernel(Args args) {
    extern __shared__ __attribute__((aligned(16))) unsigned char lds[];
    Frame F;
    F.lds = (LAS unsigned char*)lds;
    F.tid = threadIdx.x; F.lane = F.tid & 63; F.wave = __builtin_amdgcn_readfirstlane(F.tid >> 6);
    F.G = gridDim.x; { const int bx = blockIdx.x; F.vcu = (F.G % 8 == 0) ? (bx % 8) * (F.G / 8) + bx / 8 : bx; }
    F.ws = args.ws; F.out = args.out;
#pragma unroll
    for (int i = 0; i < 16; ++i) F.in[i] = args.in[i];
    for (int u = F.tid; u < (LDS_BYTES - LDSCTL_OFF) / 4; u += NTHREADS) ((LAS unsigned*)(F.lds + LDSCTL_OFF))[u] = 0u;
    __syncthreads();
    const int wave0 = __builtin_amdgcn_readfirstlane(threadIdx.x >> 6);
    const bool multi = (args.ph_hi - args.ph_lo) > 1;
    XcdBarrier bar; bar.bar = (unsigned*)(F.ws + WS_CTL) + 4096; bar.x = 0; bar.st = nullptr;
    if (multi) bar = xcd_barrier_post((unsigned*)(F.ws + WS_CTL) + 4096, (volatile LAS unsigned*)(F.lds + MISC_OFF) + 8);
    for (int ph = args.ph_lo; ph < args.ph_hi; ++ph) {
        { int ln = __builtin_amdgcn_mbcnt_hi(~0u, __builtin_amdgcn_mbcnt_lo(~0u, 0u)); asm volatile("" : "+v"(ln)); F.lane = ln; F.wave = wave0; F.tid = wave0 * 64 + ln; }
        run_phase(F, ph);
        if (ph + 1 < args.ph_hi) xcd_barrier(bar);
    }
}

#ifndef DUP_ACT
#define DUP_ACT 0
#endif
#ifndef N_LAUNCH_MODE
#define N_LAUNCH_MODE 1
#endif
extern "C" void kernel_launch(void* const* d_in, const int* in_sizes, int n_in, void* d_out, int out_size, void* d_ws, size_t ws_size, hipStream_t stream) {
    static int grid = 0;
    if (grid == 0) {
        if (n_in != 16 || out_size != S * DM || ws_size < WS_END) { fprintf(stderr, "kernel_launch: unexpected shapes (n_in %d out %d ws %zu)\n", n_in, out_size, ws_size); grid = -1; return; }
        int dev = 0, cus = 0;
        if (hipGetDevice(&dev) != hipSuccess || hipDeviceGetAttribute(&cus, hipDeviceAttributeMultiprocessorCount, dev) != hipSuccess) { grid = -1; return; }
        if (hipFuncSetAttribute((const void*)fwd_kernel, hipFuncAttributeMaxDynamicSharedMemorySize, LDS_BYTES) != hipSuccess) { fprintf(stderr, "kernel_launch: hipFuncSetAttribute failed\n"); grid = -1; return; }
        int per_cu = 0;
        if (hipOccupancyMaxActiveBlocksPerMultiprocessor(&per_cu, (const void*)fwd_kernel, NTHREADS, LDS_BYTES) != hipSuccess || per_cu < 1) fprintf(stderr, "kernel_launch: occupancy query says %d\n", per_cu);
        (void)hipGetLastError();
        grid = cus;
    }
    if (grid < 0) return;
    (void)hipMemsetAsync((char*)d_ws + WS_CTL, 0, CTL_ZERO_BYTES, stream);
    Args a{};
    for (int i = 0; i < 16; ++i) a.in[i] = (const float*)d_in[i];
    a.out = (float*)d_out; a.ws = (unsigned char*)d_ws;
#if N_LAUNCH_MODE == 1
    a.ph_lo = 0; a.ph_hi = N_PHASES;
    hipLaunchKernelGGL(fwd_kernel, dim3(grid), dim3(NTHREADS), LDS_BYTES, stream, a);
#else
    for (int ph = 0; ph < N_PHASES; ++ph) { a.ph_lo = ph; a.ph_hi = ph + 1; hipLaunchKernelGGL(fwd_kernel, dim3(grid), dim3(NTHREADS), LDS_BYTES, stream, a); }
#endif
}
```
